# Optimizing an MI355X kernel written in HIP

```python
import math
import jax, jax.numpy as jnp
from jax import lax
import numpy as np

D_MODEL = 1024
BATCH = 8
SEQ = 4096
DEPTH = 1

MIX_WIDTH = D_MODEL
HEAD_DIM = 64
RWKV_WIDTH = MIX_WIDTH // 2
ATTN_WIDTH = MIX_WIDTH - RWKV_WIDTH
RWKV_HEADS = RWKV_WIDTH // HEAD_DIM
ATTN_HEADS = ATTN_WIDTH // HEAD_DIM
DECAY_RANK = 64
ICLR_RANK = 64
DILATION_PATTERNS = ((128, 1), (512, 4), (2048, 16))
ATTN_BLOCK = 128
ROPE_THETA = 500000.0
ROPE_DIM = HEAD_DIM // 4
NORM_EPS = 1e-6
GN_EPS = 64e-5
SHIFT_WIDTH = 3 * RWKV_WIDTH + DECAY_RANK + ICLR_RANK
IN_WIDTH = SHIFT_WIDTH + RWKV_WIDTH + 4 * ATTN_WIDTH

kernel_name = "hymba_rwkv7_dilated_swa_layer"


def _rmsnorm(x, g):
    xf = x.astype(jnp.float32)
    y = xf * lax.rsqrt(jnp.mean(xf * xf, axis=-1, keepdims=True) + NORM_EPS)
    return (y * g.astype(jnp.float32)).astype(x.dtype)


def _token_shift(p):
    return jnp.pad(p, ((0, 0), (1, 0), (0, 0)))[:, :-1]


def _rwkv7_scan(r, w, k, v, kk, b):
    bsz, _, nh, n = r.shape

    def step(S, inp):
        r_t, w_t, k_t, v_t, kk_t, b_t = inp
        sa = jnp.einsum('bhvk,bhk->bhv', S, -kk_t)
        S = (S * w_t[:, :, None, :] + sa[..., None] * b_t[:, :, None, :]
             + v_t[..., None] * k_t[:, :, None, :])
        y = jnp.einsum('bhvk,bhk->bhv', S, r_t)
        return S, y

    xs = (jnp.moveaxis(r, 1, 0), jnp.moveaxis(w, 1, 0), jnp.moveaxis(k, 1, 0),
          jnp.moveaxis(v, 1, 0), jnp.moveaxis(kk, 1, 0), jnp.moveaxis(b, 1, 0))
    S0 = jnp.zeros((bsz, nh, n, n), jnp.float32)
    _, ys = lax.scan(step, S0, xs)
    return jnp.moveaxis(ys, 0, 1)


def _rwkv7_mixer(p_r, p_k, p_v, p_w, p_a, decay_base, decay_up, iclr_base,
                 iclr_up, key_norm_scale, key_iclr_mix, bonus, gn_gain, gn_bias):
    bsz, t, _ = p_r.shape
    f32 = jnp.float32
    heads = lambda a: a.astype(f32).reshape(bsz, t, RWKV_HEADS, HEAD_DIM)
    decay_logit = -jax.nn.softplus(-(decay_base.astype(f32)
                                     + jnp.tanh(p_w.astype(f32)) @ decay_up.astype(f32))) - 0.5
    w = jnp.exp(-jnp.exp(decay_logit))
    a = jax.nn.sigmoid(iclr_base.astype(f32) + p_a.astype(f32) @ iclr_up.astype(f32))
    kk = heads(p_k * key_norm_scale)
    kk = kk / jnp.maximum(jnp.sqrt(jnp.sum(kk * kk, axis=-1, keepdims=True)), 1e-12)
    k = p_k.astype(f32) * (1.0 + (a - 1.0) * key_iclr_mix.astype(f32))
    r_h, k_h, v_h, w_h, a_h = heads(p_r), heads(k), heads(p_v), heads(w), heads(a)
    y = _rwkv7_scan(r_h, w_h, k_h, v_h, kk, kk * a_h)
    mu = jnp.mean(y, axis=-1, keepdims=True)
    var = jnp.mean(jnp.square(y - mu), axis=-1, keepdims=True)
    y = (y - mu) * lax.rsqrt(var + GN_EPS)
    y = y.reshape(bsz, t, RWKV_WIDTH) * gn_gain.astype(f32) + gn_bias.astype(f32)
    bonus_term = jnp.sum(r_h * k_h * bonus.astype(f32), axis=-1, keepdims=True) * v_h
    return y + bonus_term.reshape(bsz, t, RWKV_WIDTH)


def _rope_partial(t, pos):
    half = ROPE_DIM // 2
    inv = ROPE_THETA ** (-jnp.arange(half, dtype=jnp.float32) * 2.0 / ROPE_DIM)
    ang = pos.astype(jnp.float32)[:, None] * inv[None, :]
    cos = jnp.cos(ang)[None, :, None, :].astype(t.dtype)
    sin = jnp.sin(ang)[None, :, None, :].astype(t.dtype)
    x1, x2 = t[..., :half], t[..., half:ROPE_DIM]
    return jnp.concatenate([x1 * cos - x2 * sin, x1 * sin + x2 * cos, t[..., ROPE_DIM:]], axis=-1)


def _banded_attention(q, k, v, span):
    g, L, n = q.shape
    blk = ATTN_BLOCK
    nb = -(-L // blk)
    lp = nb * blk
    qb = jnp.pad(q, ((0, 0), (0, lp - L), (0, 0))).reshape(g, nb, blk, n)
    kf = jnp.pad(k, ((0, 0), (blk, lp - L), (0, 0)))
    vf = jnp.pad(v, ((0, 0), (blk, lp - L), (0, 0)))
    kw = jnp.concatenate([kf[:, :lp].reshape(g, nb, blk, n), kf[:, blk:].reshape(g, nb, blk, n)], axis=2)
    vw = jnp.concatenate([vf[:, :lp].reshape(g, nb, blk, n), vf[:, blk:].reshape(g, nb, blk, n)], axis=2)
    s = jnp.einsum('gnqd,gnkd->gnqk', qb, kw).astype(jnp.float32) * (n ** -0.5)
    i = jnp.arange(blk)[:, None]
    j = jnp.arange(2 * blk)[None, :]
    dist = i + blk - j
    bidx = jnp.arange(nb)[:, None, None]
    mask = (dist >= 0) & (dist <= span) & (bidx * blk + j - blk >= 0)
    s = jnp.where(mask, s, -jnp.inf)
    m = jnp.max(s, axis=-1, keepdims=True)
    p = jnp.exp(s - m)
    l = jnp.sum(p, axis=-1, keepdims=True)
    o = jnp.einsum('gnqk,gnkd->gnqd', (p / l).astype(v.dtype), vw)
    lse = (m + jnp.log(l))[..., 0]
    return o.reshape(g, lp, n)[:, :L], lse.reshape(g, lp)[:, :L]


def _dilated_attention(q, k, v):
    bsz, t, nh, n = q.shape
    outs, lses = [], []
    for window, dil in DILATION_PATTERNS:
        L = t // dil
        split = lambda a: a.reshape(bsz, L, dil, nh, n).transpose(0, 2, 3, 1, 4).reshape(bsz * dil * nh, L, n)
        o, lse = _banded_attention(split(q), split(k), split(v), window // dil)
        outs.append(o.reshape(bsz, dil, nh, L, n).transpose(0, 3, 1, 2, 4).reshape(bsz, t, nh, n))
        lses.append(lse.reshape(bsz, dil, nh, L).transpose(0, 3, 1, 2).reshape(bsz, t, nh))
    wts = jax.nn.softmax(jnp.stack(lses, axis=0), axis=0)
    out = jnp.sum(wts[..., None] * jnp.stack(outs, axis=0).astype(jnp.float32), axis=0)
    return out.astype(q.dtype)


def setup_inputs(seed: int = 0) -> dict:
    key = jax.random.key(seed)
    ks = jax.random.split(key, 16)
    f32 = jnp.float32
    nrm = lambda kk, shape: jax.random.normal(kk, shape, f32)
    x = nrm(ks[0], (BATCH, SEQ, D_MODEL))
    norm_gain = 1.0 + 0.02 * nrm(ks[1], (DEPTH, D_MODEL))
    w_in = nrm(ks[2], (DEPTH, D_MODEL, IN_WIDTH)) * D_MODEL ** -0.5
    shift_mix = jax.random.uniform(ks[3], (DEPTH, SHIFT_WIDTH), f32)
    decay_base = jax.random.uniform(ks[4], (DEPTH, RWKV_WIDTH), f32, minval=-4.0, maxval=1.0)
    decay_up = nrm(ks[5], (DEPTH, DECAY_RANK, RWKV_WIDTH)) * 0.5 * DECAY_RANK ** -0.5
    iclr_base = 0.1 * nrm(ks[6], (DEPTH, RWKV_WIDTH))
    iclr_up = nrm(ks[7], (DEPTH, ICLR_RANK, RWKV_WIDTH)) * 0.5 * ICLR_RANK ** -0.5
    key_norm_scale = 0.85 + 0.05 * nrm(ks[8], (DEPTH, RWKV_WIDTH))
    key_iclr_mix = 1.0 + 0.05 * nrm(ks[9], (DEPTH, RWKV_WIDTH))
    bonus = 0.1 * nrm(ks[10], (DEPTH, RWKV_HEADS, HEAD_DIM))
    gn_gain = 1.0 + 0.02 * nrm(ks[11], (DEPTH, RWKV_WIDTH))
    gn_bias = 0.02 * nrm(ks[12], (DEPTH, RWKV_WIDTH))
    w_out = nrm(ks[13], (DEPTH, MIX_WIDTH, D_MODEL)) * MIX_WIDTH ** -0.5
    final_gain = 1.0 + 0.02 * nrm(ks[14], (D_MODEL,))
    return {"x": x, "norm_gain": norm_gain, "w_in": w_in, "shift_mix": shift_mix,
            "decay_base": decay_base, "decay_up": decay_up, "iclr_base": iclr_base,
            "iclr_up": iclr_up, "key_norm_scale": key_norm_scale, "key_iclr_mix": key_iclr_mix,
            "bonus": bonus, "gn_gain": gn_gain, "gn_bias": gn_bias, "w_out": w_out,
            "final_gain": final_gain}


def reference(x, norm_gain, w_in, shift_mix, decay_base, decay_up, iclr_base, iclr_up,
              key_norm_scale, key_iclr_mix, bonus, gn_gain, gn_bias, w_out, final_gain):
    bsz, t, _ = x.shape
    pos = jnp.arange(t, dtype=jnp.int32)
    c_a, c_b = RWKV_WIDTH, ATTN_WIDTH
    for layer in range(DEPTH):
        h = _rmsnorm(x, norm_gain[layer])
        p = h @ w_in[layer]
        ps = p[..., :SHIFT_WIDTH]
        ps = ps + (_token_shift(ps) - ps) * shift_mix[layer]
        p_r = ps[..., :c_a]
        p_k = ps[..., c_a:2 * c_a]
        p_v = ps[..., 2 * c_a:3 * c_a]
        p_w = ps[..., 3 * c_a:3 * c_a + DECAY_RANK]
        p_a = ps[..., 3 * c_a + DECAY_RANK:SHIFT_WIDTH]
        o0 = SHIFT_WIDTH
        z_a = p[..., o0:o0 + c_a]
        o1 = o0 + c_a
        q = p[..., o1:o1 + c_b].reshape(bsz, t, ATTN_HEADS, HEAD_DIM)
        k = p[..., o1 + c_b:o1 + 2 * c_b].reshape(bsz, t, ATTN_HEADS, HEAD_DIM)
        v = p[..., o1 + 2 * c_b:o1 + 3 * c_b].reshape(bsz, t, ATTN_HEADS, HEAD_DIM)
        z_b = p[..., o1 + 3 * c_b:o1 + 4 * c_b]
        y_a = _rwkv7_mixer(p_r, p_k, p_v, p_w, p_a, decay_base[layer], decay_up[layer],
                           iclr_base[layer], iclr_up[layer], key_norm_scale[layer],
                           key_iclr_mix[layer], bonus[layer], gn_gain[layer], gn_bias[layer])
        y_a = y_a.astype(x.dtype) * jax.nn.silu(z_a)
        y_b = _dilated_attention(_rope_partial(q, pos), _rope_partial(k, pos), v)
        y_b = y_b.reshape(bsz, t, c_b) * jax.nn.silu(z_b)
        x = x + jnp.concatenate([y_a, y_b], axis=-1) @ w_out[layer]
    return _rmsnorm(x, final_gain)
```

```cpp
#include <hip/hip_runtime.h>
#include <hip/hip_cooperative_groups.h>
#include <stdint.h>
#include <cstdio>
namespace cg = cooperative_groups;

typedef unsigned short bf16_t;
typedef short bf16x8 __attribute__((ext_vector_type(8)));
typedef float f32x4 __attribute__((ext_vector_type(4)));
typedef unsigned u32x4 __attribute__((ext_vector_type(4)));
#define LAS __attribute__((address_space(3)))

constexpr int SEQ = 4096, DM = 1024, MTOK = 32768, NIN = 4224, NPAD = 4352;
constexpr int OFF_R = 0, OFF_K = 512, OFF_V = 1024, OFF_WLO = 1536, OFF_ALO = 1600;
constexpr int OFF_Q = 1664, OFF_KB = 2176, OFF_VB = 2688, OFF_ZA = 3200, OFF_ZB = 3712;

struct Params {
  const float *x, *norm_gain, *w_in, *shift_mix, *decay_base, *decay_up, *iclr_base, *iclr_up,
      *key_norm_scale, *key_iclr_mix, *bonus, *gn_gain, *gn_bias, *w_out, *final_gain;
  float* out;
  bf16_t *hb, *winT, *woutT, *p, *yraw, *dut, *iut;
  char* rec;
  unsigned* barw;
};

typedef float f32x2_t __attribute__((ext_vector_type(2)));
typedef __bf16 bf16x2_t __attribute__((ext_vector_type(2)));
__device__ __forceinline__ unsigned pk_bf16(float lo, float hi) { const f32x2_t v = {lo, hi}; return __builtin_bit_cast(unsigned, __builtin_convertvector(v, bf16x2_t)); }
__device__ __forceinline__ bf16_t f2bf(float f) { return (bf16_t)(pk_bf16(f, 0.f) & 0xffffu); }
__device__ __forceinline__ u32x4 ld_nt(const void* p) { return __builtin_nontemporal_load((const u32x4*)p); }
__device__ __forceinline__ f32x4 ldf_nt(const void* p) { return __builtin_nontemporal_load((const f32x4*)p); }
__device__ __forceinline__ float bf2f(bf16_t h) { return __uint_as_float(((unsigned)h) << 16); }
__device__ __forceinline__ float dpp_add(float v, const int ctrl_sel) {
  const int iv = __builtin_bit_cast(int, v);
  int o;
  if (ctrl_sel == 0) o = __builtin_amdgcn_update_dpp(iv, iv, 0xB1, 0xF, 0xF, false);
  else if (ctrl_sel == 1) o = __builtin_amdgcn_update_dpp(iv, iv, 0x4E, 0xF, 0xF, false);
  else if (ctrl_sel == 2) o = __builtin_amdgcn_update_dpp(iv, iv, 0x141, 0xF, 0xF, false);
  else o = __builtin_amdgcn_update_dpp(iv, iv, 0x140, 0xF, 0xF, false);
  return v + __builtin_bit_cast(float, o);
}
__device__ __forceinline__ float wave_sum(float v) {
  v = dpp_add(v, 0); v = dpp_add(v, 1); v = dpp_add(v, 2); v = dpp_add(v, 3);
  const int iv = __builtin_bit_cast(int, v);
  const float s0 = __builtin_bit_cast(float, __builtin_amdgcn_readlane(iv, 0)), s1 = __builtin_bit_cast(float, __builtin_amdgcn_readlane(iv, 16));
  const float s2 = __builtin_bit_cast(float, __builtin_amdgcn_readlane(iv, 32)), s3 = __builtin_bit_cast(float, __builtin_amdgcn_readlane(iv, 48));
  return (s0 + s1) + (s2 + s3);
}
__device__ __forceinline__ float silu(float z) { return z / (1.f + __expf(-z)); }
__device__ __forceinline__ bf16x8 as_frag(u32x4 v) { return __builtin_bit_cast(bf16x8, v); }

constexpr int PREP_ROW_ITEMS = MTOK / 16, PREP_WIN_TILES = 16 * 68, PREP_WOUT_TILES = 16 * 16;
constexpr int PREP_LR_ITEMS = 128;
constexpr int PREP_ITEMS = PREP_ROW_ITEMS + PREP_WIN_TILES + PREP_WOUT_TILES + PREP_LR_ITEMS;

__device__ void prep_item(const Params& P, int it, float* sm) {
  const int tid = threadIdx.x, lane = tid & 63, wv = tid >> 6;
  if (it < PREP_ROW_ITEMS) {
    const int row = it * 16 + wv * 2;
    const float4* xr = (const float4*)(P.x + (size_t)row * DM);
    const float4* g4 = (const float4*)P.norm_gain;
    float4 v[8];
    float ss0 = 0.f, ss1 = 0.f;
#pragma unroll
    for (int i = 0; i < 8; ++i) { const f32x4 t_ = ldf_nt(xr + lane + 64 * i); v[i] = make_float4(t_[0], t_[1], t_[2], t_[3]); }
#pragma unroll
    for (int i = 0; i < 4; ++i) {
      ss0 += v[i].x * v[i].x + v[i].y * v[i].y + v[i].z * v[i].z + v[i].w * v[i].w;
      ss1 += v[4 + i].x * v[4 + i].x + v[4 + i].y * v[4 + i].y + v[4 + i].z * v[4 + i].z + v[4 + i].w * v[4 + i].w;
    }
    ss0 = wave_sum(ss0); ss1 = wave_sum(ss1);
    const float rstd0 = rsqrtf(ss0 * (1.0f / DM) + 1e-6f), rstd1 = rsqrtf(ss1 * (1.0f / DM) + 1e-6f);
#pragma unroll
    for (int i = 0; i < 8; ++i) {
      const float4 g = g4[lane + 64 * (i & 3)];
      const float rstd = (i < 4) ? rstd0 : rstd1;
      ushort4 o;
      o.x = f2bf(v[i].x * rstd * g.x); o.y = f2bf(v[i].y * rstd * g.y);
      o.z = f2bf(v[i].z * rstd * g.z); o.w = f2bf(v[i].w * rstd * g.w);
      *(ushort4*)(P.hb + (size_t)row * DM + (lane + 64 * i) * 4) = o;
    }
    return;
  }
  it -= PREP_ROW_ITEMS;
  if (it >= PREP_WIN_TILES + PREP_WOUT_TILES) {
    it -= PREP_WIN_TILES + PREP_WOUT_TILES;
    const float* srcm = (it < 64) ? P.decay_up : P.iclr_up;
    bf16_t* dstm = (it < 64) ? P.dut : P.iut;
    const int e = (it & 63) * 512 + tid, chn = e >> 6, k = e & 63;
    dstm[e] = f2bf(srcm[k * 512 + chn]);
    return;
  }
  const float* src; bf16_t* dst; int ncols, kt, nt, scol;
  if (it < PREP_WIN_TILES) {
    src = P.w_in; dst = P.winT; ncols = NIN; kt = it / 68; nt = it % 68;
    const int n0 = nt * 64;
    scol = (n0 < 1664) ? n0 : (n0 < 3200) ? (n0 + 512) : (n0 < 3712) ? (n0 - 1536) : (n0 < 4224) ? n0 : -1;
  } else { it -= PREP_WIN_TILES; src = P.w_out; dst = P.woutT; ncols = DM; kt = it / 16; nt = it % 16; scol = nt * 64; }
#pragma unroll 4
  for (int i = 0; i < 8; ++i) {
    const int r = wv + 8 * i;
    sm[r * 65 + lane] = (scol >= 0) ? src[(size_t)(kt * 64 + r) * ncols + scol + lane] : 0.f;
  }
  __syncthreads();
#pragma unroll 4
  for (int i = 0; i < 8; ++i) {
    const int r = wv + 8 * i;
    dst[(size_t)(nt * 64 + r) * DM + kt * 64 + lane] = f2bf(sm[lane * 65 + r]);
  }
  __syncthreads();
}

namespace pg8 {
constexpr int BM = 256, BK = 64, HALF = 128, HTB = HALF * BK * 2, STAGE_BYTES = 8 * HTB, NXCD = 8, WGM = 8;
__host__ __device__ __forceinline__ int lds_byte(int r, int c) { const int st = (r >> 4) * 2 + (c >> 5), rr = r & 15, cc = c & 31, ob = rr * 64 + cc * 2; return st * 1024 + (ob ^ (((ob >> 9) & 1) << 5)); }
__host__ __device__ __forceinline__ void stage_rc(int b, int& R, int& C) { const int st = b / 1024, sb = b % 1024, swz = sb ^ (((sb >> 9) & 1) << 5); R = (st >> 1) * 16 + swz / 64; C = (st & 1) * 32 + (swz % 64) / 2; }
__host__ __device__ __forceinline__ int perm32(int rho) { const int n = rho >> 4, i = rho & 15; return 8 * (i >> 2) + 4 * n + (i & 3); }
struct Unit { int pm, pn; };
struct Gemm { const bf16_t* A; const bf16_t* Bt; int M, N, K, lda; };
struct StaticOrder {
  int nM, nN, nwg, G, c;
  __host__ __device__ void init(int M, int N, int G_, int c_) { nM = M / BM; nN = N / BM; nwg = nM * nN; G = G_; c = c_; }
  __host__ __device__ bool next(int i, Unit& u) const {
    const long L = (long)i * G + c; if (L >= nwg) return false;
    int wgid = (int)L; { const int q = nwg / NXCD, r = nwg % NXCD, xcd = wgid % NXCD, off = wgid / NXCD; wgid = (xcd < r ? xcd * (q + 1) : r * (q + 1) + (xcd - r) * q) + off; }
    const int nig = WGM * nN, gid = wgid / nig, fm = gid * WGM, gsz = (nM - fm) < WGM ? (nM - fm) : WGM;
    u.pm = fm + ((wgid % nig) % gsz); u.pn = (wgid % nig) / gsz; return true;
  }
};
template <class Epi>
__device__ __forceinline__ void gemm_phase(LAS unsigned char* lds, const Gemm g, const StaticOrder& S, const Epi& E) {
  const int tid = threadIdx.x, wid = __builtin_amdgcn_readfirstlane(tid >> 6), lane = tid & 63, wr = wid >> 2, wc = wid & 3, fr = lane & 15, fq = lane >> 4;
  const int K = g.K, nt = K / BK, lda = g.lda;
  unsigned voffA[2], voffB[2];
#pragma unroll
  for (int i = 0; i < 2; ++i) { int R, C; stage_rc(tid * 16 + i * 8192, R, C); const int Rb = (R & ~31) + perm32(R & 31);
    voffA[i] = (unsigned)(R * lda + C) * 2u; voffB[i] = (unsigned)(Rb * K + C) * 2u; }
  const size_t kstep = (size_t)(BK * 2);
  const size_t hstepA = (size_t)HALF * lda * 2, hstepB = (size_t)HALF * K * 2;
  const size_t tstepA = 2 * hstepA, tstepB = 2 * hstepB;
  const unsigned ldsw = (unsigned)wid * 1024u;
  const int aoff = lds_byte(wr * 64 + fr, fq * 8), boff = lds_byte(wc * 32 + fr, fq * 8);
#define PG8_SA(b, h) (((b) * 2 + (h)) * HTB)
#define PG8_SB(b, h) ((4 + (b) * 2 + (h)) * HTB)
#define PG8_STAGE(bufoff, gbase, voff) do { _Pragma("unroll") for (int _i = 0; _i < 2; ++_i) \
    __builtin_amdgcn_global_load_lds((const unsigned*)((const char*)(gbase) + (voff)[_i]), (LAS unsigned*)(lds + (bufoff) + ldsw + _i * 8192), 16, 0, 0); } while (0)
#define PG8_LDA(dst, b, h) do { _Pragma("unroll") for (int m = 0; m < 4; ++m) _Pragma("unroll") for (int k = 0; k < 2; ++k) dst[m][k] = *(const LAS bf16x8*)(lds + PG8_SA(b, h) + aoff + m * 2048 + k * 1024); } while (0)
#define PG8_LDB(dst, b, h) do { _Pragma("unroll") for (int n = 0; n < 2; ++n) _Pragma("unroll") for (int k = 0; k < 2; ++k) dst[n][k] = *(const LAS bf16x8*)(lds + PG8_SB(b, h) + boff + n * 2048 + k * 1024); } while (0)
#define PG8_MMA(ai, bj, At, Bt) do { __builtin_amdgcn_s_setprio(1); _Pragma("unroll") for (int m = 0; m < 4; ++m) _Pragma("unroll") for (int n = 0; n < 2; ++n) _Pragma("unroll") for (int k = 0; k < 2; ++k) \
    acc[ai][bj][m][n] = __builtin_amdgcn_mfma_f32_16x16x32_bf16(Bt[n][k], At[m][k], acc[ai][bj][m][n], 0, 0, 0); __builtin_amdgcn_s_setprio(0); } while (0)
#define PG8_WAIT_V(n) asm volatile("s_waitcnt vmcnt(" #n ")" ::: "memory")
#define PG8_WAIT_L(n) asm volatile("s_waitcnt lgkmcnt(" #n ")" ::: "memory")
#define PG8_BAR __builtin_amdgcn_s_barrier()
#define PG8_SCHED __builtin_amdgcn_sched_barrier(0)
  Unit cur, nxt; int ui = 0;
  if (!S.next(0, cur)) return;
  f32x4 acc[2][2][4][2];
#pragma unroll
  for (int a = 0; a < 2; ++a)
#pragma unroll
    for (int b = 0; b < 2; ++b)
#pragma unroll
      for (int m = 0; m < 4; ++m)
#pragma unroll
        for (int n = 0; n < 2; ++n) acc[a][b][m][n] = (f32x4){0.f, 0.f, 0.f, 0.f};
  bf16x8 At[4][2], B0[2][2], B1[2][2];
  const char* cA = (const char*)g.A + (size_t)cur.pm * tstepA; const char* cB = (const char*)g.Bt + (size_t)cur.pn * tstepB;
  PG8_STAGE(PG8_SB(0, 0), cB, voffB); PG8_STAGE(PG8_SB(0, 1), cB + hstepB, voffB); PG8_STAGE(PG8_SA(0, 0), cA, voffA); PG8_STAGE(PG8_SA(0, 1), cA + hstepA, voffA);
  if (wr == 1) PG8_BAR;
  PG8_WAIT_V(2); PG8_BAR;
  PG8_STAGE(PG8_SB(1, 0), cB + kstep, voffB); PG8_STAGE(PG8_SA(1, 0), cA + kstep, voffA); PG8_STAGE(PG8_SB(1, 1), cB + hstepB + kstep, voffB);
  PG8_WAIT_V(6); PG8_BAR;
  for (;;) {
    const bool has_next = S.next(ui + 1, nxt);
    const char* nA = has_next ? (const char*)g.A + (size_t)nxt.pm * tstepA : cA; const char* nB = has_next ? (const char*)g.Bt + (size_t)nxt.pn * tstepB : cB;
    for (int t = 0; t < nt; t += 2) {
      const bool last = (t == nt - 2);
      const char* a1 = cA + (size_t)(t + 1) * kstep;
      const char* a2 = last ? nA : cA + (size_t)(t + 2) * kstep; const char* b2 = last ? nB : cB + (size_t)(t + 2) * kstep;
      const char* a3 = a2 + kstep; const char* b3 = b2 + kstep;
      PG8_LDB(B0, 0, 0); PG8_LDB(B1, 0, 1); PG8_SCHED; PG8_LDA(At, 0, 0); PG8_STAGE(PG8_SA(1, 1), a1 + hstepA, voffA);
      PG8_WAIT_V(8); PG8_WAIT_L(0); PG8_BAR; PG8_MMA(0, 0, At, B0); PG8_MMA(0, 1, At, B1); PG8_BAR; PG8_SCHED;
      PG8_LDA(At, 0, 1); PG8_STAGE(PG8_SB(0, 0), b2, voffB); PG8_STAGE(PG8_SB(0, 1), b2 + hstepB, voffB); PG8_STAGE(PG8_SA(0, 0), a2, voffA);
      PG8_WAIT_V(8); PG8_WAIT_L(0); PG8_BAR; PG8_MMA(1, 0, At, B0); PG8_MMA(1, 1, At, B1); PG8_BAR; PG8_SCHED;
      PG8_LDB(B0, 1, 0); PG8_LDB(B1, 1, 1); PG8_SCHED; PG8_LDA(At, 1, 0); PG8_STAGE(PG8_SA(0, 1), a2 + hstepA, voffA);
      PG8_WAIT_V(8); PG8_WAIT_L(0); PG8_BAR; PG8_MMA(0, 0, At, B0); PG8_MMA(0, 1, At, B1); PG8_BAR; PG8_SCHED;
      PG8_LDA(At, 1, 1); PG8_STAGE(PG8_SB(1, 0), b3, voffB); PG8_STAGE(PG8_SB(1, 1), b3 + hstepB, voffB); PG8_STAGE(PG8_SA(1, 0), a3, voffA);
      PG8_WAIT_V(8); PG8_WAIT_L(0); PG8_BAR; PG8_MMA(1, 0, At, B0); PG8_MMA(1, 1, At, B1); PG8_BAR; PG8_SCHED;
    }
    if (wr == 0) PG8_BAR;
    E(acc, cur, wr, wc, fr, fq);
    if (!has_next) break;
#pragma unroll
    for (int a = 0; a < 2; ++a)
#pragma unroll
      for (int b = 0; b < 2; ++b)
#pragma unroll
        for (int m = 0; m < 4; ++m)
#pragma unroll
          for (int n = 0; n < 2; ++n) acc[a][b][m][n] = (f32x4){0.f, 0.f, 0.f, 0.f};
    cur = nxt; cA = nA; cB = nB; ++ui;
    if (wr == 1) PG8_BAR;
  }
  PG8_WAIT_V(0);
  PG8_BAR;
#undef PG8_SA
#undef PG8_SB
#undef PG8_STAGE
#undef PG8_LDA
#undef PG8_LDB
#undef PG8_MMA
#undef PG8_WAIT_V
#undef PG8_WAIT_L
#undef PG8_BAR
#undef PG8_SCHED
}
}

struct EpiProj {
  bf16_t* p;
  __device__ __forceinline__ void operator()(const f32x4 (&acc)[2][2][4][2], const pg8::Unit& u, int wr, int wc, int fr, int fq) const {
    const float inv[8] = {1.0f, 0.1939227432012558f, 0.03760603070259094f, 0.007292664609849453f, 0.0014142135623842478f, 0.00027424818836152554f, 5.3182957344688475e-05f, 1.0313385246263351e-05f};
#pragma unroll
    for (int bj = 0; bj < 2; ++bj) {
      const int wcol = u.pn * 256 + bj * 128 + wc * 32;
      if (wcol >= NIN) continue;
      const int col0 = wcol + 8 * fq;
      const bool wrope = (wcol >= OFF_Q) && (wcol < OFF_VB) && ((wcol & 63) == 0);
#pragma unroll
      for (int ai = 0; ai < 2; ++ai)
#pragma unroll
        for (int m = 0; m < 4; ++m) {
          const int row = u.pm * 256 + ai * 128 + wr * 64 + m * 16 + fr;
          float v[8];
#pragma unroll
          for (int e = 0; e < 4; ++e) { v[e] = acc[ai][bj][m][0][e]; v[4 + e] = acc[ai][bj][m][1][e]; }
          if (wrope) {
            const float pos = (float)(row & (SEQ - 1));
#pragma unroll
            for (int e = 0; e < 8; ++e) {
              const float other = __shfl_xor(v[e], 16);
              float rev = pos * inv[e] * 0.15915494309189535f;
              rev = (rev - rintf(rev)) * 6.283185307179586f;
              const float sn = __sinf(rev), cs = __cosf(rev);
              const float r0 = v[e] * cs - other * sn, r1 = other * sn + v[e] * cs;
              v[e] = (fq == 0) ? r0 : (fq == 1) ? r1 : v[e];
            }
          }
          u32x4 w;
          w.x = pk_bf16(v[0], v[1]); w.y = pk_bf16(v[2], v[3]); w.z = pk_bf16(v[4], v[5]); w.w = pk_bf16(v[6], v[7]);
          __builtin_nontemporal_store(w, (u32x4*)(p + (size_t)row * NIN + col0));
        }
    }
  }
};
struct EpiOut {
  const float* x; bf16_t* ybf;
  __device__ __forceinline__ void operator()(const f32x4 (&acc)[2][2][4][2], const pg8::Unit& u, int wr, int wc, int fr, int fq) const {
#pragma unroll
    for (int bj = 0; bj < 2; ++bj) {
      const int col0 = u.pn * 256 + bj * 128 + wc * 32 + 8 * fq;
#pragma unroll
      for (int ai = 0; ai < 2; ++ai)
#pragma unroll
        for (int m = 0; m < 4; ++m) {
          const int row = u.pm * 256 + ai * 128 + wr * 64 + m * 16 + fr;
          const size_t idx = (size_t)row * DM + col0;
          const f32x4 a0 = ldf_nt(x + idx) + acc[ai][bj][m][0], a1 = ldf_nt(x + idx + 4) + acc[ai][bj][m][1];
          u32x4 w; w.x = pk_bf16(a0[0], a0[1]); w.y = pk_bf16(a0[2], a0[3]); w.z = pk_bf16(a1[0], a1[1]); w.w = pk_bf16(a1[2], a1[3]);
          *(u32x4*)(ybf + idx) = w;
        }
    }
  }
};

constexpr int REC_BYTES = 12672, REC_M1 = 0, REC_R = 1024, REC_BK = 2048, REC_TA = 4096, REC_AR = 4608, REC_VB = 5120;
constexpr int REC_WC_B = 12288, REC_RKB_B = 12544;
constexpr int RPREP_ITEMS = 64 * 256;
constexpr int LS = 68;
__device__ __forceinline__ bf16x8 cvt8(const float* p) {
  const float4 a = *(const float4*)p, b = *(const float4*)(p + 4);
  u32x4 r; r.x = pk_bf16(a.x, a.y); r.y = pk_bf16(a.z, a.w); r.z = pk_bf16(b.x, b.y); r.w = pk_bf16(b.z, b.w);
  return as_frag(r);
}
__device__ __forceinline__ float fast_tanh(float x) { return 1.f - 2.f * __builtin_amdgcn_rcpf(1.f + __expf(2.f * x)); }
__device__ void rwkv_prep_block(const Params& P, int vb, float* sm, const int tid, const int half) {
  const int bh = vb >> 2, b = bh >> 3, h = bh & 7;
  const int lane = tid & 63, tt = tid >> 6, g = lane >> 4, i = lane & 15;
  float* s_r = sm;             float* s_k = sm + 1088;      float* s_at = sm + 2 * 1088;  float* s_bt = sm + 3 * 1088;
  float* s_lw = sm + 4 * 1088; float* s_an = sm + 5 * 1088; float* s_b = sm + 6 * 1088;   float* s_kt = sm + 7 * 1088;
  float* s_rt = sm + 8 * 1088; float* s_Aab = sm + 9 * 1088; float* s_Aak = s_Aab + 272;
  float* s_xw = s_at; float* s_xa = s_bt;
  bf16_t* s_twb = (bf16_t*)(sm + 9 * 1088 + 544);
  bf16_t* s_pab = s_twb + 16 * 72;
  bf16_t* rec = (bf16_t*)(sm + 9 * 1088 + 544 + 1152);
  bf16_t* s_raw = (bf16_t*)s_lw;
  const int c = h * 64 + lane;
  const float mix_r = P.shift_mix[OFF_R + c], mix_k = P.shift_mix[OFF_K + c], mix_v = P.shift_mix[OFF_V + c];
  const float mix_w = P.shift_mix[OFF_WLO + lane], mix_a = P.shift_mix[OFF_ALO + lane];
  const float dbase = P.decay_base[c], ibase = P.iclr_base[c], kns = P.key_norm_scale[c], kim = P.key_iclr_mix[c], bon = P.bonus[c];
  const bf16_t* dup = P.dut + (size_t)(h * 64 + 16 * tt + i) * 64 + 8 * g;
  const bf16_t* iup = P.iut + (size_t)(h * 64 + 16 * tt + i) * 64 + 8 * g;
  const bf16x8 bd0 = *(const bf16x8*)dup, bd1 = *(const bf16x8*)(dup + 32), bi0 = *(const bf16x8*)iup, bi1 = *(const bf16x8*)(iup + 32);
  int prow[3], pcol[3], plds[3];
#pragma unroll
  for (int u = 0; u < 3; ++u) {
    const int idx = tid + 256 * u, rr = idx / 40, q = idx - rr * 40, cg = q >> 3, sub = q & 7;
    prow[u] = (idx < 680) ? rr : -100000;
    pcol[u] = ((cg < 3) ? (cg * 512 + h * 64) : (cg == 3 ? OFF_WLO : OFF_ALO)) + sub * 8;
    plds[u] = rr * 328 + cg * 64 + sub * 8;
  }
  const bf16_t* pb = P.p + (size_t)(b * SEQ) * NIN;
  uint4 pre[3];
#define RP_PREFETCH(chunk) do { _Pragma("unroll") for (int u = 0; u < 3; ++u) { const int t_ = (chunk) * 16 - 1 + prow[u]; \
    pre[u] = (t_ >= 0) ? *(const uint4*)(pb + (size_t)t_ * NIN + pcol[u]) : make_uint4(0u, 0u, 0u, 0u); } } while (0)
  const int cbase = (vb & 3) * 64 + half;
  RP_PREFETCH(cbase);
#pragma unroll
  for (int u = 0; u < 3; ++u) if (prow[u] >= 0) *(uint4*)(s_raw + plds[u]) = pre[u];
  __syncthreads();
  for (int kk2 = 0; kk2 < 32; ++kk2) {
  const int ch = cbase + 2 * kk2;
  const int item = bh * 256 + ch;
  char* recb = P.rec + (size_t)item * REC_BYTES;
  if (kk2 + 1 < 32) RP_PREFETCH(ch + 2);
  {
#pragma unroll
    for (int q = 0; q < 4; ++q) {
      const int tl = tt + 4 * q;
      const bf16_t* row = s_raw + (tl + 1) * 328;
      const bf16_t* prw = s_raw + tl * 328;
      const float cr = bf2f(row[lane]), ck = bf2f(row[64 + lane]), cv = bf2f(row[128 + lane]), cw = bf2f(row[192 + lane]), ca = bf2f(row[256 + lane]);
      const float pr = bf2f(prw[lane]), pk = bf2f(prw[64 + lane]), pv = bf2f(prw[128 + lane]), pw = bf2f(prw[192 + lane]), pa = bf2f(prw[256 + lane]);
      s_r[tl * LS + lane] = cr + (pr - cr) * mix_r;
      s_k[tl * LS + lane] = ck + (pk - ck) * mix_k;
      s_twb[tl * 72 + lane] = f2bf(fast_tanh(cw + (pw - cw) * mix_w));
      s_pab[tl * 72 + lane] = f2bf(ca + (pa - ca) * mix_a);
      const float vv = cv + (pv - cv) * mix_v;
      rec[REC_VB + (lane >> 4) * 256 + (16 * (tl >> 2) + (lane & 15)) * 4 + (tl & 3)] = f2bf(vv);
    }
  }
  __syncthreads();
  {
    const bf16x8 aw0 = *(const bf16x8*)(s_twb + i * 72 + 8 * g), aw1 = *(const bf16x8*)(s_twb + i * 72 + 32 + 8 * g);
    const bf16x8 aa0 = *(const bf16x8*)(s_pab + i * 72 + 8 * g), aa1 = *(const bf16x8*)(s_pab + i * 72 + 32 + 8 * g);
    f32x4 xw = (f32x4){0.f, 0.f, 0.f, 0.f}, xa = (f32x4){0.f, 0.f, 0.f, 0.f};
    xw = __builtin_amdgcn_mfma_f32_16x16x32_bf16(aw0, bd0, xw, 0, 0, 0);
    xw = __builtin_amdgcn_mfma_f32_16x16x32_bf16(aw1, bd1, xw, 0, 0, 0);
    xa = __builtin_amdgcn_mfma_f32_16x16x32_bf16(aa0, bi0, xa, 0, 0, 0);
    xa = __builtin_amdgcn_mfma_f32_16x16x32_bf16(aa1, bi1, xa, 0, 0, 0);
#pragma unroll
    for (int j = 0; j < 4; ++j) {
      s_xw[(4 * g + j) * LS + 16 * tt + i] = xw[j];
      s_xa[(4 * g + j) * LS + 16 * tt + i] = xa[j];
    }
  }
  __syncthreads();
  {
#pragma unroll
    for (int q = 0; q < 4; ++q) {
      const int tl = tt + 4 * q;
      const float z = -(dbase + s_xw[tl * LS + lane]);
      const float sp = fmaxf(z, 0.f) + __logf(1.f + __expf(-fabsf(z)));
      const float lwv = -__expf(-sp - 0.5f);
      const float a = 1.f / (1.f + __expf(-(ibase + s_xa[tl * LS + lane])));
      const float pk = s_k[tl * LS + lane];
      const float kkr = pk * kns;
      const float ss = wave_sum(kkr * kkr);
      const float kk = kkr * rsqrtf(fmaxf(ss, 1e-24f));
      const float kmod = pk * (1.f + (a - 1.f) * kim);
      s_lw[tl * LS + lane] = lwv;
      s_k[tl * LS + lane] = kmod;
      s_an[tl * LS + lane] = -kk;
      s_b[tl * LS + lane] = kk * a;
      const float rk = wave_sum(s_r[tl * LS + lane] * kmod * bon);
      if (lane == 0) ((float*)(recb + REC_RKB_B))[tl] = rk;
    }
  }
  __syncthreads();
  {
    float run = 0.f, LWp[4], LW[4];
#pragma unroll
    for (int s2 = 0; s2 < 16; ++s2) {
      const float x = s_lw[s2 * LS + lane];
      if ((s2 & 3) == tt) { LWp[s2 >> 2] = run; LW[s2 >> 2] = run + x; }
      run += x;
    }
    const float LWC = run;
    if (tt == 0) ((float*)(recb + REC_WC_B))[lane] = __expf(LWC);
#pragma unroll
    for (int q = 0; q < 4; ++q) {
      const int tl = tt + 4 * q;
      const float e_p = __expf(LWp[q]), e_n = __expf(-LW[q]), e_r = __expf(LW[q]), e_c = __expf(LWC - LW[q]);
      const float an = s_an[tl * LS + lane], bb = s_b[tl * LS + lane], kmod = s_k[tl * LS + lane], rr = s_r[tl * LS + lane];
      s_at[tl * LS + lane] = an * e_p;
      s_bt[tl * LS + lane] = bb * e_n;
      s_kt[tl * LS + lane] = kmod * e_n;
      const float rt = rr * e_r;
      s_rt[tl * LS + lane] = rt;
      const int bkaddr = REC_BK + (lane >> 4) * 512 + (16 * (tl >> 2) + (lane & 15)) * 8 + (tl & 3);
      rec[bkaddr] = f2bf(bb * e_c);
      rec[bkaddr + 4] = f2bf(kmod * e_c);
      const int k5 = lane & 31;
      rec[REC_R + (lane >> 5) * 512 + (16 * ((k5 & 15) >> 2) + tl) * 8 + (k5 & 3) + 4 * (k5 >> 4)] = f2bf(rt);
    }
  }
  __syncthreads();
  {
    const float* X = (tt < 2) ? s_at : s_rt;
    const float* Y = (tt & 1) ? s_kt : s_bt;
    const bf16x8 a0 = cvt8(X + i * LS + 8 * g), a1 = cvt8(X + i * LS + 32 + 8 * g);
    const bf16x8 b0 = cvt8(Y + i * LS + 8 * g), b1 = cvt8(Y + i * LS + 32 + 8 * g);
    f32x4 acc = (f32x4){0.f, 0.f, 0.f, 0.f};
    acc = __builtin_amdgcn_mfma_f32_16x16x32_bf16(a0, b0, acc, 0, 0, 0);
    acc = __builtin_amdgcn_mfma_f32_16x16x32_bf16(a1, b1, acc, 0, 0, 0);
#pragma unroll
    for (int j = 0; j < 4; ++j) {
      const int t = 4 * g + j, s2 = i;
      const bool keep = (tt < 2) ? (s2 < t) : (s2 <= t);
      const float val = keep ? acc[j] : 0.f;
      if (tt == 0) s_Aab[t * 17 + s2] = val;
      else if (tt == 1) s_Aak[t * 17 + s2] = val;
      else rec[REC_AR + (16 * (s2 >> 2) + t) * 8 + (s2 & 3) + 4 * (tt & 1)] = f2bf(val);
    }
  }
  __syncthreads();
  if (tid < 80) {
    float X[16];
#pragma unroll
    for (int t = 0; t < 16; ++t) {
      float val = (tid < 64) ? s_at[t * LS + tid] : s_Aak[t * 17 + (tid - 64)];
#pragma unroll
      for (int s2 = 0; s2 < t; ++s2) val += s_Aab[t * 17 + s2] * X[s2];
      X[t] = val;
    }
    if (tid < 64) {
      const int k5 = tid & 31;
      const int base = REC_M1 + (tid >> 5) * 512 + (16 * ((k5 & 15) >> 2)) * 8 + (k5 & 3) + 4 * (k5 >> 4);
#pragma unroll
      for (int t = 0; t < 16; ++t) rec[base + t * 8] = f2bf(X[t]);
    } else {
      const int s2 = tid - 64;
      const int base = REC_TA + (16 * (s2 >> 2)) * 8 + (s2 & 3);
#pragma unroll
      for (int t = 0; t < 16; ++t) { rec[base + t * 8] = f2bf(X[t]); rec[base + t * 8 + 4] = 0; }
    }
  }
  __syncthreads();
  {
    const uint4* srcv = (const uint4*)rec;
    uint4* dstv = (uint4*)recb;
#pragma unroll
    for (int u = 0; u < 3; ++u) dstv[tid + 256 * u] = srcv[tid + 256 * u];
  }
#pragma unroll
  for (int u = 0; u < 3; ++u) if (prow[u] >= 0) *(uint4*)(s_raw + plds[u]) = pre[u];
  __syncthreads();
  }
#undef RP_PREFETCH
}


#define WAVE_FENCE() do { __builtin_amdgcn_wave_barrier(); asm volatile("s_waitcnt lgkmcnt(0)" ::: "memory"); __builtin_amdgcn_wave_barrier(); } while (0)
__device__ void rwkv_prep_waves(const Params& P, int vb, unsigned char* ldsb) {
  const int tid = threadIdx.x, lane = tid & 63, w = tid >> 6, g = lane >> 4, i = lane & 15;
  const int bh = vb >> 2, b = bh >> 3, h = bh & 7;
  bf16_t* s_du = (bf16_t*)ldsb;
  bf16_t* s_iu = s_du + 64 * 72;
  __syncthreads();
  {
    const int row = tid >> 3, pc = tid & 7;
    *(uint4*)(s_du + row * 72 + pc * 8) = *(const uint4*)(P.dut + (size_t)(h * 64 + row) * 64 + pc * 8);
    *(uint4*)(s_iu + row * 72 + pc * 8) = *(const uint4*)(P.iut + (size_t)(h * 64 + row) * 64 + pc * 8);
  }
  __syncthreads();
  unsigned char* wb = ldsb + 18432 + w * 16384;
  bf16_t* s_twb = (bf16_t*)wb;              bf16_t* s_pab = s_twb + 16 * 72;
  float* s_xw = (float*)(wb + 4608);        float* s_xa = s_xw + 16 * 68;
  bf16_t* im_a = (bf16_t*)(wb + 4608);      bf16_t* im_b = im_a + 1152; bf16_t* im_k = im_b + 1152; bf16_t* im_r = im_k + 1152;
  bf16_t* im_m1 = (bf16_t*)wb;              bf16_t* arim = (bf16_t*)(wb + 2304); bf16_t* taim = (bf16_t*)(wb + 3328);
  float* s_Aab = (float*)(wb + 14208);      float* s_Aak = s_Aab + 272;
  const int c = h * 64 + lane;
  const float mix_r = P.shift_mix[OFF_R + c], mix_k = P.shift_mix[OFF_K + c], mix_v = P.shift_mix[OFF_V + c];
  const float mix_w = P.shift_mix[OFF_WLO + lane], mix_a = P.shift_mix[OFF_ALO + lane];
  const float dbase = P.decay_base[c], ibase = P.iclr_base[c], kns = P.key_norm_scale[c], kim = P.key_iclr_mix[c], bon = P.bonus[c];
  const bf16_t* pb = P.p + (size_t)(b * SEQ) * NIN;
  bf16_t* rawb = (bf16_t*)(wb + 4608);
  u32x4 pre[11];
#define RAWP_LOAD(chn) do { int lane_o = lane; asm volatile("" : "+v"(lane_o)); _Pragma("unroll") for (int u = 0; u < 11; ++u) { int q_ = lane_o + 64 * u; q_ = (q_ < 680) ? q_ : 679; \
    const int rr_ = q_ / 40, qq_ = q_ - rr_ * 40, cg_ = qq_ >> 3, sub_ = qq_ & 7; int t_ = (chn) * 16 - 1 + rr_; t_ = (t_ < 0) ? 0 : t_; \
    const int col_ = ((cg_ < 3) ? (cg_ * 512 + h * 64) : (cg_ == 3 ? OFF_WLO : OFF_ALO)) + sub_ * 8; \
    pre[u] = ld_nt(pb + (size_t)t_ * NIN + col_); } } while (0)
  RAWP_LOAD((vb & 3) * 64 + w);
  for (int k8 = 0; k8 < 8; ++k8) {
    const int ch = (vb & 3) * 64 + w + 8 * k8;
    const int t0 = ch * 16;
    char* recb = P.rec + (size_t)(bh * 256 + ch) * REC_BYTES;
    float r[16], an[16], bb[16], km[16], LW[16];
    int lane_o2 = lane; asm volatile("" : "+v"(lane_o2));
#pragma unroll
    for (int u = 0; u < 11; ++u) {
      const int q = lane_o2 + 64 * u, rr = q / 40, qq = q - rr * 40, cg = qq >> 3, sub = qq & 7;
      u32x4 val = pre[u];
      if (t0 == 0 && rr == 0) val = (u32x4){0u, 0u, 0u, 0u};
      if (q < 680) *(u32x4*)(rawb + rr * 328 + cg * 64 + sub * 8) = val;
    }
    WAVE_FENCE();
    {
      float pr = bf2f(rawb[lane]), pk = bf2f(rawb[64 + lane]), pv = bf2f(rawb[128 + lane]), pw = bf2f(rawb[192 + lane]), pa = bf2f(rawb[256 + lane]);
      float vv[16];
#pragma unroll
      for (int t = 0; t < 16; ++t) {
        const bf16_t* row = rawb + (t + 1) * 328;
        const float cr = bf2f(row[lane]), ck = bf2f(row[64 + lane]), cv = bf2f(row[128 + lane]), cw = bf2f(row[192 + lane]), ca = bf2f(row[256 + lane]);
        r[t] = cr + (pr - cr) * mix_r;
        km[t] = ck + (pk - ck) * mix_k;
        vv[t] = cv + (pv - cv) * mix_v;
        s_twb[t * 72 + lane] = f2bf(fast_tanh(cw + (pw - cw) * mix_w));
        s_pab[t * 72 + lane] = f2bf(ca + (pa - ca) * mix_a);
        pr = cr; pk = ck; pv = cv; pw = cw; pa = ca;
      }
#pragma unroll
      for (int g2 = 0; g2 < 4; ++g2) {
        typedef unsigned u32x2_t __attribute__((ext_vector_type(2)));
        u32x2_t o; o.x = pk_bf16(vv[4 * g2], vv[4 * g2 + 1]); o.y = pk_bf16(vv[4 * g2 + 2], vv[4 * g2 + 3]);
        *(u32x2_t*)(recb + 10240 + (lane >> 4) * 512 + (16 * g2 + (lane & 15)) * 8) = o;
      }
    }
    WAVE_FENCE();
    {
      const bf16x8 aw0 = *(const bf16x8*)(s_twb + i * 72 + 8 * g), aw1 = *(const bf16x8*)(s_twb + i * 72 + 32 + 8 * g);
      const bf16x8 aa0 = *(const bf16x8*)(s_pab + i * 72 + 8 * g), aa1 = *(const bf16x8*)(s_pab + i * 72 + 32 + 8 * g);
#pragma unroll
      for (int nt = 0; nt < 4; ++nt) {
        const bf16x8 bd0 = *(const bf16x8*)(s_du + (16 * nt + i) * 72 + 8 * g), bd1 = *(const bf16x8*)(s_du + (16 * nt + i) * 72 + 32 + 8 * g);
        const bf16x8 bi0 = *(const bf16x8*)(s_iu + (16 * nt + i) * 72 + 8 * g), bi1 = *(const bf16x8*)(s_iu + (16 * nt + i) * 72 + 32 + 8 * g);
        f32x4 xw = (f32x4){0.f, 0.f, 0.f, 0.f}, xa = (f32x4){0.f, 0.f, 0.f, 0.f};
        xw = __builtin_amdgcn_mfma_f32_16x16x32_bf16(aw0, bd0, xw, 0, 0, 0);
        xw = __builtin_amdgcn_mfma_f32_16x16x32_bf16(aw1, bd1, xw, 0, 0, 0);
        xa = __builtin_amdgcn_mfma_f32_16x16x32_bf16(aa0, bi0, xa, 0, 0, 0);
        xa = __builtin_amdgcn_mfma_f32_16x16x32_bf16(aa1, bi1, xa, 0, 0, 0);
#pragma unroll
        for (int j = 0; j < 4; ++j) {
          s_xw[(4 * g + j) * 68 + 16 * nt + i] = xw[j];
          s_xa[(4 * g + j) * 68 + 16 * nt + i] = xa[j];
        }
      }
    }
    WAVE_FENCE();
    {
      float run = 0.f, myrk = 0.f;
#pragma unroll
      for (int t = 0; t < 16; ++t) {
        const float z = -(dbase + s_xw[t * 68 + lane]);
        const float sp = fmaxf(z, 0.f) + __logf(1.f + __expf(-fabsf(z)));
        const float lwv = -__expf(-sp - 0.5f);
        const float a = __builtin_amdgcn_rcpf(1.f + __expf(-(ibase + s_xa[t * 68 + lane])));
        const float pk = km[t];
        const float kkr = pk * kns;
        const float ss = wave_sum(kkr * kkr);
        const float kk = kkr * rsqrtf(fmaxf(ss, 1e-24f));
        const float kmod = pk * (1.f + (a - 1.f) * kim);
        km[t] = kmod; an[t] = -kk; bb[t] = kk * a;
        run += lwv; LW[t] = run;
        const float rk = wave_sum(r[t] * kmod * bon);
        if (lane == t) myrk = rk;
        if ((t & 7) == 7) __builtin_amdgcn_sched_barrier(0);
      }
      if (lane < 16) ((float*)(recb + REC_RKB_B))[lane] = myrk;
    }
    WAVE_FENCE();
    {
      const float LWC = LW[15];
      ((float*)(recb + REC_WC_B))[lane] = __expf(LWC);
#pragma unroll
      for (int g2 = 0; g2 < 4; ++g2) {
        float Bp[4], Kp[4];
#pragma unroll
        for (int j = 0; j < 4; ++j) {
          const int t = 4 * g2 + j;
          const float lwp = (t == 0) ? 0.f : LW[t - 1];
          const float e_p = __expf(lwp), e_n = __expf(-LW[t]), e_r = __expf(LW[t]), e_c = __expf(LWC - LW[t]);
          const float at = an[t] * e_p;
          an[t] = at;
          im_a[t * 72 + lane] = f2bf(at);
          im_b[t * 72 + lane] = f2bf(bb[t] * e_n);
          im_k[t * 72 + lane] = f2bf(km[t] * e_n);
          im_r[t * 72 + lane] = f2bf(r[t] * e_r);
          Bp[j] = bb[t] * e_c; Kp[j] = km[t] * e_c;
        }
        u32x4 o; o.x = pk_bf16(Bp[0], Bp[1]); o.y = pk_bf16(Bp[2], Bp[3]); o.z = pk_bf16(Kp[0], Kp[1]); o.w = pk_bf16(Kp[2], Kp[3]);
        *(u32x4*)(recb + 4096 + (lane >> 4) * 1024 + (16 * g2 + (lane & 15)) * 16) = o;
      }
    }
    WAVE_FENCE();
    { const int chn = (k8 < 7) ? ch + 8 : ch; RAWP_LOAD(chn); }
    float abm0, abm1, abm2, abm3;
    {
      const bf16x8 fa0 = *(const bf16x8*)(im_a + i * 72 + 8 * g), fa1 = *(const bf16x8*)(im_a + i * 72 + 32 + 8 * g);
      const bf16x8 fr0 = *(const bf16x8*)(im_r + i * 72 + 8 * g), fr1 = *(const bf16x8*)(im_r + i * 72 + 32 + 8 * g);
      const bf16x8 fb0 = *(const bf16x8*)(im_b + i * 72 + 8 * g), fb1 = *(const bf16x8*)(im_b + i * 72 + 32 + 8 * g);
      const bf16x8 fk0 = *(const bf16x8*)(im_k + i * 72 + 8 * g), fk1 = *(const bf16x8*)(im_k + i * 72 + 32 + 8 * g);
      const f32x4 z4 = (f32x4){0.f, 0.f, 0.f, 0.f};
      f32x4 ab = __builtin_amdgcn_mfma_f32_16x16x32_bf16(fa0, fb0, z4, 0, 0, 0); ab = __builtin_amdgcn_mfma_f32_16x16x32_bf16(fa1, fb1, ab, 0, 0, 0);
      f32x4 ak = __builtin_amdgcn_mfma_f32_16x16x32_bf16(fa0, fk0, z4, 0, 0, 0); ak = __builtin_amdgcn_mfma_f32_16x16x32_bf16(fa1, fk1, ak, 0, 0, 0);
      f32x4 rb = __builtin_amdgcn_mfma_f32_16x16x32_bf16(fr0, fb0, z4, 0, 0, 0); rb = __builtin_amdgcn_mfma_f32_16x16x32_bf16(fr1, fb1, rb, 0, 0, 0);
      f32x4 rk = __builtin_amdgcn_mfma_f32_16x16x32_bf16(fr0, fk0, z4, 0, 0, 0); rk = __builtin_amdgcn_mfma_f32_16x16x32_bf16(fr1, fk1, rk, 0, 0, 0);
      abm0 = (i < 4 * g + 0) ? ab[0] : 0.f; abm1 = (i < 4 * g + 1) ? ab[1] : 0.f;
      abm2 = (i < 4 * g + 2) ? ab[2] : 0.f; abm3 = (i < 4 * g + 3) ? ab[3] : 0.f;
#pragma unroll
      for (int j = 0; j < 4; ++j) {
        const int t = 4 * g + j, s2 = i;
        s_Aak[t * 17 + s2] = (s2 < t) ? ak[j] : 0.f;
        const int ara = (16 * (s2 >> 2) + t) * 8 + (s2 & 3);
        arim[ara] = f2bf((s2 <= t) ? rb[j] : 0.f);
        arim[ara + 4] = f2bf((s2 <= t) ? rk[j] : 0.f);
      }
    }
    WAVE_FENCE();
    {
      float X[16], Y[16];
      const int sc = lane & 15;
#pragma unroll
      for (int t = 0; t < 16; ++t) {
        float v1 = an[t], v2 = s_Aak[t * 17 + sc];
        const float arow = ((t & 3) == 0) ? abm0 : ((t & 3) == 1) ? abm1 : ((t & 3) == 2) ? abm2 : abm3;
#pragma unroll
        for (int s2 = 0; s2 < t; ++s2) {
          const float cf = __builtin_bit_cast(float, __builtin_amdgcn_readlane(__builtin_bit_cast(int, arow), 16 * (t >> 2) + s2));
          v1 += cf * X[s2]; v2 += cf * Y[s2];
        }
        X[t] = v1; Y[t] = v2;
        im_m1[t * 72 + lane] = f2bf(v1);
        if (lane < 16) { const int ta = (16 * (sc >> 2) + t) * 8 + (sc & 3); taim[ta] = f2bf(v2); taim[ta + 4] = 0; }
        __builtin_amdgcn_sched_barrier(0);
      }
    }
    WAVE_FENCE();
    {
      typedef unsigned u32x2_t __attribute__((ext_vector_type(2)));
#pragma unroll
      for (int ks = 0; ks < 2; ++ks) {
        const u32x2_t ml = *(const u32x2_t*)(im_m1 + i * 72 + 32 * ks + 4 * g), mh = *(const u32x2_t*)(im_m1 + i * 72 + 32 * ks + 16 + 4 * g);
        const u32x2_t rl = *(const u32x2_t*)(im_r + i * 72 + 32 * ks + 4 * g), rh = *(const u32x2_t*)(im_r + i * 72 + 32 * ks + 16 + 4 * g);
        u32x4 mo; mo.x = ml.x; mo.y = ml.y; mo.z = mh.x; mo.w = mh.y;
        u32x4 ro; ro.x = rl.x; ro.y = rl.y; ro.z = rh.x; ro.w = rh.y;
        *(u32x4*)(recb + ks * 1024 + lane * 16) = mo;
        *(u32x4*)(recb + 2048 + ks * 1024 + lane * 16) = ro;
      }
      *(u32x4*)(recb + 8192 + lane * 16) = *(const u32x4*)(taim + lane * 8);
      *(u32x4*)(recb + 9216 + lane * 16) = *(const u32x4*)(arim + lane * 8);
    }
    WAVE_FENCE();
  }
#undef RAWP_LOAD
}

constexpr int SCAN_SLOT = 13312, SCAN_D = 10;
__device__ void rwkv_scan_block(const Params& P, int bh, LAS unsigned char* lds) {
  const int tid = threadIdx.x, wave = __builtin_amdgcn_readfirstlane(tid >> 6), lane = tid & 63;
  const char* rec0 = P.rec + (size_t)(bh * 256) * REC_BYTES;
  if (wave >= 2) {
    const int lw = wave - 2;
    const char* src0 = rec0 + lw * 2048 + lane * 16;
#define SCAN_ISSUE(chsrc, slot) do { const char* src_ = src0 + (size_t)(chsrc) * REC_BYTES; LAS unsigned char* dst_ = lds + (slot) * SCAN_SLOT + lw * 2048; \
    _Pragma("unroll") for (int u_ = 0; u_ < 2; ++u_) __builtin_amdgcn_global_load_lds((const unsigned*)(src_ + u_ * 1024), (LAS unsigned*)(dst_ + u_ * 1024), 16, 0, 2); \
    if (lw == 0) __builtin_amdgcn_global_load_lds((const unsigned*)(src_ + 12288), (LAS unsigned*)(dst_ + 12288), 16, 0, 2); } while (0)
#define SCAN_WAITBAR() do { if (lw == 0) asm volatile("s_waitcnt vmcnt(21)\n\ts_barrier" ::: "memory"); else asm volatile("s_waitcnt vmcnt(14)\n\ts_barrier" ::: "memory"); } while (0)
#pragma unroll
    for (int c0 = 0; c0 < SCAN_D - 1; ++c0) SCAN_ISSUE(c0, c0);
    SCAN_WAITBAR();
    int slot = SCAN_D - 1;
    for (int ch = 0; ch < 256; ++ch) {
      const int nx = ch + SCAN_D - 1;
      SCAN_ISSUE((nx < 256 ? nx : 255), slot);
      slot = (slot == SCAN_D - 1) ? 0 : slot + 1;
      SCAN_WAITBAR();
    }
    asm volatile("s_waitcnt vmcnt(0)" ::: "memory");
#undef SCAN_ISSUE
#undef SCAN_WAITBAR
  } else {
    const int b = bh >> 3, h = bh & 7, cw = wave, g = lane >> 4, i = lane & 15;
    f32x4 sa[4], sbt[4];
#pragma unroll
    for (int kt = 0; kt < 4; ++kt) { sa[kt] = (f32x4){0.f, 0.f, 0.f, 0.f}; sbt[kt] = (f32x4){0.f, 0.f, 0.f, 0.f}; }
    const f32x4 zero4 = (f32x4){0.f, 0.f, 0.f, 0.f};
    typedef unsigned u32x2_t __attribute__((ext_vector_type(2)));
    struct Fr { u32x4 m1f0, m1f1, rf0, rf1, bk0, bk1, bk2, bk3, taf, arf; u32x2_t va, vb2; f32x4 wc0, wc1, wc2, wc3; };
#define SCAN_FR(F, slotv) do { const LAS unsigned char* sl_ = lds + (slotv) * SCAN_SLOT; const LAS u32x4* fr_ = (const LAS u32x4*)sl_; \
      F.m1f0 = fr_[lane]; F.m1f1 = fr_[64 + lane]; F.rf0 = fr_[128 + lane]; F.rf1 = fr_[192 + lane]; \
      F.bk0 = fr_[256 + lane]; F.bk1 = fr_[320 + lane]; F.bk2 = fr_[384 + lane]; F.bk3 = fr_[448 + lane]; F.taf = fr_[512 + lane]; F.arf = fr_[576 + lane]; \
      F.va = *(const LAS u32x2_t*)(sl_ + 10240 + (2 * cw) * 512 + lane * 8); F.vb2 = *(const LAS u32x2_t*)(sl_ + 10240 + (2 * cw + 1) * 512 + lane * 8); \
      const LAS f32x4* wc_ = (const LAS f32x4*)(sl_ + REC_WC_B); F.wc0 = wc_[g]; F.wc1 = wc_[4 + g]; F.wc2 = wc_[8 + g]; F.wc3 = wc_[12 + g]; } while (0)
#define SCAN_TILE(F, S, VBL, vtv, chv) do { \
      u32x4 sb0, sb1; \
      sb0.x = pk_bf16(S[0][0], S[0][1]); sb0.y = pk_bf16(S[0][2], S[0][3]); sb0.z = pk_bf16(S[1][0], S[1][1]); sb0.w = pk_bf16(S[1][2], S[1][3]); \
      sb1.x = pk_bf16(S[2][0], S[2][1]); sb1.y = pk_bf16(S[2][2], S[2][3]); sb1.z = pk_bf16(S[3][0], S[3][1]); sb1.w = pk_bf16(S[3][2], S[3][3]); \
      u32x4 vbz; vbz.x = VBL.x; vbz.y = VBL.y; vbz.z = 0u; vbz.w = 0u; \
      f32x4 u = __builtin_amdgcn_mfma_f32_16x16x32_bf16(as_frag(F.taf), as_frag(vbz), zero4, 0, 0, 0); \
      u = __builtin_amdgcn_mfma_f32_16x16x32_bf16(as_frag(F.m1f0), as_frag(sb0), u, 0, 0, 0); \
      u = __builtin_amdgcn_mfma_f32_16x16x32_bf16(as_frag(F.m1f1), as_frag(sb1), u, 0, 0, 0); \
      u32x4 uvb; uvb.x = pk_bf16(u[0], u[1]); uvb.y = pk_bf16(u[2], u[3]); uvb.z = VBL.x; uvb.w = VBL.y; \
      f32x4 y = __builtin_amdgcn_mfma_f32_16x16x32_bf16(as_frag(F.rf0), as_frag(sb0), zero4, 0, 0, 0); \
      y = __builtin_amdgcn_mfma_f32_16x16x32_bf16(as_frag(F.rf1), as_frag(sb1), y, 0, 0, 0); \
      y = __builtin_amdgcn_mfma_f32_16x16x32_bf16(as_frag(F.arf), as_frag(uvb), y, 0, 0, 0); \
      S[0] = __builtin_amdgcn_mfma_f32_16x16x32_bf16(as_frag(F.bk0), as_frag(uvb), S[0] * F.wc0, 0, 0, 0); \
      S[1] = __builtin_amdgcn_mfma_f32_16x16x32_bf16(as_frag(F.bk1), as_frag(uvb), S[1] * F.wc1, 0, 0, 0); \
      S[2] = __builtin_amdgcn_mfma_f32_16x16x32_bf16(as_frag(F.bk2), as_frag(uvb), S[2] * F.wc2, 0, 0, 0); \
      S[3] = __builtin_amdgcn_mfma_f32_16x16x32_bf16(as_frag(F.bk3), as_frag(uvb), S[3] * F.wc3, 0, 0, 0); \
      _Pragma("unroll") for (int j = 0; j < 4; ++j) (ystage + ((chv) & 1) * 512)[(4 * g + j) * 32 + 16 * ((vtv) & 1) + i] = f2bf(y[j]); } while (0)
#define SCAN_YOUT(chprev) do { const u32x4 yv_ = *(const LAS u32x4*)(ystage + ((chprev) & 1) * 512 + (lane >> 2) * 32 + (lane & 3) * 8); \
      *(u32x4*)(P.yraw + (size_t)(b * SEQ + (chprev) * 16 + (lane >> 2)) * 512 + h * 64 + 32 * cw + (lane & 3) * 8) = yv_; } while (0)
#define SCAN_STEP(F, chv) do { if ((chv) > 0) SCAN_YOUT((chv) - 1); SCAN_TILE(F, sa, F.va, 2 * cw, chv); SCAN_TILE(F, sbt, F.vb2, 2 * cw + 1, chv); } while (0)
    LAS bf16_t* ystage = (LAS bf16_t*)(lds + SCAN_D * SCAN_SLOT + cw * 2048);
    Fr FA, FB;
    asm volatile("s_barrier" ::: "memory");
    SCAN_FR(FA, 0);
    int slot = 1;
    for (int ch = 0; ch < 256; ch += 2) {
      SCAN_FR(FB, slot); slot = (slot == SCAN_D - 1) ? 0 : slot + 1;
      SCAN_STEP(FA, ch);
      asm volatile("s_waitcnt lgkmcnt(0)\n\ts_barrier" ::: "memory");
      SCAN_FR(FA, slot); slot = (slot == SCAN_D - 1) ? 0 : slot + 1;
      SCAN_STEP(FB, ch + 1);
      asm volatile("s_waitcnt lgkmcnt(0)\n\ts_barrier" ::: "memory");
    }
    SCAN_YOUT(255);
#undef SCAN_YOUT
#undef SCAN_FR
#undef SCAN_TILE
#undef SCAN_STEP
  }
  __syncthreads();
}

#ifndef ATT_TR
#define ATT_TR 1
#endif
constexpr int ATT_ITEMS = 64 * 3 * 32;
constexpr int KV_LD = 72;
typedef short v4i16_t __attribute__((ext_vector_type(4)));
__device__ __forceinline__ bf16x8 vfrag(const bf16_t* sV, int row0, int row1, int g, int i, int mt) {
  bf16x8 a;
#if ATT_TR
  typedef __attribute__((address_space(3))) v4i16_t* ldsp;
  const v4i16_t lo = __builtin_amdgcn_ds_read_tr16_b64_v4i16((ldsp)(sV + (row0 + 4 * g + (i >> 2)) * KV_LD + 16 * mt + 4 * (i & 3)));
  const v4i16_t hi = __builtin_amdgcn_ds_read_tr16_b64_v4i16((ldsp)(sV + (row1 + 4 * g + (i >> 2)) * KV_LD + 16 * mt + 4 * (i & 3)));
#pragma unroll
  for (int j = 0; j < 4; ++j) { a[j] = lo[j]; a[4 + j] = hi[j]; }
#else
#pragma unroll
  for (int j = 0; j < 4; ++j) {
    a[j] = (short)sV[(row0 + 4 * g + j) * KV_LD + 16 * mt + i];
    a[4 + j] = (short)sV[(row1 + 4 * g + j) * KV_LD + 16 * mt + i];
  }
#endif
  return a;
}
constexpr int ATT_ROWS = 256;
struct AttnRegs { u32x4 k0, k1, k2, k3, k4, k5, k6, k7, v0, v1, v2, v3, v4, v5, v6, v7; bf16x8 qa0, qa1, qb0, qb1; };
__device__ __forceinline__ void attn_load(const Params& P, int item, const int tid, AttnRegs& R) {
  const int lane = tid & 63, w = tid >> 6, g = lane >> 4, i = lane & 15;
  const int bh = item / 96, rem = item % 96, pat = rem >> 5, idx = rem & 31;
  const int b = bh >> 3, h = bh & 7;
  const int sh = 2 * pat, dil = 1 << sh;
  const int rho = idx & (dil - 1), qt = idx >> sh;
  const bf16_t* pb = P.p + (size_t)(b * SEQ) * NIN;
#define ATT_LD(u, KK, VV) do { const int c_ = tid + 256 * (u), row_ = c_ >> 3, cc_ = c_ & 7; int ik_ = 128 * qt - 128 + row_; if (ik_ < 0) ik_ = 0; \
    const bf16_t* src_ = pb + (size_t)(rho + (ik_ << sh)) * NIN + h * 64 + cc_ * 8; KK = *(const u32x4*)(src_ + OFF_KB); VV = *(const u32x4*)(src_ + OFF_VB); } while (0)
  ATT_LD(0, R.k0, R.v0); ATT_LD(1, R.k1, R.v1); ATT_LD(2, R.k2, R.v2); ATT_LD(3, R.k3, R.v3);
  ATT_LD(4, R.k4, R.v4); ATT_LD(5, R.k5, R.v5); ATT_LD(6, R.k6, R.v6); ATT_LD(7, R.k7, R.v7);
#undef ATT_LD
  const int qposa = rho + ((128 * qt + 32 * w + i) << sh);
  const bf16_t* qsrc = pb + (size_t)qposa * NIN + OFF_Q + h * 64 + 8 * g;
  R.qa0 = *(const bf16x8*)(qsrc); R.qa1 = *(const bf16x8*)(qsrc + 32);
  const bf16_t* qsrb = qsrc + (size_t)(16 << sh) * NIN;
  R.qb0 = *(const bf16x8*)(qsrb); R.qb1 = *(const bf16x8*)(qsrb + 32);
}
__device__ __forceinline__ void attn_stage(float* sm, const int tid, const AttnRegs& R) {
  bf16_t* sK = (bf16_t*)sm;
  bf16_t* sV = sK + ATT_ROWS * KV_LD;
#define ATT_ST(u, KK, VV) do { const int c_ = tid + 256 * (u), row_ = c_ >> 3, cc_ = c_ & 7; *(u32x4*)(sK + row_ * KV_LD + cc_ * 8) = KK; *(u32x4*)(sV + row_ * KV_LD + cc_ * 8) = VV; } while (0)
  ATT_ST(0, R.k0, R.v0); ATT_ST(1, R.k1, R.v1); ATT_ST(2, R.k2, R.v2); ATT_ST(3, R.k3, R.v3);
  ATT_ST(4, R.k4, R.v4); ATT_ST(5, R.k5, R.v5); ATT_ST(6, R.k6, R.v6); ATT_ST(7, R.k7, R.v7);
#undef ATT_ST
}
__device__ __forceinline__ void attn_compute(const Params& P, int item, float* sm, const int tid, const int weff, const bf16x8 qf0, const bf16x8 qf1) {
  bf16_t* sK = (bf16_t*)sm;
  bf16_t* sV = sK + ATT_ROWS * KV_LD;
  const int lane = tid & 63, g = lane >> 4, i = lane & 15;
  const int bh = item / 96, rem = item % 96, pat = rem >> 5, idx = rem & 31;
  const int b = bh >> 3, h = bh & 7;
  const int sh = 2 * pat, dil = 1 << sh;
  const int rho = idx & (dil - 1), qt = idx >> sh;
  const int qpos = rho + ((128 * qt + 16 * weff + i) << sh);
  f32x4 st[9];
#pragma unroll
  for (int kt = 0; kt < 9; ++kt) {
    const bf16_t* kr = sK + (16 * (weff + kt) + i) * KV_LD + 8 * g;
    f32x4 acc = (f32x4){0.f, 0.f, 0.f, 0.f};
    acc = __builtin_amdgcn_mfma_f32_16x16x32_bf16(*(const bf16x8*)(kr), qf0, acc, 0, 0, 0);
    acc = __builtin_amdgcn_mfma_f32_16x16x32_bf16(*(const bf16x8*)(kr + 32), qf1, acc, 0, 0, 0);
    st[kt] = acc;
  }
  float mx = -INFINITY;
#pragma unroll
  for (int j = 0; j < 4; ++j) {
    if (4 * g + j < i) st[0][j] = -INFINITY;
    if (4 * g + j > i) st[8][j] = -INFINITY;
  }
  if (qt == 0) {
#pragma unroll
    for (int kt = 0; kt < 9; ++kt)
#pragma unroll
      for (int j = 0; j < 4; ++j) if (16 * (weff + kt) + 4 * g + j < 128) st[kt][j] = -INFINITY;
  }
#pragma unroll
  for (int kt = 0; kt < 9; ++kt)
#pragma unroll
    for (int j = 0; j < 4; ++j) mx = fmaxf(mx, st[kt][j]);
  mx = fmaxf(mx, __shfl_xor(mx, 16));
  mx = fmaxf(mx, __shfl_xor(mx, 32));
  constexpr float C2 = 0.125f * 1.4426950408889634f;
  const float nm2 = -mx * C2;
  float l = 0.f;
#pragma unroll
  for (int kt = 0; kt < 9; ++kt)
#pragma unroll
    for (int j = 0; j < 4; ++j) {
      const float pe = __builtin_amdgcn_exp2f(__builtin_fmaf(st[kt][j], C2, nm2));
      st[kt][j] = pe;
      l += pe;
    }
  l += __shfl_xor(l, 16);
  l += __shfl_xor(l, 32);
  f32x4 o[4];
#pragma unroll
  for (int mt = 0; mt < 4; ++mt) o[mt] = (f32x4){0.f, 0.f, 0.f, 0.f};
#pragma unroll
  for (int s2 = 0; s2 < 5; ++s2) {
    const int t0 = 2 * s2, t1 = (2 * s2 + 1 < 9) ? (2 * s2 + 1) : t0;
    u32x4 pw;
    pw.x = pk_bf16(st[t0][0], st[t0][1]); pw.y = pk_bf16(st[t0][2], st[t0][3]);
    pw.z = (2 * s2 + 1 < 9) ? pk_bf16(st[t1][0], st[t1][1]) : 0u; pw.w = (2 * s2 + 1 < 9) ? pk_bf16(st[t1][2], st[t1][3]) : 0u;
    const bf16x8 pbv = as_frag(pw);
#pragma unroll
    for (int mt = 0; mt < 4; ++mt) {
      const bf16x8 a = vfrag(sV, 16 * (weff + t0), 16 * (weff + t1), g, i, mt);
      o[mt] = __builtin_amdgcn_mfma_f32_16x16x32_bf16(a, pbv, o[mt], 0, 0, 0);
    }
  }
  const float rl = 1.f / l;
  const size_t bt = (size_t)(b * SEQ + qpos);
  bf16_t* od = P.p + bt * NIN + pat * 512 + h * 64 + 4 * g;
#pragma unroll
  for (int mt = 0; mt < 4; ++mt) {
    typedef unsigned u32x2_t __attribute__((ext_vector_type(2)));
    u32x2_t ov; ov.x = pk_bf16(o[mt][0] * rl, o[mt][1] * rl); ov.y = pk_bf16(o[mt][2] * rl, o[mt][3] * rl);
    __builtin_nontemporal_store(ov, (u32x2_t*)(od + 16 * mt));
  }
  if (g == 0) ((float*)(P.p + bt * NIN + 1536))[pat * 8 + h] = mx * 0.125f + __logf(l);
}

constexpr int MERGE_ITEMS = MTOK * 8 * 8 / 512;
__device__ __forceinline__ void merge_one(const Params& P, const int gid, const bool scratch) {
  const int dg = gid & 7, h = (gid >> 3) & 7, bt = gid >> 6;
  bf16_t* prow = P.p + (size_t)bt * NIN;
  {
    const float* lse = (const float*)(prow + 1536);
    const float l0 = lse[h], l1 = lse[8 + h], l2 = lse[16 + h];
    const float m = fmaxf(l0, fmaxf(l1, l2));
    float w0 = __expf(l0 - m), w1 = __expf(l1 - m), w2 = __expf(l2 - m);
    const float rs = 1.f / (w0 + w1 + w2);
    w0 *= rs; w1 *= rs; w2 *= rs;
    const int off = h * 64 + dg * 8;
    const u32x4 a0 = ld_nt(prow + off), a1 = ld_nt(prow + 512 + off), a2 = ld_nt(prow + 1024 + off);
    const u32x4 zz = ld_nt(prow + OFF_ZB + off);
    const unsigned av0[4] = {a0.x, a0.y, a0.z, a0.w}, av1[4] = {a1.x, a1.y, a1.z, a1.w}, av2[4] = {a2.x, a2.y, a2.z, a2.w}, zv[4] = {zz.x, zz.y, zz.z, zz.w};
    unsigned ov[4];
#pragma unroll
    for (int u = 0; u < 4; ++u) {
      const float lo = w0 * __uint_as_float(av0[u] << 16) + w1 * __uint_as_float(av1[u] << 16) + w2 * __uint_as_float(av2[u] << 16);
      const float hi = w0 * __uint_as_float(av0[u] & 0xffff0000u) + w1 * __uint_as_float(av1[u] & 0xffff0000u) + w2 * __uint_as_float(av2[u] & 0xffff0000u);
      const float zl = __uint_as_float(zv[u] << 16), zh = __uint_as_float(zv[u] & 0xffff0000u);
      ov[u] = (unsigned)f2bf(lo * silu(zl)) | ((unsigned)f2bf(hi * silu(zh)) << 16);
    }
    *(uint4*)((scratch ? (bf16_t*)P.out + (size_t)bt * DM + 512 : prow + OFF_ZB) + off) = make_uint4(ov[0], ov[1], ov[2], ov[3]);
  }
  {
    const int cb = h * 64 + dg * 8;
    const u32x4 yy = ld_nt(P.yraw + (size_t)bt * 512 + cb);
    const u32x4 zz = ld_nt(prow + OFF_ZA + cb);
    const unsigned yv[4] = {yy.x, yy.y, yy.z, yy.w}, zv[4] = {zz.x, zz.y, zz.z, zz.w};
    float y[8];
#pragma unroll
    for (int u = 0; u < 4; ++u) { y[2 * u] = __uint_as_float(yv[u] << 16); y[2 * u + 1] = __uint_as_float(yv[u] & 0xffff0000u); }
    float sm1 = 0.f;
#pragma unroll
    for (int u = 0; u < 8; ++u) sm1 += y[u];
    sm1 += __shfl_xor(sm1, 1); sm1 += __shfl_xor(sm1, 2); sm1 += __shfl_xor(sm1, 4);
    const float mu = sm1 * (1.f / 64.f);
    float sq = 0.f;
#pragma unroll
    for (int u = 0; u < 8; ++u) { const float d = y[u] - mu; sq += d * d; }
    sq += __shfl_xor(sq, 1); sq += __shfl_xor(sq, 2); sq += __shfl_xor(sq, 4);
    const float rstd = rsqrtf(sq * (1.f / 64.f) + 64e-5f);
    const int b = bt >> 12, t = bt & (SEQ - 1), tl = t & 15;
    const char* recb = P.rec + (size_t)((b * 8 + h) * 256 + (t >> 4)) * REC_BYTES;
    const float rkb = ((const float*)(recb + REC_RKB_B))[tl];
    const bf16_t* vbp = (const bf16_t*)recb + REC_VB;
    float o[8];
#pragma unroll
    for (int u = 0; u < 8; ++u) {
      const int v = dg * 8 + u;
      const float vv = bf2f(vbp[(v >> 4) * 256 + (16 * (tl >> 2) + (v & 15)) * 4 + (tl & 3)]);
      const float yn = (y[u] - mu) * rstd * P.gn_gain[cb + u] + P.gn_bias[cb + u];
      const float z = (u & 1) ? __uint_as_float(zv[u >> 1] & 0xffff0000u) : __uint_as_float(zv[u >> 1] << 16);
      o[u] = (yn + rkb * vv) * silu(z);
    }
    *(uint4*)((scratch ? (bf16_t*)P.out + (size_t)bt * DM : prow + OFF_ZA) + cb) = make_uint4(pk_bf16(o[0], o[1]), pk_bf16(o[2], o[3]), pk_bf16(o[4], o[5]), pk_bf16(o[6], o[7]));
  }
}

__device__ void merge_item(const Params& P, int item, const bool scratch) {
  const int gid = item * 512 + threadIdx.x;
  merge_one(P, gid, scratch);
  merge_one(P, gid + (MERGE_ITEMS / 2) * 512, scratch);
}

__device__ void final_norm_item(const Params& P, int it, const bool scratch) {
  const int lane = threadIdx.x & 63, wv = threadIdx.x >> 6;
  const int row = it * 16 + wv * 2;
  const bf16_t* yb = (const bf16_t*)P.rec + (size_t)row * DM;
  u32x4 raw[4];
#pragma unroll
  for (int i = 0; i < 4; ++i) raw[i] = ld_nt(yb + (i >> 1) * DM + (i & 1) * 512 + lane * 8);
  float v[4][8];
  float ss0 = 0.f, ss1 = 0.f;
#pragma unroll
  for (int i = 0; i < 4; ++i)
#pragma unroll
    for (int e = 0; e < 4; ++e) {
      v[i][2 * e] = __uint_as_float(raw[i][e] << 16); v[i][2 * e + 1] = __uint_as_float(raw[i][e] & 0xffff0000u);
      const float q = v[i][2 * e] * v[i][2 * e] + v[i][2 * e + 1] * v[i][2 * e + 1];
      if (i < 2) ss0 += q; else ss1 += q;
    }
  ss0 = wave_sum(ss0); ss1 = wave_sum(ss1);
  const float rstd0 = rsqrtf(ss0 * (1.0f / DM) + 1e-6f), rstd1 = rsqrtf(ss1 * (1.0f / DM) + 1e-6f);
#pragma unroll
  for (int i = 0; i < 4; ++i) {
    const int col = (i & 1) * 512 + lane * 8;
    const f32x4 g0 = *(const f32x4*)(P.final_gain + col), g1 = *(const f32x4*)(P.final_gain + col + 4);
    const float rstd = (i < 2) ? rstd0 : rstd1;
    f32x4 o0, o1;
#pragma unroll
    for (int e = 0; e < 4; ++e) { o0[e] = v[i][e] * rstd * g0[e]; o1[e] = v[i][4 + e] * rstd * g1[e]; }
    float* dst = P.out + (size_t)(row + (i >> 1)) * DM + col;
    __builtin_nontemporal_store(o0, (f32x4*)dst); __builtin_nontemporal_store(o1, (f32x4*)(dst + 4));
  }
}

#define XB_TMO      128
#define XB_XCNT(j)  (256  + 64 * (j))
#define XB_XSUB(j)  (1280 + 64 * (j))
#define XB_XGEN(j)  (2304 + 64 * (j))
#define XB_TOP      3328
#define XB_TOPGEN   3392
#define XCD_BAR_WORDS 3456
#define XB_SPIN_CAP (1u << 18)
__device__ __forceinline__ unsigned xb_ld(unsigned* p)              { return __hip_atomic_load(p, __ATOMIC_RELAXED, __HIP_MEMORY_SCOPE_AGENT); }
__device__ __forceinline__ unsigned xb_add(unsigned* p, unsigned v) { return __hip_atomic_fetch_add(p, v, __ATOMIC_RELAXED, __HIP_MEMORY_SCOPE_AGENT); }
__device__ __forceinline__ unsigned xb_xcc_id() { return (unsigned)__builtin_amdgcn_s_getreg((3 << 11) | 20) & 0xFu; }
#define XB_SPIN(cond, bar) do { unsigned _sp = 0; while (cond) { __builtin_amdgcn_s_sleep(1); \
    if ((++_sp & 255u) == 0u) { if (xb_ld(&(bar)[XB_TMO])) break; if (_sp > XB_SPIN_CAP) { atomicAdd(&(bar)[XB_TMO], 1u); break; } } } } while (0)
struct XcdBarrier { unsigned* bar; unsigned x; volatile LAS unsigned* st; };
__device__ __forceinline__ XcdBarrier xcd_barrier_post(unsigned* bar, volatile LAS unsigned* st) {
  XcdBarrier b; b.bar = bar; b.x = xb_xcc_id(); b.st = st;
  if (threadIdx.x == 0) (void)xb_add(&bar[XB_XCNT(b.x)], 1u);
  return b;
}
__device__ __forceinline__ void xcd_barrier_complete(unsigned* bar, unsigned x, unsigned& nloc, unsigned& nx) {
  const unsigned G = gridDim.x * gridDim.y * gridDim.z;
  unsigned sum, cnt, mine, sp = 0u;
  for (;;) {
    sum = 0u; cnt = 0u; mine = 0u;
#pragma unroll
    for (unsigned j = 0; j < 16; ++j) { const unsigned c = xb_ld(&bar[XB_XCNT(j)]); sum += c; cnt += (c > 0u) ? 1u : 0u; mine = (j == x) ? c : mine; }
    if (sum == G) break;
    __builtin_amdgcn_s_sleep(1);
    if ((++sp & 255u) == 0u) { if (xb_ld(&bar[XB_TMO])) break; if (sp > XB_SPIN_CAP) { atomicAdd(&bar[XB_TMO], 1u); break; } }
  }
  nloc = mine > 0u ? mine : 1u; nx = cnt > 0u ? cnt : 1u;
}
__device__ __forceinline__ void xcd_barrier(const XcdBarrier& b) {
  asm volatile("s_waitcnt vmcnt(0)" ::: "memory");
  __syncthreads();
  if (threadIdx.x == 0) {
    unsigned* bar = b.bar;
    __builtin_amdgcn_s_waitcnt(0);
    unsigned nloc = b.st[0], nx = b.st[1];
    if (nloc == 0u) { xcd_barrier_complete(bar, b.x, nloc, nx); b.st[0] = nloc; b.st[1] = nx; }
    const unsigned old = xb_add(&bar[XB_XSUB(b.x)], 1u);
    const unsigned gen = old / nloc;
    if (old + 1u == (gen + 1u) * nloc) {
      __builtin_amdgcn_fence(__ATOMIC_RELEASE, "agent");
      asm volatile("s_waitcnt vmcnt(0)" ::: "memory");
      const unsigned og = xb_add(&bar[XB_TOP], 1u);
      const unsigned tg = og / nx;
      if (og + 1u == (tg + 1u) * nx) xb_add(&bar[XB_TOPGEN], 1u);
      else XB_SPIN(xb_ld(&bar[XB_TOPGEN]) == tg, bar);
      __builtin_amdgcn_fence(__ATOMIC_ACQUIRE, "agent");
      xb_add(&bar[XB_XGEN(b.x)], 1u);
      asm volatile("s_waitcnt vmcnt(0)" ::: "memory");
    } else {
      XB_SPIN(xb_ld(&bar[XB_XGEN(b.x)]) == gen, bar);
      __builtin_amdgcn_fence(__ATOMIC_ACQUIRE, "agent");
      asm volatile("s_waitcnt vmcnt(0)" ::: "memory");
    }
  }
  __syncthreads();
}

constexpr int LDS_CTRL = 18432 + 8 * 16384;
constexpr int LDS_BYTES = LDS_CTRL + 16;
constexpr int HALF_LDS_FLOATS = 18432;
constexpr int SCAN_BLOCKS = 64;
#ifndef PROBE
#define PROBE 0
#endif

__global__ void __launch_bounds__(512, 2) fwd_megakernel(Params P) {
  extern __shared__ __attribute__((aligned(16))) unsigned char lds[];
  float* sm = (float*)lds;
  cg::grid_group grid = cg::this_grid();
  const int nb = gridDim.x, bid = blockIdx.x, tid = threadIdx.x, half = tid >> 8, t8 = tid & 255;
  float* smh = sm + half * HALF_LDS_FLOATS;
  volatile LAS unsigned* xst = (volatile LAS unsigned*)((LAS unsigned char*)lds + LDS_CTRL);
  if (tid == 0) { xst[0] = 0u; xst[1] = 0u; }
  __syncthreads();
  const XcdBarrier xbar = xcd_barrier_post(P.barw, xst);
  for (int rep = 0; rep < (PROBE == 5 ? 2 : 1); ++rep)
  for (int it = bid; it < PREP_ITEMS; it += nb) prep_item(P, it, sm);
  if (P.out == nullptr) grid.sync();
  for (int r_ = 0; r_ < (PROBE == 10 ? 3 : 1); ++r_) xcd_barrier(xbar);
  {
    pg8::Gemm g; g.A = P.hb; g.Bt = P.winT; g.M = MTOK; g.N = NPAD; g.K = DM; g.lda = DM;
    pg8::StaticOrder S; S.init(MTOK, NPAD, nb, bid);
    EpiProj E; E.p = P.p;
    pg8::gemm_phase<EpiProj>((LAS unsigned char*)lds, g, S, E);
    if (PROBE == 4) pg8::gemm_phase<EpiProj>((LAS unsigned char*)lds, g, S, E);
  }
  for (int r_ = 0; r_ < (PROBE == 10 ? 3 : 1); ++r_) xcd_barrier(xbar);
  for (int rep = 0; rep < (PROBE == 3 ? 2 : 1); ++rep)
  for (int vb = bid; vb < 256; vb += nb) rwkv_prep_waves(P, vb, (unsigned char*)lds);
  for (int r_ = 0; r_ < (PROBE == 10 ? 3 : 1); ++r_) xcd_barrier(xbar);
  for (int rep = 0; rep < (PROBE == 7 ? 2 : 1); ++rep) {
  if (bid < SCAN_BLOCKS) rwkv_scan_block(P, bid, (LAS unsigned char*)lds);
  {
    volatile LAS int* qslot = (volatile LAS int*)((LAS unsigned char*)lds + LDS_CTRL + 8);
    unsigned* ctr = P.barw + XCD_BAR_WORDS + 64 + rep * 1024;
    int qx = (int)(xbar.x & 7u), tried = 0;
    constexpr int QPAIRS = ATT_ITEMS / 16;
#define ATT_FETCH(dst) do { dst = -1; while (tried < 8) { const int ix_ = (int)atomicAdd(ctr + qx * 64, 1u); if (ix_ < QPAIRS) { dst = qx * QPAIRS + ix_; break; } qx = (qx + 1) & 7; ++tried; } } while (0)
    int a1 = -1;
    if (tid == 0) { int a0; ATT_FETCH(a0); ATT_FETCH(a1); *qslot = a0; }
    __syncthreads();
    int it = *qslot;
    AttnRegs R;
#define ATT_ITEM(pr) ((8 * ((2 * ((pr) % QPAIRS)) / 96) + (pr) / QPAIRS) * 96 + (2 * ((pr) % QPAIRS)) % 96 + half)
    attn_load(P, ATT_ITEM(it >= 0 ? it : 0), t8, R);
    while (it >= 0) {
      __syncthreads();
      if (tid == 0) { *qslot = a1; ATT_FETCH(a1); }
      attn_stage(smh, t8, R);
      const bf16x8 qa0 = R.qa0, qa1 = R.qa1, qb0 = R.qb0, qb1 = R.qb1;
      __syncthreads();
      const int itn = *qslot;
      attn_load(P, ATT_ITEM(itn >= 0 ? itn : 0), t8, R);
      const int item = ATT_ITEM(it);
      attn_compute(P, item, smh, t8, 2 * (t8 >> 6), qa0, qa1);
      attn_compute(P, item, smh, t8, 2 * (t8 >> 6) + 1, qb0, qb1);
      it = itn;
    }
#undef ATT_FETCH
#undef ATT_ITEM
  }
  __syncthreads();
  }
  for (int r_ = 0; r_ < (PROBE == 10 ? 3 : 1); ++r_) xcd_barrier(xbar);
  if (PROBE == 9) for (int it = bid; it < MERGE_ITEMS / 2; it += nb) merge_item(P, it, true);
  for (int it = bid; it < MERGE_ITEMS / 2; it += nb) merge_item(P, it, false);
  for (int r_ = 0; r_ < (PROBE == 10 ? 3 : 1); ++r_) xcd_barrier(xbar);
  {
    pg8::Gemm g; g.A = P.p + OFF_ZA; g.Bt = P.woutT; g.M = MTOK; g.N = DM; g.K = DM; g.lda = NIN;
    pg8::StaticOrder S; S.init(MTOK, DM, nb, bid);
    EpiOut E; E.x = P.x; E.ybf = (bf16_t*)P.rec;
    pg8::gemm_phase<EpiOut>((LAS unsigned char*)lds, g, S, E);
    if (PROBE == 6) pg8::gemm_phase<EpiOut>((LAS unsigned char*)lds, g, S, E);
  }
  for (int r_ = 0; r_ < (PROBE == 10 ? 3 : 1); ++r_) xcd_barrier(xbar);
  for (int it = bid; it < MTOK / 16; it += nb) final_norm_item(P, it, false);
}

extern "C" void kernel_launch(void* const* d_in, const int* in_sizes, int n_in, void* d_out, int out_size, void* d_ws, size_t ws_size,
                              hipStream_t stream) {
  Params P{};
  P.x = (const float*)d_in[0]; P.norm_gain = (const float*)d_in[1]; P.w_in = (const float*)d_in[2]; P.shift_mix = (const float*)d_in[3];
  P.decay_base = (const float*)d_in[4]; P.decay_up = (const float*)d_in[5]; P.iclr_base = (const float*)d_in[6]; P.iclr_up = (const float*)d_in[7];
  P.key_norm_scale = (const float*)d_in[8]; P.key_iclr_mix = (const float*)d_in[9]; P.bonus = (const float*)d_in[10]; P.gn_gain = (const float*)d_in[11];
  P.gn_bias = (const float*)d_in[12]; P.w_out = (const float*)d_in[13]; P.final_gain = (const float*)d_in[14];
  P.out = (float*)d_out;
  char* ws = (char*)d_ws;
  const size_t MiB = 1024 * 1024;
  P.winT = (bf16_t*)(ws);
  P.woutT = (bf16_t*)(ws + 9 * MiB);
  P.dut = (bf16_t*)(ws + 11 * MiB);
  P.iut = (bf16_t*)(ws + 11 * MiB + 65536);
  P.p = (bf16_t*)(ws + 12 * MiB);
  P.hb = (bf16_t*)(ws + 276 * MiB);
  P.rec = ws + 276 * MiB;
  P.yraw = (bf16_t*)(ws + 474 * MiB);
  P.barw = (unsigned*)(ws + 506 * MiB);
  if (ws_size < 507 * MiB) { fprintf(stderr, "workspace too small\n"); return; }
  static int grid_blocks = 0;
  if (!grid_blocks) {
    int dev = 0, cus = 0, per_cu = 0;
    (void)hipGetDevice(&dev);
    (void)hipDeviceGetAttribute(&cus, hipDeviceAttributeMultiprocessorCount, dev);
    (void)hipFuncSetAttribute((const void*)fwd_megakernel, hipFuncAttributeMaxDynamicSharedMemorySize, LDS_BYTES);
    (void)hipOccupancyMaxActiveBlocksPerMultiprocessor(&per_cu, fwd_megakernel, 512, LDS_BYTES);
    if (per_cu > 1) per_cu = 1;
    grid_blocks = cus * per_cu;
  }
  (void)hipMemsetAsync(P.barw, 0, (XCD_BAR_WORDS + 64 + 2048) * sizeof(unsigned), stream);
  void* args[] = {&P};
  hipError_t e = hipLaunchCooperativeKernel((void*)fwd_megakernel, dim3(grid_blocks), dim3(512), args, LDS_BYTES, stream);
  if (e != hipSuccess) fprintf(stderr, "cooperative launch failed: %s (grid %d)\n", hipGetErrorString(e), grid_blocks);
}
```

```cpp
#include <hip/hip_runtime.h>
#include <hip/hip_cooperative_groups.h>
#include <stdint.h>
#include <cstdio>
namespace cg = cooperative_groups;

typedef unsigned short bf16_t;
typedef short bf16x8 __attribute__((ext_vector_type(8)));
typedef float f32x4 __attribute__((ext_vector_type(4)));
typedef unsigned u32x4 __attribute__((ext_vector_type(4)));
#define LAS __attribute__((address_space(3)))

constexpr int SEQ = 4096, DM = 1024, MTOK = 32768, NIN = 4224, NPAD = 4352;
constexpr int OFF_R = 0, OFF_K = 512, OFF_V = 1024, OFF_WLO = 1536, OFF_ALO = 1600;
constexpr int OFF_Q = 1664, OFF_KB = 2176, OFF_VB = 2688, OFF_ZA = 3200, OFF_ZB = 3712;

struct Params {
  const float *x, *norm_gain, *w_in, *shift_mix, *decay_base, *decay_up, *iclr_base, *iclr_up,
      *key_norm_scale, *key_iclr_mix, *bonus, *gn_gain, *gn_bias, *w_out, *final_gain;
  float* out;
  bf16_t *hb, *winT, *woutT, *p, *yraw, *dut, *iut;
  char* rec;
  unsigned* barw;
};

typedef float f32x2_t __attribute__((ext_vector_type(2)));
typedef __bf16 bf16x2_t __attribute__((ext_vector_type(2)));
__device__ __forceinline__ unsigned pk_bf16(float lo, float hi) { const f32x2_t v = {lo, hi}; return __builtin_bit_cast(unsigned, __builtin_convertvector(v, bf16x2_t)); }
__device__ __forceinline__ bf16_t f2bf(float f) { return (bf16_t)(pk_bf16(f, 0.f) & 0xffffu); }
__device__ __forceinline__ u32x4 ld_nt(const void* p) { return __builtin_nontemporal_load((const u32x4*)p); }
__device__ __forceinline__ f32x4 ldf_nt(const void* p) { return __builtin_nontemporal_load((const f32x4*)p); }
__device__ __forceinline__ float bf2f(bf16_t h) { return __uint_as_float(((unsigned)h) << 16); }
__device__ __forceinline__ float dpp_add(float v, const int ctrl_sel) {
  const int iv = __builtin_bit_cast(int, v);
  int o;
  if (ctrl_sel == 0) o = __builtin_amdgcn_update_dpp(iv, iv, 0xB1, 0xF, 0xF, false);
  else if (ctrl_sel == 1) o = __builtin_amdgcn_update_dpp(iv, iv, 0x4E, 0xF, 0xF, false);
  else if (ctrl_sel == 2) o = __builtin_amdgcn_update_dpp(iv, iv, 0x141, 0xF, 0xF, false);
  else o = __builtin_amdgcn_update_dpp(iv, iv, 0x140, 0xF, 0xF, false);
  return v + __builtin_bit_cast(float, o);
}
__device__ __forceinline__ float wave_sum(float v) {
  v = dpp_add(v, 0); v = dpp_add(v, 1); v = dpp_add(v, 2); v = dpp_add(v, 3);
  const int iv = __builtin_bit_cast(int, v);
  const float s0 = __builtin_bit_cast(float, __builtin_amdgcn_readlane(iv, 0)), s1 = __builtin_bit_cast(float, __builtin_amdgcn_readlane(iv, 16));
  const float s2 = __builtin_bit_cast(float, __builtin_amdgcn_readlane(iv, 32)), s3 = __builtin_bit_cast(float, __builtin_amdgcn_readlane(iv, 48));
  return (s0 + s1) + (s2 + s3);
}
__device__ __forceinline__ float silu(float z) { return z / (1.f + __expf(-z)); }
__device__ __forceinline__ bf16x8 as_frag(u32x4 v) { return __builtin_bit_cast(bf16x8, v); }

constexpr int PREP_ROW_ITEMS = MTOK / 16, PREP_WIN_TILES = 16 * 68, PREP_WOUT_TILES = 16 * 16;
constexpr int PREP_LR_ITEMS = 128;
constexpr int PREP_ITEMS = PREP_ROW_ITEMS + PREP_WIN_TILES + PREP_WOUT_TILES + PREP_LR_ITEMS;

__device__ void prep_item(const Params& P, int it, float* sm) {
  const int tid = threadIdx.x, lane = tid & 63, wv = tid >> 6;
  if (it < PREP_ROW_ITEMS) {
    const int row = it * 16 + wv * 2;
    const float4* xr = (const float4*)(P.x + (size_t)row * DM);
    const float4* g4 = (const float4*)P.norm_gain;
    float4 v[8];
    float ss0 = 0.f, ss1 = 0.f;
#pragma unroll
    for (int i = 0; i < 8; ++i) { const f32x4 t_ = ldf_nt(xr + lane + 64 * i); v[i] = make_float4(t_[0], t_[1], t_[2], t_[3]); }
#pragma unroll
    for (int i = 0; i < 4; ++i) {
      ss0 += v[i].x * v[i].x + v[i].y * v[i].y + v[i].z * v[i].z + v[i].w * v[i].w;
      ss1 += v[4 + i].x * v[4 + i].x + v[4 + i].y * v[4 + i].y + v[4 + i].z * v[4 + i].z + v[4 + i].w * v[4 + i].w;
    }
    ss0 = wave_sum(ss0); ss1 = wave_sum(ss1);
    const float rstd0 = rsqrtf(ss0 * (1.0f / DM) + 1e-6f), rstd1 = rsqrtf(ss1 * (1.0f / DM) + 1e-6f);
#pragma unroll
    for (int i = 0; i < 8; ++i) {
      const float4 g = g4[lane + 64 * (i & 3)];
      const float rstd = (i < 4) ? rstd0 : rstd1;
      ushort4 o;
      o.x = f2bf(v[i].x * rstd * g.x); o.y = f2bf(v[i].y * rstd * g.y);
      o.z = f2bf(v[i].z * rstd * g.z); o.w = f2bf(v[i].w * rstd * g.w);
      *(ushort4*)(P.hb + (size_t)row * DM + (lane + 64 * i) * 4) = o;
    }
    return;
  }
  it -= PREP_ROW_ITEMS;
  if (it >= PREP_WIN_TILES + PREP_WOUT_TILES) {
    it -= PREP_WIN_TILES + PREP_WOUT_TILES;
    const float* srcm = (it < 64) ? P.decay_up : P.iclr_up;
    bf16_t* dstm = (it < 64) ? P.dut : P.iut;
    const int e = (it & 63) * 512 + tid, chn = e >> 6, k = e & 63;
    dstm[e] = f2bf(srcm[k * 512 + chn]);
    return;
  }
  const float* src; bf16_t* dst; int ncols, kt, nt, scol;
  if (it < PREP_WIN_TILES) {
    src = P.w_in; dst = P.winT; ncols = NIN; kt = it / 68; nt = it % 68;
    const int n0 = nt * 64;
    scol = (n0 < 1664) ? n0 : (n0 < 3200) ? (n0 + 512) : (n0 < 3712) ? (n0 - 1536) : (n0 < 4224) ? n0 : -1;
  } else { it -= PREP_WIN_TILES; src = P.w_out; dst = P.woutT; ncols = DM; kt = it / 16; nt = it % 16; scol = nt * 64; }
#pragma unroll 4
  for (int i = 0; i < 8; ++i) {
    const int r = wv + 8 * i;
    sm[r * 65 + lane] = (scol >= 0) ? src[(size_t)(kt * 64 + r) * ncols + scol + lane] : 0.f;
  }
  __syncthreads();
#pragma unroll 4
  for (int i = 0; i < 8; ++i) {
    const int r = wv + 8 * i;
    dst[(size_t)(nt * 64 + r) * DM + kt * 64 + lane] = f2bf(sm[lane * 65 + r]);
  }
  __syncthreads();
}

namespace pg8 {
constexpr int BM = 256, BK = 64, HALF = 128, HTB = HALF * BK * 2, STAGE_BYTES = 8 * HTB, NXCD = 8, WGM = 8;
__host__ __device__ __forceinline__ int lds_byte(int r, int c) { const int st = (r >> 4) * 2 + (c >> 5), rr = r & 15, cc = c & 31, ob = rr * 64 + cc * 2; return st * 1024 + (ob ^ (((ob >> 9) & 1) << 5)); }
__host__ __device__ __forceinline__ void stage_rc(int b, int& R, int& C) { const int st = b / 1024, sb = b % 1024, swz = sb ^ (((sb >> 9) & 1) << 5); R = (st >> 1) * 16 + swz / 64; C = (st & 1) * 32 + (swz % 64) / 2; }
__host__ __device__ __forceinline__ int perm32(int rho) { const int n = rho >> 4, i = rho & 15; return 8 * (i >> 2) + 4 * n + (i & 3); }
struct Unit { int pm, pn; };
struct Gemm { const bf16_t* A; const bf16_t* Bt; int M, N, K, lda; };
struct StaticOrder {
  int nM, nN, nwg, G, c;
  __host__ __device__ void init(int M, int N, int G_, int c_) { nM = M / BM; nN = N / BM; nwg = nM * nN; G = G_; c = c_; }
  __host__ __device__ bool next(int i, Unit& u) const {
    const long L = (long)i * G + c; if (L >= nwg) return false;
    int wgid = (int)L; { const int q = nwg / NXCD, r = nwg % NXCD, xcd = wgid % NXCD, off = wgid / NXCD; wgid = (xcd < r ? xcd * (q + 1) : r * (q + 1) + (xcd - r) * q) + off; }
    const int nig = WGM * nN, gid = wgid / nig, fm = gid * WGM, gsz = (nM - fm) < WGM ? (nM - fm) : WGM;
    u.pm = fm + ((wgid % nig) % gsz); u.pn = (wgid % nig) / gsz; return true;
  }
};
template <class Epi>
__device__ __forceinline__ void gemm_phase(LAS unsigned char* lds, const Gemm g, const StaticOrder& S, const Epi& E) {
  const int tid = threadIdx.x, wid = __builtin_amdgcn_readfirstlane(tid >> 6), lane = tid & 63, wr = wid >> 2, wc = wid & 3, fr = lane & 15, fq = lane >> 4;
  const int K = g.K, nt = K / BK, lda = g.lda;
  unsigned voffA[2], voffB[2];
#pragma unroll
  for (int i = 0; i < 2; ++i) { int R, C; stage_rc(tid * 16 + i * 8192, R, C); const int Rb = (R & ~31) + perm32(R & 31);
    voffA[i] = (unsigned)(R * lda + C) * 2u; voffB[i] = (unsigned)(Rb * K + C) * 2u; }
  const size_t kstep = (size_t)(BK * 2);
  const size_t hstepA = (size_t)HALF * lda * 2, hstepB = (size_t)HALF * K * 2;
  const size_t tstepA = 2 * hstepA, tstepB = 2 * hstepB;
  const unsigned ldsw = (unsigned)wid * 1024u;
  const int aoff = lds_byte(wr * 64 + fr, fq * 8), boff = lds_byte(wc * 32 + fr, fq * 8);
#define PG8_SA(b, h) (((b) * 2 + (h)) * HTB)
#define PG8_SB(b, h) ((4 + (b) * 2 + (h)) * HTB)
#define PG8_STAGE(bufoff, gbase, voff) do { _Pragma("unroll") for (int _i = 0; _i < 2; ++_i) \
    __builtin_amdgcn_global_load_lds((const unsigned*)((const char*)(gbase) + (voff)[_i]), (LAS unsigned*)(lds + (bufoff) + ldsw + _i * 8192), 16, 0, 0); } while (0)
#define PG8_LDA(dst, b, h) do { _Pragma("unroll") for (int m = 0; m < 4; ++m) _Pragma("unroll") for (int k = 0; k < 2; ++k) dst[m][k] = *(const LAS bf16x8*)(lds + PG8_SA(b, h) + aoff + m * 2048 + k * 1024); } while (0)
#define PG8_LDB(dst, b, h) do { _Pragma("unroll") for (int n = 0; n < 2; ++n) _Pragma("unroll") for (int k = 0; k < 2; ++k) dst[n][k] = *(const LAS bf16x8*)(lds + PG8_SB(b, h) + boff + n * 2048 + k * 1024); } while (0)
#define PG8_MMA(ai, bj, At, Bt) do { __builtin_amdgcn_s_setprio(1); _Pragma("unroll") for (int m = 0; m < 4; ++m) _Pragma("unroll") for (int n = 0; n < 2; ++n) _Pragma("unroll") for (int k = 0; k < 2; ++k) \
    acc[ai][bj][m][n] = __builtin_amdgcn_mfma_f32_16x16x32_bf16(Bt[n][k], At[m][k], acc[ai][bj][m][n], 0, 0, 0); __builtin_amdgcn_s_setprio(0); } while (0)
#define PG8_WAIT_V(n) asm volatile("s_waitcnt vmcnt(" #n ")" ::: "memory")
#define PG8_WAIT_L(n) asm volatile("s_waitcnt lgkmcnt(" #n ")" ::: "memory")
#define PG8_BAR __builtin_amdgcn_s_barrier()
#define PG8_SCHED __builtin_amdgcn_sched_barrier(0)
  Unit cur, nxt; int ui = 0;
  if (!S.next(0, cur)) return;
  f32x4 acc[2][2][4][2];
#pragma unroll
  for (int a = 0; a < 2; ++a)
#pragma unroll
    for (int b = 0; b < 2; ++b)
#pragma unroll
      for (int m = 0; m < 4; ++m)
#pragma unroll
        for (int n = 0; n < 2; ++n) acc[a][b][m][n] = (f32x4){0.f, 0.f, 0.f, 0.f};
  bf16x8 At[4][2], B0[2][2], B1[2][2];
  const char* cA = (const char*)g.A + (size_t)cur.pm * tstepA; const char* cB = (const char*)g.Bt + (size_t)cur.pn * tstepB;
  PG8_STAGE(PG8_SB(0, 0), cB, voffB); PG8_STAGE(PG8_SB(0, 1), cB + hstepB, voffB); PG8_STAGE(PG8_SA(0, 0), cA, voffA); PG8_STAGE(PG8_SA(0, 1), cA + hstepA, voffA);
  if (wr == 1) PG8_BAR;
  PG8_WAIT_V(2); PG8_BAR;
  PG8_STAGE(PG8_SB(1, 0), cB + kstep, voffB); PG8_STAGE(PG8_SA(1, 0), cA + kstep, voffA); PG8_STAGE(PG8_SB(1, 1), cB + hstepB + kstep, voffB);
  PG8_WAIT_V(6); PG8_BAR;
  for (;;) {
    const bool has_next = S.next(ui + 1, nxt);
    const char* nA = has_next ? (const char*)g.A + (size_t)nxt.pm * tstepA : cA; const char* nB = has_next ? (const char*)g.Bt + (size_t)nxt.pn * tstepB : cB;
    for (int t = 0; t < nt; t += 2) {
      const bool last = (t == nt - 2);
      const char* a1 = cA + (size_t)(t + 1) * kstep;
      const char* a2 = last ? nA : cA + (size_t)(t + 2) * kstep; const char* b2 = last ? nB : cB + (size_t)(t + 2) * kstep;
      const char* a3 = a2 + kstep; const char* b3 = b2 + kstep;
      PG8_LDB(B0, 0, 0); PG8_LDB(B1, 0, 1); PG8_SCHED; PG8_LDA(At, 0, 0); PG8_STAGE(PG8_SA(1, 1), a1 + hstepA, voffA);
      PG8_WAIT_V(8); PG8_WAIT_L(0); PG8_BAR; PG8_MMA(0, 0, At, B0); PG8_MMA(0, 1, At, B1); PG8_BAR; PG8_SCHED;
      PG8_LDA(At, 0, 1); PG8_STAGE(PG8_SB(0, 0), b2, voffB); PG8_STAGE(PG8_SB(0, 1), b2 + hstepB, voffB); PG8_STAGE(PG8_SA(0, 0), a2, voffA);
      PG8_WAIT_V(8); PG8_WAIT_L(0); PG8_BAR; PG8_MMA(1, 0, At, B0); PG8_MMA(1, 1, At, B1); PG8_BAR; PG8_SCHED;
      PG8_LDB(B0, 1, 0); PG8_LDB(B1, 1, 1); PG8_SCHED; PG8_LDA(At, 1, 0); PG8_STAGE(PG8_SA(0, 1), a2 + hstepA, voffA);
      PG8_WAIT_V(8); PG8_WAIT_L(0); PG8_BAR; PG8_MMA(0, 0, At, B0); PG8_MMA(0, 1, At, B1); PG8_BAR; PG8_SCHED;
      PG8_LDA(At, 1, 1); PG8_STAGE(PG8_SB(1, 0), b3, voffB); PG8_STAGE(PG8_SB(1, 1), b3 + hstepB, voffB); PG8_STAGE(PG8_SA(1, 0), a3, voffA);
      PG8_WAIT_V(8); PG8_WAIT_L(0); PG8_BAR; PG8_MMA(1, 0, At, B0); PG8_MMA(1, 1, At, B1); PG8_BAR; PG8_SCHED;
    }
    if (wr == 0) PG8_BAR;
    E(acc, cur, wr, wc, fr, fq);
    if (!has_next) break;
#pragma unroll
    for (int a = 0; a < 2; ++a)
#pragma unroll
      for (int b = 0; b < 2; ++b)
#pragma unroll
        for (int m = 0; m < 4; ++m)
#pragma unroll
          for (int n = 0; n < 2; ++n) acc[a][b][m][n] = (f32x4){0.f, 0.f, 0.f, 0.f};
    cur = nxt; cA = nA; cB = nB; ++ui;
    if (wr == 1) PG8_BAR;
  }
  PG8_WAIT_V(0);
  PG8_BAR;
#undef PG8_SA
#undef PG8_SB
#undef PG8_STAGE
#undef PG8_LDA
#undef PG8_LDB
#undef PG8_MMA
#undef PG8_WAIT_V
#undef PG8_WAIT_L
#undef PG8_BAR
#undef PG8_SCHED
}
}

struct EpiProj {
  bf16_t* p;
  __device__ __forceinline__ void operator()(const f32x4 (&acc)[2][2][4][2], const pg8::Unit& u, int wr, int wc, int fr, int fq) const {
    const float inv[8] = {1.0f, 0.1939227432012558f, 0.03760603070259094f, 0.007292664609849453f, 0.0014142135623842478f, 0.00027424818836152554f, 5.3182957344688475e-05f, 1.0313385246263351e-05f};
#pragma unroll
    for (int bj = 0; bj < 2; ++bj) {
      const int wcol = u.pn * 256 + bj * 128 + wc * 32;
      if (wcol >= NIN) continue;
      const int col0 = wcol + 8 * fq;
      const bool wrope = (wcol >= OFF_Q) && (wcol < OFF_VB) && ((wcol & 63) == 0);
#pragma unroll
      for (int ai = 0; ai < 2; ++ai)
#pragma unroll
        for (int m = 0; m < 4; ++m) {
          const int row = u.pm * 256 + ai * 128 + wr * 64 + m * 16 + fr;
          float v[8];
#pragma unroll
          for (int e = 0; e < 4; ++e) { v[e] = acc[ai][bj][m][0][e]; v[4 + e] = acc[ai][bj][m][1][e]; }
          if (wrope) {
            const float pos = (float)(row & (SEQ - 1));
#pragma unroll
            for (int e = 0; e < 8; ++e) {
              const float other = __shfl_xor(v[e], 16);
              float rev = pos * inv[e] * 0.15915494309189535f;
              rev = (rev - rintf(rev)) * 6.283185307179586f;
              const float sn = __sinf(rev), cs = __cosf(rev);
              const float r0 = v[e] * cs - other * sn, r1 = other * sn + v[e] * cs;
              v[e] = (fq == 0) ? r0 : (fq == 1) ? r1 : v[e];
            }
          }
          u32x4 w;
          w.x = pk_bf16(v[0], v[1]); w.y = pk_bf16(v[2], v[3]); w.z = pk_bf16(v[4], v[5]); w.w = pk_bf16(v[6], v[7]);
          __builtin_nontemporal_store(w, (u32x4*)(p + (size_t)row * NIN + col0));
        }
    }
  }
};
struct EpiOut {
  const float* x; bf16_t* ybf;
  __device__ __forceinline__ void operator()(const f32x4 (&acc)[2][2][4][2], const pg8::Unit& u, int wr, int wc, int fr, int fq) const {
#pragma unroll
    for (int bj = 0; bj < 2; ++bj) {
      const int col0 = u.pn * 256 + bj * 128 + wc * 32 + 8 * fq;
#pragma unroll
      for (int ai = 0; ai < 2; ++ai)
#pragma unroll
        for (int m = 0; m < 4; ++m) {
          const int row = u.pm * 256 + ai * 128 + wr * 64 + m * 16 + fr;
          const size_t idx = (size_t)row * DM + col0;
          const f32x4 a0 = ldf_nt(x + idx) + acc[ai][bj][m][0], a1 = ldf_nt(x + idx + 4) + acc[ai][bj][m][1];
          u32x4 w; w.x = pk_bf16(a0[0], a0[1]); w.y = pk_bf16(a0[2], a0[3]); w.z = pk_bf16(a1[0], a1[1]); w.w = pk_bf16(a1[2], a1[3]);
          *(u32x4*)(ybf + idx) = w;
        }
    }
  }
};

constexpr int REC_BYTES = 12672, REC_M1 = 0, REC_R = 1024, REC_BK = 2048, REC_TA = 4096, REC_AR = 4608, REC_VB = 5120;
constexpr int REC_WC_B = 12288, REC_RKB_B = 12544;
constexpr int RPREP_ITEMS = 64 * 256;
constexpr int LS = 68;
__device__ __forceinline__ bf16x8 cvt8(const float* p) {
  const float4 a = *(const float4*)p, b = *(const float4*)(p + 4);
  u32x4 r; r.x = pk_bf16(a.x, a.y); r.y = pk_bf16(a.z, a.w); r.z = pk_bf16(b.x, b.y); r.w = pk_bf16(b.z, b.w);
  return as_frag(r);
}
__device__ __forceinline__ float fast_tanh(float x) { return 1.f - 2.f * __builtin_amdgcn_rcpf(1.f + __expf(2.f * x)); }
__device__ void rwkv_prep_block(const Params& P, int vb, float* sm, const int tid, const int half) {
  const int bh = vb >> 2, b = bh >> 3, h = bh & 7;
  const int lane = tid & 63, tt = tid >> 6, g = lane >> 4, i = lane & 15;
  float* s_r = sm;             float* s_k = sm + 1088;      float* s_at = sm + 2 * 1088;  float* s_bt = sm + 3 * 1088;
  float* s_lw = sm + 4 * 1088; float* s_an = sm + 5 * 1088; float* s_b = sm + 6 * 1088;   float* s_kt = sm + 7 * 1088;
  float* s_rt = sm + 8 * 1088; float* s_Aab = sm + 9 * 1088; float* s_Aak = s_Aab + 272;
  float* s_xw = s_at; float* s_xa = s_bt;
  bf16_t* s_twb = (bf16_t*)(sm + 9 * 1088 + 544);
  bf16_t* s_pab = s_twb + 16 * 72;
  bf16_t* rec = (bf16_t*)(sm + 9 * 1088 + 544 + 1152);
  bf16_t* s_raw = (bf16_t*)s_lw;
  const int c = h * 64 + lane;
  const float mix_r = P.shift_mix[OFF_R + c], mix_k = P.shift_mix[OFF_K + c], mix_v = P.shift_mix[OFF_V + c];
  const float mix_w = P.shift_mix[OFF_WLO + lane], mix_a = P.shift_mix[OFF_ALO + lane];
  const float dbase = P.decay_base[c], ibase = P.iclr_base[c], kns = P.key_norm_scale[c], kim = P.key_iclr_mix[c], bon = P.bonus[c];
  const bf16_t* dup = P.dut + (size_t)(h * 64 + 16 * tt + i) * 64 + 8 * g;
  const bf16_t* iup = P.iut + (size_t)(h * 64 + 16 * tt + i) * 64 + 8 * g;
  const bf16x8 bd0 = *(const bf16x8*)dup, bd1 = *(const bf16x8*)(dup + 32), bi0 = *(const bf16x8*)iup, bi1 = *(const bf16x8*)(iup + 32);
  int prow[3], pcol[3], plds[3];
#pragma unroll
  for (int u = 0; u < 3; ++u) {
    const int idx = tid + 256 * u, rr = idx / 40, q = idx - rr * 40, cg = q >> 3, sub = q & 7;
    prow[u] = (idx < 680) ? rr : -100000;
    pcol[u] = ((cg < 3) ? (cg * 512 + h * 64) : (cg == 3 ? OFF_WLO : OFF_ALO)) + sub * 8;
    plds[u] = rr * 328 + cg * 64 + sub * 8;
  }
  const bf16_t* pb = P.p + (size_t)(b * SEQ) * NIN;
  uint4 pre[3];
#define RP_PREFETCH(chunk) do { _Pragma("unroll") for (int u = 0; u < 3; ++u) { const int t_ = (chunk) * 16 - 1 + prow[u]; \
    pre[u] = (t_ >= 0) ? *(const uint4*)(pb + (size_t)t_ * NIN + pcol[u]) : make_uint4(0u, 0u, 0u, 0u); } } while (0)
  const int cbase = (vb & 3) * 64 + half;
  RP_PREFETCH(cbase);
#pragma unroll
  for (int u = 0; u < 3; ++u) if (prow[u] >= 0) *(uint4*)(s_raw + plds[u]) = pre[u];
  __syncthreads();
  for (int kk2 = 0; kk2 < 32; ++kk2) {
  const int ch = cbase + 2 * kk2;
  const int item = bh * 256 + ch;
  char* recb = P.rec + (size_t)item * REC_BYTES;
  if (kk2 + 1 < 32) RP_PREFETCH(ch + 2);
  {
#pragma unroll
    for (int q = 0; q < 4; ++q) {
      const int tl = tt + 4 * q;
      const bf16_t* row = s_raw + (tl + 1) * 328;
      const bf16_t* prw = s_raw + tl * 328;
      const float cr = bf2f(row[lane]), ck = bf2f(row[64 + lane]), cv = bf2f(row[128 + lane]), cw = bf2f(row[192 + lane]), ca = bf2f(row[256 + lane]);
      const float pr = bf2f(prw[lane]), pk = bf2f(prw[64 + lane]), pv = bf2f(prw[128 + lane]), pw = bf2f(prw[192 + lane]), pa = bf2f(prw[256 + lane]);
      s_r[tl * LS + lane] = cr + (pr - cr) * mix_r;
      s_k[tl * LS + lane] = ck + (pk - ck) * mix_k;
      s_twb[tl * 72 + lane] = f2bf(fast_tanh(cw + (pw - cw) * mix_w));
      s_pab[tl * 72 + lane] = f2bf(ca + (pa - ca) * mix_a);
      const float vv = cv + (pv - cv) * mix_v;
      rec[REC_VB + (lane >> 4) * 256 + (16 * (tl >> 2) + (lane & 15)) * 4 + (tl & 3)] = f2bf(vv);
    }
  }
  __syncthreads();
  {
    const bf16x8 aw0 = *(const bf16x8*)(s_twb + i * 72 + 8 * g), aw1 = *(const bf16x8*)(s_twb + i * 72 + 32 + 8 * g);
    const bf16x8 aa0 = *(const bf16x8*)(s_pab + i * 72 + 8 * g), aa1 = *(const bf16x8*)(s_pab + i * 72 + 32 + 8 * g);
    f32x4 xw = (f32x4){0.f, 0.f, 0.f, 0.f}, xa = (f32x4){0.f, 0.f, 0.f, 0.f};
    xw = __builtin_amdgcn_mfma_f32_16x16x32_bf16(aw0, bd0, xw, 0, 0, 0);
    xw = __builtin_amdgcn_mfma_f32_16x16x32_bf16(aw1, bd1, xw, 0, 0, 0);
    xa = __builtin_amdgcn_mfma_f32_16x16x32_bf16(aa0, bi0, xa, 0, 0, 0);
    xa = __builtin_amdgcn_mfma_f32_16x16x32_bf16(aa1, bi1, xa, 0, 0, 0);
#pragma unroll
    for (int j = 0; j < 4; ++j) {
      s_xw[(4 * g + j) * LS + 16 * tt + i] = xw[j];
      s_xa[(4 * g + j) * LS + 16 * tt + i] = xa[j];
    }
  }
  __syncthreads();
  {
#pragma unroll
    for (int q = 0; q < 4; ++q) {
      const int tl = tt + 4 * q;
      const float z = -(dbase + s_xw[tl * LS + lane]);
      const float sp = fmaxf(z, 0.f) + __logf(1.f + __expf(-fabsf(z)));
      const float lwv = -__expf(-sp - 0.5f);
      const float a = 1.f / (1.f + __expf(-(ibase + s_xa[tl * LS + lane])));
      const float pk = s_k[tl * LS + lane];
      const float kkr = pk * kns;
      const float ss = wave_sum(kkr * kkr);
      const float kk = kkr * rsqrtf(fmaxf(ss, 1e-24f));
      const float kmod = pk * (1.f + (a - 1.f) * kim);
      s_lw[tl * LS + lane] = lwv;
      s_k[tl * LS + lane] = kmod;
      s_an[tl * LS + lane] = -kk;
      s_b[tl * LS + lane] = kk * a;
      const float rk = wave_sum(s_r[tl * LS + lane] * kmod * bon);
      if (lane == 0) ((float*)(recb + REC_RKB_B))[tl] = rk;
    }
  }
  __syncthreads();
  {
    float run = 0.f, LWp[4], LW[4];
#pragma unroll
    for (int s2 = 0; s2 < 16; ++s2) {
      const float x = s_lw[s2 * LS + lane];
      if ((s2 & 3) == tt) { LWp[s2 >> 2] = run; LW[s2 >> 2] = run + x; }
      run += x;
    }
    const float LWC = run;
    if (tt == 0) ((float*)(recb + REC_WC_B))[lane] = __expf(LWC);
#pragma unroll
    for (int q = 0; q < 4; ++q) {
      const int tl = tt + 4 * q;
      const float e_p = __expf(LWp[q]), e_n = __expf(-LW[q]), e_r = __expf(LW[q]), e_c = __expf(LWC - LW[q]);
      const float an = s_an[tl * LS + lane], bb = s_b[tl * LS + lane], kmod = s_k[tl * LS + lane], rr = s_r[tl * LS + lane];
      s_at[tl * LS + lane] = an * e_p;
      s_bt[tl * LS + lane] = bb * e_n;
      s_kt[tl * LS + lane] = kmod * e_n;
      const float rt = rr * e_r;
      s_rt[tl * LS + lane] = rt;
      const int bkaddr = REC_BK + (lane >> 4) * 512 + (16 * (tl >> 2) + (lane & 15)) * 8 + (tl & 3);
      rec[bkaddr] = f2bf(bb * e_c);
      rec[bkaddr + 4] = f2bf(kmod * e_c);
      const int k5 = lane & 31;
      rec[REC_R + (lane >> 5) * 512 + (16 * ((k5 & 15) >> 2) + tl) * 8 + (k5 & 3) + 4 * (k5 >> 4)] = f2bf(rt);
    }
  }
  __syncthreads();
  {
    const float* X = (tt < 2) ? s_at : s_rt;
    const float* Y = (tt & 1) ? s_kt : s_bt;
    const bf16x8 a0 = cvt8(X + i * LS + 8 * g), a1 = cvt8(X + i * LS + 32 + 8 * g);
    const bf16x8 b0 = cvt8(Y + i * LS + 8 * g), b1 = cvt8(Y + i * LS + 32 + 8 * g);
    f32x4 acc = (f32x4){0.f, 0.f, 0.f, 0.f};
    acc = __builtin_amdgcn_mfma_f32_16x16x32_bf16(a0, b0, acc, 0, 0, 0);
    acc = __builtin_amdgcn_mfma_f32_16x16x32_bf16(a1, b1, acc, 0, 0, 0);
#pragma unroll
    for (int j = 0; j < 4; ++j) {
      const int t = 4 * g + j, s2 = i;
      const bool keep = (tt < 2) ? (s2 < t) : (s2 <= t);
      const float val = keep ? acc[j] : 0.f;
      if (tt == 0) s_Aab[t * 17 + s2] = val;
      else if (tt == 1) s_Aak[t * 17 + s2] = val;
      else rec[REC_AR + (16 * (s2 >> 2) + t) * 8 + (s2 & 3) + 4 * (tt & 1)] = f2bf(val);
    }
  }
  __syncthreads();
  if (tid < 80) {
    float X[16];
#pragma unroll
    for (int t = 0; t < 16; ++t) {
      float val = (tid < 64) ? s_at[t * LS + tid] : s_Aak[t * 17 + (tid - 64)];
#pragma unroll
      for (int s2 = 0; s2 < t; ++s2) val += s_Aab[t * 17 + s2] * X[s2];
      X[t] = val;
    }
    if (tid < 64) {
      const int k5 = tid & 31;
      const int base = REC_M1 + (tid >> 5) * 512 + (16 * ((k5 & 15) >> 2)) * 8 + (k5 & 3) + 4 * (k5 >> 4);
#pragma unroll
      for (int t = 0; t < 16; ++t) rec[base + t * 8] = f2bf(X[t]);
    } else {
      const int s2 = tid - 64;
      const int base = REC_TA + (16 * (s2 >> 2)) * 8 + (s2 & 3);
#pragma unroll
      for (int t = 0; t < 16; ++t) { rec[base + t * 8] = f2bf(X[t]); rec[base + t * 8 + 4] = 0; }
    }
  }
  __syncthreads();
  {
    const uint4* srcv = (const uint4*)rec;
    uint4* dstv = (uint4*)recb;
#pragma unroll
    for (int u = 0; u < 3; ++u) dstv[tid + 256 * u] = srcv[tid + 256 * u];
  }
#pragma unroll
  for (int u = 0; u < 3; ++u) if (prow[u] >= 0) *(uint4*)(s_raw + plds[u]) = pre[u];
  __syncthreads();
  }
#undef RP_PREFETCH
}


#define WAVE_FENCE() do { __builtin_amdgcn_wave_barrier(); asm volatile("s_waitcnt lgkmcnt(0)" ::: "memory"); __builtin_amdgcn_wave_barrier(); } while (0)
__device__ void rwkv_prep_waves(const Params& P, int vb, unsigned char* ldsb) {
  const int tid = threadIdx.x, lane = tid & 63, w = tid >> 6, g = lane >> 4, i = lane & 15;
  const int bh = vb >> 2, b = bh >> 3, h = bh & 7;
  bf16_t* s_du = (bf16_t*)ldsb;
  bf16_t* s_iu = s_du + 64 * 72;
  __syncthreads();
  {
    const int row = tid >> 3, pc = tid & 7;
    *(uint4*)(s_du + row * 72 + pc * 8) = *(const uint4*)(P.dut + (size_t)(h * 64 + row) * 64 + pc * 8);
    *(uint4*)(s_iu + row * 72 + pc * 8) = *(const uint4*)(P.iut + (size_t)(h * 64 + row) * 64 + pc * 8);
  }
  __syncthreads();
  unsigned char* wb = ldsb + 18432 + w * 16384;
  bf16_t* s_twb = (bf16_t*)wb;              bf16_t* s_pab = s_twb + 16 * 72;
  float* s_xw = (float*)(wb + 4608);        float* s_xa = s_xw + 16 * 68;
  bf16_t* im_a = (bf16_t*)(wb + 4608);      bf16_t* im_b = im_a + 1152; bf16_t* im_k = im_b + 1152; bf16_t* im_r = im_k + 1152;
  bf16_t* im_m1 = (bf16_t*)wb;              bf16_t* arim = (bf16_t*)(wb + 2304); bf16_t* taim = (bf16_t*)(wb + 3328);
  float* s_Aab = (float*)(wb + 14208);      float* s_Aak = s_Aab + 272;
  const int c = h * 64 + lane;
  const float mix_r = P.shift_mix[OFF_R + c], mix_k = P.shift_mix[OFF_K + c], mix_v = P.shift_mix[OFF_V + c];
  const float mix_w = P.shift_mix[OFF_WLO + lane], mix_a = P.shift_mix[OFF_ALO + lane];
  const float dbase = P.decay_base[c], ibase = P.iclr_base[c], kns = P.key_norm_scale[c], kim = P.key_iclr_mix[c], bon = P.bonus[c];
  const bf16_t* pb = P.p + (size_t)(b * SEQ) * NIN;
  bf16_t* rawb = (bf16_t*)(wb + 4608);
  u32x4 pre[11];
#define RAWP_LOAD(chn) do { int lane_o = lane; asm volatile("" : "+v"(lane_o)); _Pragma("unroll") for (int u = 0; u < 11; ++u) { int q_ = lane_o + 64 * u; q_ = (q_ < 680) ? q_ : 679; \
    const int rr_ = q_ / 40, qq_ = q_ - rr_ * 40, cg_ = qq_ >> 3, sub_ = qq_ & 7; int t_ = (chn) * 16 - 1 + rr_; t_ = (t_ < 0) ? 0 : t_; \
    const int col_ = ((cg_ < 3) ? (cg_ * 512 + h * 64) : (cg_ == 3 ? OFF_WLO : OFF_ALO)) + sub_ * 8; \
    pre[u] = ld_nt(pb + (size_t)t_ * NIN + col_); } } while (0)
  RAWP_LOAD((vb & 3) * 64 + w);
  for (int k8 = 0; k8 < 8; ++k8) {
    const int ch = (vb & 3) * 64 + w + 8 * k8;
    const int t0 = ch * 16;
    char* recb = P.rec + (size_t)(bh * 256 + ch) * REC_BYTES;
    float r[16], an[16], bb[16], km[16], LW[16];
    int lane_o2 = lane; asm volatile("" : "+v"(lane_o2));
#pragma unroll
    for (int u = 0; u < 11; ++u) {
      const int q = lane_o2 + 64 * u, rr = q / 40, qq = q - rr * 40, cg = qq >> 3, sub = qq & 7;
      u32x4 val = pre[u];
      if (t0 == 0 && rr == 0) val = (u32x4){0u, 0u, 0u, 0u};
      if (q < 680) *(u32x4*)(rawb + rr * 328 + cg * 64 + sub * 8) = val;
    }
    WAVE_FENCE();
    {
      float pr = bf2f(rawb[lane]), pk = bf2f(rawb[64 + lane]), pv = bf2f(rawb[128 + lane]), pw = bf2f(rawb[192 + lane]), pa = bf2f(rawb[256 + lane]);
      float vv[16];
#pragma unroll
      for (int t = 0; t < 16; ++t) {
        const bf16_t* row = rawb + (t + 1) * 328;
        const float cr = bf2f(row[lane]), ck = bf2f(row[64 + lane]), cv = bf2f(row[128 + lane]), cw = bf2f(row[192 + lane]), ca = bf2f(row[256 + lane]);
        r[t] = cr + (pr - cr) * mix_r;
        km[t] = ck + (pk - ck) * mix_k;
        vv[t] = cv + (pv - cv) * mix_v;
        s_twb[t * 72 + lane] = f2bf(fast_tanh(cw + (pw - cw) * mix_w));
        s_pab[t * 72 + lane] = f2bf(ca + (pa - ca) * mix_a);
        pr = cr; pk = ck; pv = cv; pw = cw; pa = ca;
      }
#pragma unroll
      for (int g2 = 0; g2 < 4; ++g2) {
        typedef unsigned u32x2_t __attribute__((ext_vector_type(2)));
        u32x2_t o; o.x = pk_bf16(vv[4 * g2], vv[4 * g2 + 1]); o.y = pk_bf16(vv[4 * g2 + 2], vv[4 * g2 + 3]);
        *(u32x2_t*)(recb + 10240 + (lane >> 4) * 512 + (16 * g2 + (lane & 15)) * 8) = o;
      }
    }
    WAVE_FENCE();
    {
      const bf16x8 aw0 = *(const bf16x8*)(s_twb + i * 72 + 8 * g), aw1 = *(const bf16x8*)(s_twb + i * 72 + 32 + 8 * g);
      const bf16x8 aa0 = *(const bf16x8*)(s_pab + i * 72 + 8 * g), aa1 = *(const bf16x8*)(s_pab + i * 72 + 32 + 8 * g);
#pragma unroll
      for (int nt = 0; nt < 4; ++nt) {
        const bf16x8 bd0 = *(const bf16x8*)(s_du + (16 * nt + i) * 72 + 8 * g), bd1 = *(const bf16x8*)(s_du + (16 * nt + i) * 72 + 32 + 8 * g);
        const bf16x8 bi0 = *(const bf16x8*)(s_iu + (16 * nt + i) * 72 + 8 * g), bi1 = *(const bf16x8*)(s_iu + (16 * nt + i) * 72 + 32 + 8 * g);
        f32x4 xw = (f32x4){0.f, 0.f, 0.f, 0.f}, xa = (f32x4){0.f, 0.f, 0.f, 0.f};
        xw = __builtin_amdgcn_mfma_f32_16x16x32_bf16(aw0, bd0, xw, 0, 0, 0);
        xw = __builtin_amdgcn_mfma_f32_16x16x32_bf16(aw1, bd1, xw, 0, 0, 0);
        xa = __builtin_amdgcn_mfma_f32_16x16x32_bf16(aa0, bi0, xa, 0, 0, 0);
        xa = __builtin_amdgcn_mfma_f32_16x16x32_bf16(aa1, bi1, xa, 0, 0, 0);
#pragma unroll
        for (int j = 0; j < 4; ++j) {
          s_xw[(4 * g + j) * 68 + 16 * nt + i] = xw[j];
          s_xa[(4 * g + j) * 68 + 16 * nt + i] = xa[j];
        }
      }
    }
    WAVE_FENCE();
    {
      float run = 0.f, myrk = 0.f;
#pragma unroll
      for (int t = 0; t < 16; ++t) {
        const float lwv = -0.6065306597126334f * __builtin_amdgcn_rcpf(1.f + __expf(-(dbase + s_xw[t * 68 + lane])));
        const float a = __builtin_amdgcn_rcpf(1.f + __expf(-(ibase + s_xa[t * 68 + lane])));
        const float pk = km[t];
        const float kkr = pk * kns;
        const float ss = wave_sum(kkr * kkr);
        const float kk = kkr * rsqrtf(fmaxf(ss, 1e-24f));
        const float kmod = pk * (1.f + (a - 1.f) * kim);
        km[t] = kmod; an[t] = -kk; bb[t] = kk * a;
        run += lwv; LW[t] = run;
        const float rk = wave_sum(r[t] * kmod * bon);
        if (lane == t) myrk = rk;
        if ((t & 7) == 7) __builtin_amdgcn_sched_barrier(0);
      }
      if (lane < 16) ((float*)(recb + REC_RKB_B))[lane] = myrk;
    }
    WAVE_FENCE();
    {
      const float LWC = LW[15];
      const float ewc = __expf(LWC);
      float e_prev = 1.f;
      ((float*)(recb + REC_WC_B))[lane] = ewc;
#pragma unroll
      for (int g2 = 0; g2 < 4; ++g2) {
        float Bp[4], Kp[4];
#pragma unroll
        for (int j = 0; j < 4; ++j) {
          const int t = 4 * g2 + j;
          const float e_p = e_prev, e_n = __expf(-LW[t]), e_r = __builtin_amdgcn_rcpf(e_n), e_c = ewc * e_n;
          e_prev = e_r;
          const float at = an[t] * e_p;
          an[t] = at;
          im_a[t * 72 + lane] = f2bf(at);
          im_b[t * 72 + lane] = f2bf(bb[t] * e_n);
          im_k[t * 72 + lane] = f2bf(km[t] * e_n);
          im_r[t * 72 + lane] = f2bf(r[t] * e_r);
          Bp[j] = bb[t] * e_c; Kp[j] = km[t] * e_c;
        }
        u32x4 o; o.x = pk_bf16(Bp[0], Bp[1]); o.y = pk_bf16(Bp[2], Bp[3]); o.z = pk_bf16(Kp[0], Kp[1]); o.w = pk_bf16(Kp[2], Kp[3]);
        *(u32x4*)(recb + 4096 + (lane >> 4) * 1024 + (16 * g2 + (lane & 15)) * 16) = o;
      }
    }
    WAVE_FENCE();
    { const int chn = (k8 < 7) ? ch + 8 : ch; RAWP_LOAD(chn); }
    float abm0, abm1, abm2, abm3;
    {
      const bf16x8 fa0 = *(const bf16x8*)(im_a + i * 72 + 8 * g), fa1 = *(const bf16x8*)(im_a + i * 72 + 32 + 8 * g);
      const bf16x8 fr0 = *(const bf16x8*)(im_r + i * 72 + 8 * g), fr1 = *(const bf16x8*)(im_r + i * 72 + 32 + 8 * g);
      const bf16x8 fb0 = *(const bf16x8*)(im_b + i * 72 + 8 * g), fb1 = *(const bf16x8*)(im_b + i * 72 + 32 + 8 * g);
      const bf16x8 fk0 = *(const bf16x8*)(im_k + i * 72 + 8 * g), fk1 = *(const bf16x8*)(im_k + i * 72 + 32 + 8 * g);
      const f32x4 z4 = (f32x4){0.f, 0.f, 0.f, 0.f};
      f32x4 ab = __builtin_amdgcn_mfma_f32_16x16x32_bf16(fa0, fb0, z4, 0, 0, 0); ab = __builtin_amdgcn_mfma_f32_16x16x32_bf16(fa1, fb1, ab, 0, 0, 0);
      f32x4 ak = __builtin_amdgcn_mfma_f32_16x16x32_bf16(fa0, fk0, z4, 0, 0, 0); ak = __builtin_amdgcn_mfma_f32_16x16x32_bf16(fa1, fk1, ak, 0, 0, 0);
      f32x4 rb = __builtin_amdgcn_mfma_f32_16x16x32_bf16(fr0, fb0, z4, 0, 0, 0); rb = __builtin_amdgcn_mfma_f32_16x16x32_bf16(fr1, fb1, rb, 0, 0, 0);
      f32x4 rk = __builtin_amdgcn_mfma_f32_16x16x32_bf16(fr0, fk0, z4, 0, 0, 0); rk = __builtin_amdgcn_mfma_f32_16x16x32_bf16(fr1, fk1, rk, 0, 0, 0);
      abm0 = (i < 4 * g + 0) ? ab[0] : 0.f; abm1 = (i < 4 * g + 1) ? ab[1] : 0.f;
      abm2 = (i < 4 * g + 2) ? ab[2] : 0.f; abm3 = (i < 4 * g + 3) ? ab[3] : 0.f;
#pragma unroll
      for (int j = 0; j < 4; ++j) {
        const int t = 4 * g + j, s2 = i;
        s_Aak[t * 17 + s2] = (s2 < t) ? ak[j] : 0.f;
        const int ara = (16 * (s2 >> 2) + t) * 8 + (s2 & 3);
        arim[ara] = f2bf((s2 <= t) ? rb[j] : 0.f);
        arim[ara + 4] = f2bf((s2 <= t) ? rk[j] : 0.f);
      }
    }
    WAVE_FENCE();
    {
      float X[16], Y[16];
      const int sc = lane & 15;
#pragma unroll
      for (int t = 0; t < 16; ++t) {
        float v1 = an[t], v2 = s_Aak[t * 17 + sc];
        const float arow = ((t & 3) == 0) ? abm0 : ((t & 3) == 1) ? abm1 : ((t & 3) == 2) ? abm2 : abm3;
#pragma unroll
        for (int s2 = 0; s2 < t; ++s2) {
          const float cf = __builtin_bit_cast(float, __builtin_amdgcn_readlane(__builtin_bit_cast(int, arow), 16 * (t >> 2) + s2));
          v1 += cf * X[s2]; v2 += cf * Y[s2];
        }
        X[t] = v1; Y[t] = v2;
        im_m1[t * 72 + lane] = f2bf(v1);
        if (lane < 16) { const int ta = (16 * (sc >> 2) + t) * 8 + (sc & 3); taim[ta] = f2bf(v2); taim[ta + 4] = 0; }
        __builtin_amdgcn_sched_barrier(0);
      }
    }
    WAVE_FENCE();
    {
      typedef unsigned u32x2_t __attribute__((ext_vector_type(2)));
#pragma unroll
      for (int ks = 0; ks < 2; ++ks) {
        const u32x2_t ml = *(const u32x2_t*)(im_m1 + i * 72 + 32 * ks + 4 * g), mh = *(const u32x2_t*)(im_m1 + i * 72 + 32 * ks + 16 + 4 * g);
        const u32x2_t rl = *(const u32x2_t*)(im_r + i * 72 + 32 * ks + 4 * g), rh = *(const u32x2_t*)(im_r + i * 72 + 32 * ks + 16 + 4 * g);
        u32x4 mo; mo.x = ml.x; mo.y = ml.y; mo.z = mh.x; mo.w = mh.y;
        u32x4 ro; ro.x = rl.x; ro.y = rl.y; ro.z = rh.x; ro.w = rh.y;
        *(u32x4*)(recb + ks * 1024 + lane * 16) = mo;
        *(u32x4*)(recb + 2048 + ks * 1024 + lane * 16) = ro;
      }
      *(u32x4*)(recb + 8192 + lane * 16) = *(const u32x4*)(taim + lane * 8);
      *(u32x4*)(recb + 9216 + lane * 16) = *(const u32x4*)(arim + lane * 8);
    }
    WAVE_FENCE();
  }
#undef RAWP_LOAD
}

constexpr int SCAN_SLOT = 13312, SCAN_D = 10;
__device__ void rwkv_scan_block(const Params& P, int bh, LAS unsigned char* lds) {
  const int tid = threadIdx.x, wave = __builtin_amdgcn_readfirstlane(tid >> 6), lane = tid & 63;
  const char* rec0 = P.rec + (size_t)(bh * 256) * REC_BYTES;
  if (wave >= 2) {
    const int lw = wave - 2;
    const char* src0 = rec0 + lw * 2048 + lane * 16;
#define SCAN_ISSUE(chsrc, slot) do { const char* src_ = src0 + (size_t)(chsrc) * REC_BYTES; LAS unsigned char* dst_ = lds + (slot) * SCAN_SLOT + lw * 2048; \
    _Pragma("unroll") for (int u_ = 0; u_ < 2; ++u_) __builtin_amdgcn_global_load_lds((const unsigned*)(src_ + u_ * 1024), (LAS unsigned*)(dst_ + u_ * 1024), 16, 0, 2); \
    if (lw == 0) __builtin_amdgcn_global_load_lds((const unsigned*)(src_ + 12288), (LAS unsigned*)(dst_ + 12288), 16, 0, 2); } while (0)
#define SCAN_WAITBAR() do { if (lw == 0) asm volatile("s_waitcnt vmcnt(21)\n\ts_barrier" ::: "memory"); else asm volatile("s_waitcnt vmcnt(14)\n\ts_barrier" ::: "memory"); } while (0)
#pragma unroll
    for (int c0 = 0; c0 < SCAN_D - 1; ++c0) SCAN_ISSUE(c0, c0);
    SCAN_WAITBAR();
    int slot = SCAN_D - 1;
    for (int ch = 0; ch < 256; ++ch) {
      const int nx = ch + SCAN_D - 1;
      SCAN_ISSUE((nx < 256 ? nx : 255), slot);
      slot = (slot == SCAN_D - 1) ? 0 : slot + 1;
      SCAN_WAITBAR();
    }
    asm volatile("s_waitcnt vmcnt(0)" ::: "memory");
#undef SCAN_ISSUE
#undef SCAN_WAITBAR
  } else {
    const int b = bh >> 3, h = bh & 7, cw = wave, g = lane >> 4, i = lane & 15;
    f32x4 sa[4], sbt[4];
#pragma unroll
    for (int kt = 0; kt < 4; ++kt) { sa[kt] = (f32x4){0.f, 0.f, 0.f, 0.f}; sbt[kt] = (f32x4){0.f, 0.f, 0.f, 0.f}; }
    const f32x4 zero4 = (f32x4){0.f, 0.f, 0.f, 0.f};
    typedef unsigned u32x2_t __attribute__((ext_vector_type(2)));
    struct Fr { u32x4 m1f0, m1f1, rf0, rf1, bk0, bk1, bk2, bk3, taf, arf; u32x2_t va, vb2; f32x4 wc0, wc1, wc2, wc3; };
#define SCAN_FR(F, slotv) do { const LAS unsigned char* sl_ = lds + (slotv) * SCAN_SLOT; const LAS u32x4* fr_ = (const LAS u32x4*)sl_; \
      F.m1f0 = fr_[lane]; F.m1f1 = fr_[64 + lane]; F.rf0 = fr_[128 + lane]; F.rf1 = fr_[192 + lane]; \
      F.bk0 = fr_[256 + lane]; F.bk1 = fr_[320 + lane]; F.bk2 = fr_[384 + lane]; F.bk3 = fr_[448 + lane]; F.taf = fr_[512 + lane]; F.arf = fr_[576 + lane]; \
      F.va = *(const LAS u32x2_t*)(sl_ + 10240 + (2 * cw) * 512 + lane * 8); F.vb2 = *(const LAS u32x2_t*)(sl_ + 10240 + (2 * cw + 1) * 512 + lane * 8); \
      const LAS f32x4* wc_ = (const LAS f32x4*)(sl_ + REC_WC_B); F.wc0 = wc_[g]; F.wc1 = wc_[4 + g]; F.wc2 = wc_[8 + g]; F.wc3 = wc_[12 + g]; } while (0)
#define SCAN_TILE(F, S, VBL, vtv, chv) do { \
      u32x4 sb0, sb1; \
      sb0.x = pk_bf16(S[0][0], S[0][1]); sb0.y = pk_bf16(S[0][2], S[0][3]); sb0.z = pk_bf16(S[1][0], S[1][1]); sb0.w = pk_bf16(S[1][2], S[1][3]); \
      sb1.x = pk_bf16(S[2][0], S[2][1]); sb1.y = pk_bf16(S[2][2], S[2][3]); sb1.z = pk_bf16(S[3][0], S[3][1]); sb1.w = pk_bf16(S[3][2], S[3][3]); \
      u32x4 vbz; vbz.x = VBL.x; vbz.y = VBL.y; vbz.z = 0u; vbz.w = 0u; \
      f32x4 u = __builtin_amdgcn_mfma_f32_16x16x32_bf16(as_frag(F.taf), as_frag(vbz), zero4, 0, 0, 0); \
      u = __builtin_amdgcn_mfma_f32_16x16x32_bf16(as_frag(F.m1f0), as_frag(sb0), u, 0, 0, 0); \
      u = __builtin_amdgcn_mfma_f32_16x16x32_bf16(as_frag(F.m1f1), as_frag(sb1), u, 0, 0, 0); \
      u32x4 uvb; uvb.x = pk_bf16(u[0], u[1]); uvb.y = pk_bf16(u[2], u[3]); uvb.z = VBL.x; uvb.w = VBL.y; \
      f32x4 y = __builtin_amdgcn_mfma_f32_16x16x32_bf16(as_frag(F.rf0), as_frag(sb0), zero4, 0, 0, 0); \
      y = __builtin_amdgcn_mfma_f32_16x16x32_bf16(as_frag(F.rf1), as_frag(sb1), y, 0, 0, 0); \
      y = __builtin_amdgcn_mfma_f32_16x16x32_bf16(as_frag(F.arf), as_frag(uvb), y, 0, 0, 0); \
      S[0] = __builtin_amdgcn_mfma_f32_16x16x32_bf16(as_frag(F.bk0), as_frag(uvb), S[0] * F.wc0, 0, 0, 0); \
      S[1] = __builtin_amdgcn_mfma_f32_16x16x32_bf16(as_frag(F.bk1), as_frag(uvb), S[1] * F.wc1, 0, 0, 0); \
      S[2] = __builtin_amdgcn_mfma_f32_16x16x32_bf16(as_frag(F.bk2), as_frag(uvb), S[2] * F.wc2, 0, 0, 0); \
      S[3] = __builtin_amdgcn_mfma_f32_16x16x32_bf16(as_frag(F.bk3), as_frag(uvb), S[3] * F.wc3, 0, 0, 0); \
      _Pragma("unroll") for (int j = 0; j < 4; ++j) (ystage + ((chv) & 1) * 512)[(4 * g + j) * 32 + 16 * ((vtv) & 1) + i] = f2bf(y[j]); } while (0)
#define SCAN_YOUT(chprev) do { const u32x4 yv_ = *(const LAS u32x4*)(ystage + ((chprev) & 1) * 512 + (lane >> 2) * 32 + (lane & 3) * 8); \
      *(u32x4*)(P.yraw + (size_t)(b * SEQ + (chprev) * 16 + (lane >> 2)) * 512 + h * 64 + 32 * cw + (lane & 3) * 8) = yv_; } while (0)
#define SCAN_STEP(F, chv) do { if ((chv) > 0) SCAN_YOUT((chv) - 1); SCAN_TILE(F, sa, F.va, 2 * cw, chv); SCAN_TILE(F, sbt, F.vb2, 2 * cw + 1, chv); } while (0)
    LAS bf16_t* ystage = (LAS bf16_t*)(lds + SCAN_D * SCAN_SLOT + cw * 2048);
    Fr FA, FB;
    asm volatile("s_barrier" ::: "memory");
    SCAN_FR(FA, 0);
    int slot = 1;
    for (int ch = 0; ch < 256; ch += 2) {
      SCAN_FR(FB, slot); slot = (slot == SCAN_D - 1) ? 0 : slot + 1;
      SCAN_STEP(FA, ch);
      asm volatile("s_waitcnt lgkmcnt(0)\n\ts_barrier" ::: "memory");
      SCAN_FR(FA, slot); slot = (slot == SCAN_D - 1) ? 0 : slot + 1;
      SCAN_STEP(FB, ch + 1);
      asm volatile("s_waitcnt lgkmcnt(0)\n\ts_barrier" ::: "memory");
    }
    SCAN_YOUT(255);
#undef SCAN_YOUT
#undef SCAN_FR
#undef SCAN_TILE
#undef SCAN_STEP
  }
  __syncthreads();
}

#ifndef ATT_TR
#define ATT_TR 1
#endif
constexpr int ATT_ITEMS = 64 * 3 * 32;
constexpr int KV_LD = 72;
typedef short v4i16_t __attribute__((ext_vector_type(4)));
__device__ __forceinline__ bf16x8 vfrag(const bf16_t* sV, int row0, int row1, int g, int i, int mt) {
  bf16x8 a;
#if ATT_TR
  typedef __attribute__((address_space(3))) v4i16_t* ldsp;
  const v4i16_t lo = __builtin_amdgcn_ds_read_tr16_b64_v4i16((ldsp)(sV + (row0 + 4 * g + (i >> 2)) * KV_LD + 16 * mt + 4 * (i & 3)));
  const v4i16_t hi = __builtin_amdgcn_ds_read_tr16_b64_v4i16((ldsp)(sV + (row1 + 4 * g + (i >> 2)) * KV_LD + 16 * mt + 4 * (i & 3)));
#pragma unroll
  for (int j = 0; j < 4; ++j) { a[j] = lo[j]; a[4 + j] = hi[j]; }
#else
#pragma unroll
  for (int j = 0; j < 4; ++j) {
    a[j] = (short)sV[(row0 + 4 * g + j) * KV_LD + 16 * mt + i];
    a[4 + j] = (short)sV[(row1 + 4 * g + j) * KV_LD + 16 * mt + i];
  }
#endif
  return a;
}
constexpr int ATT_ROWS = 256;
struct AttnRegs { u32x4 k0, k1, k2, k3, k4, k5, k6, k7, v0, v1, v2, v3, v4, v5, v6, v7; bf16x8 qa0, qa1, qb0, qb1; };
__device__ __forceinline__ void attn_load(const Params& P, int item, const int tid, AttnRegs& R) {
  const int lane = tid & 63, w = tid >> 6, g = lane >> 4, i = lane & 15;
  const int bh = item / 96, rem = item % 96, pat = rem >> 5, idx = rem & 31;
  const int b = bh >> 3, h = bh & 7;
  const int sh = 2 * pat, dil = 1 << sh;
  const int rho = idx & (dil - 1), qt = idx >> sh;
  const bf16_t* pb = P.p + (size_t)(b * SEQ) * NIN;
#define ATT_LD(u, KK, VV) do { const int c_ = tid + 256 * (u), row_ = c_ >> 3, cc_ = c_ & 7; int ik_ = 128 * qt - 128 + row_; if (ik_ < 0) ik_ = 0; \
    const bf16_t* src_ = pb + (size_t)(rho + (ik_ << sh)) * NIN + h * 64 + cc_ * 8; KK = *(const u32x4*)(src_ + OFF_KB); VV = *(const u32x4*)(src_ + OFF_VB); } while (0)
  ATT_LD(0, R.k0, R.v0); ATT_LD(1, R.k1, R.v1); ATT_LD(2, R.k2, R.v2); ATT_LD(3, R.k3, R.v3);
  ATT_LD(4, R.k4, R.v4); ATT_LD(5, R.k5, R.v5); ATT_LD(6, R.k6, R.v6); ATT_LD(7, R.k7, R.v7);
#undef ATT_LD
  const int qposa = rho + ((128 * qt + 32 * w + i) << sh);
  const bf16_t* qsrc = pb + (size_t)qposa * NIN + OFF_Q + h * 64 + 8 * g;
  R.qa0 = *(const bf16x8*)(qsrc); R.qa1 = *(const bf16x8*)(qsrc + 32);
  const bf16_t* qsrb = qsrc + (size_t)(16 << sh) * NIN;
  R.qb0 = *(const bf16x8*)(qsrb); R.qb1 = *(const bf16x8*)(qsrb + 32);
}
__device__ __forceinline__ void attn_stage(float* sm, const int tid, const AttnRegs& R) {
  bf16_t* sK = (bf16_t*)sm;
  bf16_t* sV = sK + ATT_ROWS * KV_LD;
#define ATT_ST(u, KK, VV) do { const int c_ = tid + 256 * (u), row_ = c_ >> 3, cc_ = c_ & 7; *(u32x4*)(sK + row_ * KV_LD + cc_ * 8) = KK; *(u32x4*)(sV + row_ * KV_LD + cc_ * 8) = VV; } while (0)
  ATT_ST(0, R.k0, R.v0); ATT_ST(1, R.k1, R.v1); ATT_ST(2, R.k2, R.v2); ATT_ST(3, R.k3, R.v3);
  ATT_ST(4, R.k4, R.v4); ATT_ST(5, R.k5, R.v5); ATT_ST(6, R.k6, R.v6); ATT_ST(7, R.k7, R.v7);
#undef ATT_ST
}
__device__ __forceinline__ void attn_compute(const Params& P, int item, float* sm, const int tid, const int weff, const bf16x8 qf0, const bf16x8 qf1) {
  bf16_t* sK = (bf16_t*)sm;
  bf16_t* sV = sK + ATT_ROWS * KV_LD;
  const int lane = tid & 63, g = lane >> 4, i = lane & 15;
  const int bh = item / 96, rem = item % 96, pat = rem >> 5, idx = rem & 31;
  const int b = bh >> 3, h = bh & 7;
  const int sh = 2 * pat, dil = 1 << sh;
  const int rho = idx & (dil - 1), qt = idx >> sh;
  const int qpos = rho + ((128 * qt + 16 * weff + i) << sh);
  f32x4 st[9];
#pragma unroll
  for (int kt = 0; kt < 9; ++kt) {
    const bf16_t* kr = sK + (16 * (weff + kt) + i) * KV_LD + 8 * g;
    f32x4 acc = (f32x4){0.f, 0.f, 0.f, 0.f};
    acc = __builtin_amdgcn_mfma_f32_16x16x32_bf16(*(const bf16x8*)(kr), qf0, acc, 0, 0, 0);
    acc = __builtin_amdgcn_mfma_f32_16x16x32_bf16(*(const bf16x8*)(kr + 32), qf1, acc, 0, 0, 0);
    st[kt] = acc;
  }
  float mx = -INFINITY;
#pragma unroll
  for (int j = 0; j < 4; ++j) {
    if (4 * g + j < i) st[0][j] = -INFINITY;
    if (4 * g + j > i) st[8][j] = -INFINITY;
  }
  if (qt == 0) {
#pragma unroll
    for (int kt = 0; kt < 9; ++kt)
#pragma unroll
      for (int j = 0; j < 4; ++j) if (16 * (weff + kt) + 4 * g + j < 128) st[kt][j] = -INFINITY;
  }
#pragma unroll
  for (int kt = 0; kt < 9; ++kt)
#pragma unroll
    for (int j = 0; j < 4; ++j) mx = fmaxf(mx, st[kt][j]);
  mx = fmaxf(mx, __shfl_xor(mx, 16));
  mx = fmaxf(mx, __shfl_xor(mx, 32));
  constexpr float C2 = 0.125f * 1.4426950408889634f;
  const float nm2 = -mx * C2;
  float l = 0.f;
#pragma unroll
  for (int kt = 0; kt < 9; ++kt)
#pragma unroll
    for (int j = 0; j < 4; ++j) {
      const float pe = __builtin_amdgcn_exp2f(__builtin_fmaf(st[kt][j], C2, nm2));
      st[kt][j] = pe;
      l += pe;
    }
  l += __shfl_xor(l, 16);
  l += __shfl_xor(l, 32);
  f32x4 o[4];
#pragma unroll
  for (int mt = 0; mt < 4; ++mt) o[mt] = (f32x4){0.f, 0.f, 0.f, 0.f};
#pragma unroll
  for (int s2 = 0; s2 < 5; ++s2) {
    const int t0 = 2 * s2, t1 = (2 * s2 + 1 < 9) ? (2 * s2 + 1) : t0;
    u32x4 pw;
    pw.x = pk_bf16(st[t0][0], st[t0][1]); pw.y = pk_bf16(st[t0][2], st[t0][3]);
    pw.z = (2 * s2 + 1 < 9) ? pk_bf16(st[t1][0], st[t1][1]) : 0u; pw.w = (2 * s2 + 1 < 9) ? pk_bf16(st[t1][2], st[t1][3]) : 0u;
    const bf16x8 pbv = as_frag(pw);
#pragma unroll
    for (int mt = 0; mt < 4; ++mt) {
      const bf16x8 a = vfrag(sV, 16 * (weff + t0), 16 * (weff + t1), g, i, mt);
      o[mt] = __builtin_amdgcn_mfma_f32_16x16x32_bf16(a, pbv, o[mt], 0, 0, 0);
    }
  }
  const float rl = 1.f / l;
  const size_t bt = (size_t)(b * SEQ + qpos);
  bf16_t* od = P.p + bt * NIN + pat * 512 + h * 64 + 4 * g;
#pragma unroll
  for (int mt = 0; mt < 4; ++mt) {
    typedef unsigned u32x2_t __attribute__((ext_vector_type(2)));
    u32x2_t ov; ov.x = pk_bf16(o[mt][0] * rl, o[mt][1] * rl); ov.y = pk_bf16(o[mt][2] * rl, o[mt][3] * rl);
    *(u32x2_t*)(od + 16 * mt) = ov;
  }
  if (g == 0) ((float*)(P.p + bt * NIN + 1536))[pat * 8 + h] = mx * 0.125f + __logf(l);
}

constexpr int MERGE_ITEMS = MTOK * 8 * 8 / 512;
__device__ __forceinline__ void merge_one(const Params& P, const int gid, const bool scratch) {
  const int dg = gid & 7, h = (gid >> 3) & 7, bt = gid >> 6;
  bf16_t* prow = P.p + (size_t)bt * NIN;
  {
    const float* lse = (const float*)(prow + 1536);
    const float l0 = lse[h], l1 = lse[8 + h], l2 = lse[16 + h];
    const float m = fmaxf(l0, fmaxf(l1, l2));
    float w0 = __expf(l0 - m), w1 = __expf(l1 - m), w2 = __expf(l2 - m);
    const float rs = 1.f / (w0 + w1 + w2);
    w0 *= rs; w1 *= rs; w2 *= rs;
    const int off = h * 64 + dg * 8;
    const u32x4 a0 = ld_nt(prow + off), a1 = ld_nt(prow + 512 + off), a2 = ld_nt(prow + 1024 + off);
    const u32x4 zz = ld_nt(prow + OFF_ZB + off);
    const unsigned av0[4] = {a0.x, a0.y, a0.z, a0.w}, av1[4] = {a1.x, a1.y, a1.z, a1.w}, av2[4] = {a2.x, a2.y, a2.z, a2.w}, zv[4] = {zz.x, zz.y, zz.z, zz.w};
    unsigned ov[4];
#pragma unroll
    for (int u = 0; u < 4; ++u) {
      const float lo = w0 * __uint_as_float(av0[u] << 16) + w1 * __uint_as_float(av1[u] << 16) + w2 * __uint_as_float(av2[u] << 16);
      const float hi = w0 * __uint_as_float(av0[u] & 0xffff0000u) + w1 * __uint_as_float(av1[u] & 0xffff0000u) + w2 * __uint_as_float(av2[u] & 0xffff0000u);
      const float zl = __uint_as_float(zv[u] << 16), zh = __uint_as_float(zv[u] & 0xffff0000u);
      ov[u] = (unsigned)f2bf(lo * silu(zl)) | ((unsigned)f2bf(hi * silu(zh)) << 16);
    }
    *(uint4*)((scratch ? (bf16_t*)P.out + (size_t)bt * DM + 512 : prow + OFF_ZB) + off) = make_uint4(ov[0], ov[1], ov[2], ov[3]);
  }
  {
    const int cb = h * 64 + dg * 8;
    const u32x4 yy = ld_nt(P.yraw + (size_t)bt * 512 + cb);
    const u32x4 zz = ld_nt(prow + OFF_ZA + cb);
    const unsigned yv[4] = {yy.x, yy.y, yy.z, yy.w}, zv[4] = {zz.x, zz.y, zz.z, zz.w};
    float y[8];
#pragma unroll
    for (int u = 0; u < 4; ++u) { y[2 * u] = __uint_as_float(yv[u] << 16); y[2 * u + 1] = __uint_as_float(yv[u] & 0xffff0000u); }
    float sm1 = 0.f;
#pragma unroll
    for (int u = 0; u < 8; ++u) sm1 += y[u];
    sm1 += __shfl_xor(sm1, 1); sm1 += __shfl_xor(sm1, 2); sm1 += __shfl_xor(sm1, 4);
    const float mu = sm1 * (1.f / 64.f);
    float sq = 0.f;
#pragma unroll
    for (int u = 0; u < 8; ++u) { const float d = y[u] - mu; sq += d * d; }
    sq += __shfl_xor(sq, 1); sq += __shfl_xor(sq, 2); sq += __shfl_xor(sq, 4);
    const float rstd = rsqrtf(sq * (1.f / 64.f) + 64e-5f);
    const int b = bt >> 12, t = bt & (SEQ - 1), tl = t & 15;
    const char* recb = P.rec + (size_t)((b * 8 + h) * 256 + (t >> 4)) * REC_BYTES;
    const float rkb = ((const float*)(recb + REC_RKB_B))[tl];
    const bf16_t* vbp = (const bf16_t*)recb + REC_VB;
    float o[8];
#pragma unroll
    for (int u = 0; u < 8; ++u) {
      const int v = dg * 8 + u;
      const float vv = bf2f(vbp[(v >> 4) * 256 + (16 * (tl >> 2) + (v & 15)) * 4 + (tl & 3)]);
      const float yn = (y[u] - mu) * rstd * P.gn_gain[cb + u] + P.gn_bias[cb + u];
      const float z = (u & 1) ? __uint_as_float(zv[u >> 1] & 0xffff0000u) : __uint_as_float(zv[u >> 1] << 16);
      o[u] = (yn + rkb * vv) * silu(z);
    }
    *(uint4*)((scratch ? (bf16_t*)P.out + (size_t)bt * DM : prow + OFF_ZA) + cb) = make_uint4(pk_bf16(o[0], o[1]), pk_bf16(o[2], o[3]), pk_bf16(o[4], o[5]), pk_bf16(o[6], o[7]));
  }
}

__device__ void merge_item(const Params& P, int item, const bool scratch) {
  const int gid = item * 512 + threadIdx.x;
  merge_one(P, gid, scratch);
  merge_one(P, gid + (MERGE_ITEMS / 2) * 512, scratch);
}

__device__ void final_norm_item(const Params& P, int it, const bool scratch) {
  const int lane = threadIdx.x & 63, wv = threadIdx.x >> 6;
  const int row = it * 16 + wv * 2;
  const bf16_t* yb = (const bf16_t*)P.rec + (size_t)row * DM;
  u32x4 raw[4];
#pragma unroll
  for (int i = 0; i < 4; ++i) raw[i] = ld_nt(yb + (i >> 1) * DM + (i & 1) * 512 + lane * 8);
  float v[4][8];
  float ss0 = 0.f, ss1 = 0.f;
#pragma unroll
  for (int i = 0; i < 4; ++i)
#pragma unroll
    for (int e = 0; e < 4; ++e) {
      v[i][2 * e] = __uint_as_float(raw[i][e] << 16); v[i][2 * e + 1] = __uint_as_float(raw[i][e] & 0xffff0000u);
      const float q = v[i][2 * e] * v[i][2 * e] + v[i][2 * e + 1] * v[i][2 * e + 1];
      if (i < 2) ss0 += q; else ss1 += q;
    }
  ss0 = wave_sum(ss0); ss1 = wave_sum(ss1);
  const float rstd0 = rsqrtf(ss0 * (1.0f / DM) + 1e-6f), rstd1 = rsqrtf(ss1 * (1.0f / DM) + 1e-6f);
#pragma unroll
  for (int i = 0; i < 4; ++i) {
    const int col = (i & 1) * 512 + lane * 8;
    const f32x4 g0 = *(const f32x4*)(P.final_gain + col), g1 = *(const f32x4*)(P.final_gain + col + 4);
    const float rstd = (i < 2) ? rstd0 : rstd1;
    f32x4 o0, o1;
#pragma unroll
    for (int e = 0; e < 4; ++e) { o0[e] = v[i][e] * rstd * g0[e]; o1[e] = v[i][4 + e] * rstd * g1[e]; }
    float* dst = P.out + (size_t)(row + (i >> 1)) * DM + col;
    __builtin_nontemporal_store(o0, (f32x4*)dst); __builtin_nontemporal_store(o1, (f32x4*)(dst + 4));
  }
}

#define XB_TMO      128
#define XB_XCNT(j)  (256  + 64 * (j))
#define XB_XSUB(j)  (1280 + 64 * (j))
#define XB_XGEN(j)  (2304 + 64 * (j))
#define XB_TOP      3328
#define XB_TOPGEN   3392
#define XCD_BAR_WORDS 3456
#define XB_SPIN_CAP (1u << 18)
__device__ __forceinline__ unsigned xb_ld(unsigned* p)              { return __hip_atomic_load(p, __ATOMIC_RELAXED, __HIP_MEMORY_SCOPE_AGENT); }
__device__ __forceinline__ unsigned xb_add(unsigned* p, unsigned v) { return __hip_atomic_fetch_add(p, v, __ATOMIC_RELAXED, __HIP_MEMORY_SCOPE_AGENT); }
__device__ __forceinline__ unsigned xb_xcc_id() { return (unsigned)__builtin_amdgcn_s_getreg((3 << 11) | 20) & 0xFu; }
#define XB_SPIN(cond, bar) do { unsigned _sp = 0; while (cond) { __builtin_amdgcn_s_sleep(1); \
    if ((++_sp & 255u) == 0u) { if (xb_ld(&(bar)[XB_TMO])) break; if (_sp > XB_SPIN_CAP) { atomicAdd(&(bar)[XB_TMO], 1u); break; } } } } while (0)
struct XcdBarrier { unsigned* bar; unsigned x; volatile LAS unsigned* st; };
__device__ __forceinline__ XcdBarrier xcd_barrier_post(unsigned* bar, volatile LAS unsigned* st) {
  XcdBarrier b; b.bar = bar; b.x = xb_xcc_id(); b.st = st;
  if (threadIdx.x == 0) (void)xb_add(&bar[XB_XCNT(b.x)], 1u);
  return b;
}
__device__ __forceinline__ void xcd_barrier_complete(unsigned* bar, unsigned x, unsigned& nloc, unsigned& nx) {
  const unsigned G = gridDim.x * gridDim.y * gridDim.z;
  unsigned sum, cnt, mine, sp = 0u;
  for (;;) {
    sum = 0u; cnt = 0u; mine = 0u;
#pragma unroll
    for (unsigned j = 0; j < 16; ++j) { const unsigned c = xb_ld(&bar[XB_XCNT(j)]); sum += c; cnt += (c > 0u) ? 1u : 0u; mine = (j == x) ? c : mine; }
    if (sum == G) break;
    __builtin_amdgcn_s_sleep(1);
    if ((++sp & 255u) == 0u) { if (xb_ld(&bar[XB_TMO])) break; if (sp > XB_SPIN_CAP) { atomicAdd(&bar[XB_TMO], 1u); break; } }
  }
  nloc = mine > 0u ? mine : 1u; nx = cnt > 0u ? cnt : 1u;
}
__device__ __forceinline__ void xcd_barrier(const XcdBarrier& b) {
  asm volatile("s_waitcnt vmcnt(0)" ::: "memory");
  __syncthreads();
  if (threadIdx.x == 0) {
    unsigned* bar = b.bar;
    __builtin_amdgcn_s_waitcnt(0);
    unsigned nloc = b.st[0], nx = b.st[1];
    if (nloc == 0u) { xcd_barrier_complete(bar, b.x, nloc, nx); b.st[0] = nloc; b.st[1] = nx; }
    const unsigned old = xb_add(&bar[XB_XSUB(b.x)], 1u);
    const unsigned gen = old / nloc;
    if (old + 1u == (gen + 1u) * nloc) {
      __builtin_amdgcn_fence(__ATOMIC_RELEASE, "agent");
      asm volatile("s_waitcnt vmcnt(0)" ::: "memory");
      const unsigned og = xb_add(&bar[XB_TOP], 1u);
      const unsigned tg = og / nx;
      if (og + 1u == (tg + 1u) * nx) xb_add(&bar[XB_TOPGEN], 1u);
      else XB_SPIN(xb_ld(&bar[XB_TOPGEN]) == tg, bar);
      __builtin_amdgcn_fence(__ATOMIC_ACQUIRE, "agent");
      xb_add(&bar[XB_XGEN(b.x)], 1u);
      asm volatile("s_waitcnt vmcnt(0)" ::: "memory");
    } else {
      XB_SPIN(xb_ld(&bar[XB_XGEN(b.x)]) == gen, bar);
      __builtin_amdgcn_fence(__ATOMIC_ACQUIRE, "agent");
      asm volatile("s_waitcnt vmcnt(0)" ::: "memory");
    }
  }
  __syncthreads();
}

constexpr int LDS_CTRL = 18432 + 8 * 16384;
constexpr int LDS_BYTES = LDS_CTRL + 16;
constexpr int HALF_LDS_FLOATS = 18432;
constexpr int SCAN_BLOCKS = 64;
#ifndef PROBE
#define PROBE 0
#endif

__global__ void __launch_bounds__(512, 2) fwd_megakernel(Params P) {
  extern __shared__ __attribute__((aligned(16))) unsigned char lds[];
  float* sm = (float*)lds;
  cg::grid_group grid = cg::this_grid();
  const int nb = gridDim.x, bid = blockIdx.x, tid = threadIdx.x, half = tid >> 8, t8 = tid & 255;
  float* smh = sm + half * HALF_LDS_FLOATS;
  volatile LAS unsigned* xst = (volatile LAS unsigned*)((LAS unsigned char*)lds + LDS_CTRL);
  if (tid == 0) { xst[0] = 0u; xst[1] = 0u; }
  __syncthreads();
  const XcdBarrier xbar = xcd_barrier_post(P.barw, xst);
  for (int rep = 0; rep < (PROBE == 5 ? 2 : 1); ++rep)
  for (int it = bid; it < PREP_ITEMS; it += nb) prep_item(P, it, sm);
  if (P.out == nullptr) grid.sync();
  for (int r_ = 0; r_ < (PROBE == 10 ? 3 : 1); ++r_) xcd_barrier(xbar);
  {
    pg8::Gemm g; g.A = P.hb; g.Bt = P.winT; g.M = MTOK; g.N = NPAD; g.K = DM; g.lda = DM;
    pg8::StaticOrder S; S.init(MTOK, NPAD, nb, bid);
    EpiProj E; E.p = P.p;
    pg8::gemm_phase<EpiProj>((LAS unsigned char*)lds, g, S, E);
    if (PROBE == 4) pg8::gemm_phase<EpiProj>((LAS unsigned char*)lds, g, S, E);
  }
  for (int r_ = 0; r_ < (PROBE == 10 ? 3 : 1); ++r_) xcd_barrier(xbar);
  for (int rep = 0; rep < (PROBE == 3 ? 2 : 1); ++rep)
  for (int vb = bid; vb < 256; vb += nb) rwkv_prep_waves(P, vb, (unsigned char*)lds);
  for (int r_ = 0; r_ < (PROBE == 10 ? 3 : 1); ++r_) xcd_barrier(xbar);
  for (int rep = 0; rep < (PROBE == 7 ? 2 : 1); ++rep) {
  if (bid < SCAN_BLOCKS) rwkv_scan_block(P, bid, (LAS unsigned char*)lds);
  {
    volatile LAS int* qslot = (volatile LAS int*)((LAS unsigned char*)lds + LDS_CTRL + 8);
    unsigned* ctr = P.barw + XCD_BAR_WORDS + 64 + rep * 1024;
    int qx = (int)(xbar.x & 7u), tried = 0;
    constexpr int QPAIRS = ATT_ITEMS / 16;
#define ATT_FETCH(dst) do { dst = -1; while (tried < 8) { const int ix_ = (int)atomicAdd(ctr + qx * 64, 1u); if (ix_ < QPAIRS) { dst = qx * QPAIRS + ix_; break; } qx = (qx + 1) & 7; ++tried; } } while (0)
    int a1 = -1;
    if (tid == 0) { int a0; ATT_FETCH(a0); ATT_FETCH(a1); *qslot = a0; }
    __syncthreads();
    int it = *qslot;
    AttnRegs R;
#define ATT_ITEM(pr) ((8 * ((2 * ((pr) % QPAIRS)) / 96) + (pr) / QPAIRS) * 96 + (2 * ((pr) % QPAIRS)) % 96 + half)
    attn_load(P, ATT_ITEM(it >= 0 ? it : 0), t8, R);
    while (it >= 0) {
      __syncthreads();
      if (tid == 0) { *qslot = a1; ATT_FETCH(a1); }
      attn_stage(smh, t8, R);
      const bf16x8 qa0 = R.qa0, qa1 = R.qa1, qb0 = R.qb0, qb1 = R.qb1;
      __syncthreads();
      const int itn = *qslot;
      attn_load(P, ATT_ITEM(itn >= 0 ? itn : 0), t8, R);
      const int item = ATT_ITEM(it);
      attn_compute(P, item, smh, t8, 2 * (t8 >> 6), qa0, qa1);
      attn_compute(P, item, smh, t8, 2 * (t8 >> 6) + 1, qb0, qb1);
      it = itn;
    }
#undef ATT_FETCH
#undef ATT_ITEM
  }
  __syncthreads();
  }
  for (int r_ = 0; r_ < (PROBE == 10 ? 3 : 1); ++r_) xcd_barrier(xbar);
  if (PROBE == 9) for (int it = bid; it < MERGE_ITEMS / 2; it += nb) merge_item(P, it, true);
  for (int it = bid; it < MERGE_ITEMS / 2; it += nb) merge_item(P, it, false);
  for (int r_ = 0; r_ < (PROBE == 10 ? 3 : 1); ++r_) xcd_barrier(xbar);
  {
    pg8::Gemm g; g.A = P.p + OFF_ZA; g.Bt = P.woutT; g.M = MTOK; g.N = DM; g.K = DM; g.lda = NIN;
    pg8::StaticOrder S; S.init(MTOK, DM, nb, bid);
    EpiOut E; E.x = P.x; E.ybf = (bf16_t*)P.rec;
    pg8::gemm_phase<EpiOut>((LAS unsigned char*)lds, g, S, E);
    if (PROBE == 6) pg8::gemm_phase<EpiOut>((LAS unsigned char*)lds, g, S, E);
  }
  for (int r_ = 0; r_ < (PROBE == 10 ? 3 : 1); ++r_) xcd_barrier(xbar);
  for (int it = bid; it < MTOK / 16; it += nb) final_norm_item(P, it, false);
}

extern "C" void kernel_launch(void* const* d_in, const int* in_sizes, int n_in, void* d_out, int out_size, void* d_ws, size_t ws_size,
                              hipStream_t stream) {
  Params P{};
  P.x = (const float*)d_in[0]; P.norm_gain = (const float*)d_in[1]; P.w_in = (const float*)d_in[2]; P.shift_mix = (const float*)d_in[3];
  P.decay_base = (const float*)d_in[4]; P.decay_up = (const float*)d_in[5]; P.iclr_base = (const float*)d_in[6]; P.iclr_up = (const float*)d_in[7];
  P.key_norm_scale = (const float*)d_in[8]; P.key_iclr_mix = (const float*)d_in[9]; P.bonus = (const float*)d_in[10]; P.gn_gain = (const float*)d_in[11];
  P.gn_bias = (const float*)d_in[12]; P.w_out = (const float*)d_in[13]; P.final_gain = (const float*)d_in[14];
  P.out = (float*)d_out;
  char* ws = (char*)d_ws;
  const size_t MiB = 1024 * 1024;
  P.winT = (bf16_t*)(ws);
  P.woutT = (bf16_t*)(ws + 9 * MiB);
  P.dut = (bf16_t*)(ws + 11 * MiB);
  P.iut = (bf16_t*)(ws + 11 * MiB + 65536);
  P.p = (bf16_t*)(ws + 12 * MiB);
  P.hb = (bf16_t*)(ws + 276 * MiB);
  P.rec = ws + 276 * MiB;
  P.yraw = (bf16_t*)(ws + 474 * MiB);
  P.barw = (unsigned*)(ws + 506 * MiB);
  if (ws_size < 507 * MiB) { fprintf(stderr, "workspace too small\n"); return; }
  static int grid_blocks = 0;
  if (!grid_blocks) {
    int dev = 0, cus = 0, per_cu = 0;
    (void)hipGetDevice(&dev);
    (void)hipDeviceGetAttribute(&cus, hipDeviceAttributeMultiprocessorCount, dev);
    (void)hipFuncSetAttribute((const void*)fwd_megakernel, hipFuncAttributeMaxDynamicSharedMemorySize, LDS_BYTES);
    (void)hipOccupancyMaxActiveBlocksPerMultiprocessor(&per_cu, fwd_megakernel, 512, LDS_BYTES);
    if (per_cu > 1) per_cu = 1;
    grid_blocks = cus * per_cu;
  }
  (void)hipMemsetAsync(P.barw, 0, (XCD_BAR_WORDS + 64 + 2048) * sizeof(unsigned), stream);
  void* args[] = {&P};
  hipError_t e = hipLaunchCooperativeKernel((void*)fwd_megakernel, dim3(grid_blocks), dim3(512), args, LDS_BYTES, stream);
  if (e != hipSuccess) fprintf(stderr, "cooperative launch failed: %s (grid %d)\n", hipGetErrorString(e), grid_blocks);
}
```

```cpp
#include <hip/hip_runtime.h>
#include <hip/hip_cooperative_groups.h>
#include <stdint.h>
#include <cstdio>
namespace cg = cooperative_groups;

typedef unsigned short bf16_t;
typedef short bf16x8 __attribute__((ext_vector_type(8)));
typedef float f32x4 __attribute__((ext_vector_type(4)));
typedef unsigned u32x4 __attribute__((ext_vector_type(4)));
#define LAS __attribute__((address_space(3)))

constexpr int SEQ = 4096, DM = 1024, MTOK = 32768, NIN = 4224, NPAD = 4352;
constexpr int OFF_R = 0, OFF_K = 512, OFF_V = 1024, OFF_WLO = 1536, OFF_ALO = 1600;
constexpr int OFF_Q = 1664, OFF_KB = 2176, OFF_VB = 2688, OFF_ZA = 3200, OFF_ZB = 3712;

struct Params {
  const float *x, *norm_gain, *w_in, *shift_mix, *decay_base, *decay_up, *iclr_base, *iclr_up,
      *key_norm_scale, *key_iclr_mix, *bonus, *gn_gain, *gn_bias, *w_out, *final_gain;
  float* out;
  bf16_t *hb, *winT, *woutT, *p, *yraw, *dut, *iut;
  char* rec;
  unsigned* barw;
};

typedef float f32x2_t __attribute__((ext_vector_type(2)));
typedef __bf16 bf16x2_t __attribute__((ext_vector_type(2)));
__device__ __forceinline__ unsigned pk_bf16(float lo, float hi) { const f32x2_t v = {lo, hi}; return __builtin_bit_cast(unsigned, __builtin_convertvector(v, bf16x2_t)); }
__device__ __forceinline__ bf16_t f2bf(float f) { return (bf16_t)(pk_bf16(f, 0.f) & 0xffffu); }
__device__ __forceinline__ u32x4 ld_nt(const void* p) { return __builtin_nontemporal_load((const u32x4*)p); }
__device__ __forceinline__ f32x4 ldf_nt(const void* p) { return __builtin_nontemporal_load((const f32x4*)p); }
__device__ __forceinline__ float bf2f(bf16_t h) { return __uint_as_float(((unsigned)h) << 16); }
__device__ __forceinline__ float dpp_add(float v, const int ctrl_sel) {
  const int iv = __builtin_bit_cast(int, v);
  int o;
  if (ctrl_sel == 0) o = __builtin_amdgcn_update_dpp(iv, iv, 0xB1, 0xF, 0xF, false);
  else if (ctrl_sel == 1) o = __builtin_amdgcn_update_dpp(iv, iv, 0x4E, 0xF, 0xF, false);
  else if (ctrl_sel == 2) o = __builtin_amdgcn_update_dpp(iv, iv, 0x141, 0xF, 0xF, false);
  else o = __builtin_amdgcn_update_dpp(iv, iv, 0x140, 0xF, 0xF, false);
  return v + __builtin_bit_cast(float, o);
}
__device__ __forceinline__ float wave_sum(float v) {
  v = dpp_add(v, 0); v = dpp_add(v, 1); v = dpp_add(v, 2); v = dpp_add(v, 3);
  const int iv = __builtin_bit_cast(int, v);
  const float s0 = __builtin_bit_cast(float, __builtin_amdgcn_readlane(iv, 0)), s1 = __builtin_bit_cast(float, __builtin_amdgcn_readlane(iv, 16));
  const float s2 = __builtin_bit_cast(float, __builtin_amdgcn_readlane(iv, 32)), s3 = __builtin_bit_cast(float, __builtin_amdgcn_readlane(iv, 48));
  return (s0 + s1) + (s2 + s3);
}
__device__ __forceinline__ float silu(float z) { return z / (1.f + __expf(-z)); }
__device__ __forceinline__ bf16x8 as_frag(u32x4 v) { return __builtin_bit_cast(bf16x8, v); }

constexpr int PREP_ROW_ITEMS = MTOK / 16, PREP_WIN_TILES = 16 * 68, PREP_WOUT_TILES = 16 * 16;
constexpr int PREP_LR_ITEMS = 128;
constexpr int PREP_ITEMS = PREP_ROW_ITEMS + PREP_WIN_TILES + PREP_WOUT_TILES + PREP_LR_ITEMS;

__device__ void prep_item(const Params& P, int it, float* sm) {
  const int tid = threadIdx.x, lane = tid & 63, wv = tid >> 6;
  if (it < PREP_ROW_ITEMS) {
    const int row = it * 16 + wv * 2;
    const float4* xr = (const float4*)(P.x + (size_t)row * DM);
    const float4* g4 = (const float4*)P.norm_gain;
    float4 v[8];
    float ss0 = 0.f, ss1 = 0.f;
#pragma unroll
    for (int i = 0; i < 8; ++i) { const f32x4 t_ = ldf_nt(xr + lane + 64 * i); v[i] = make_float4(t_[0], t_[1], t_[2], t_[3]); }
#pragma unroll
    for (int i = 0; i < 4; ++i) {
      ss0 += v[i].x * v[i].x + v[i].y * v[i].y + v[i].z * v[i].z + v[i].w * v[i].w;
      ss1 += v[4 + i].x * v[4 + i].x + v[4 + i].y * v[4 + i].y + v[4 + i].z * v[4 + i].z + v[4 + i].w * v[4 + i].w;
    }
    ss0 = wave_sum(ss0); ss1 = wave_sum(ss1);
    const float rstd0 = rsqrtf(ss0 * (1.0f / DM) + 1e-6f), rstd1 = rsqrtf(ss1 * (1.0f / DM) + 1e-6f);
#pragma unroll
    for (int i = 0; i < 8; ++i) {
      const float4 g = g4[lane + 64 * (i & 3)];
      const float rstd = (i < 4) ? rstd0 : rstd1;
      ushort4 o;
      o.x = f2bf(v[i].x * rstd * g.x); o.y = f2bf(v[i].y * rstd * g.y);
      o.z = f2bf(v[i].z * rstd * g.z); o.w = f2bf(v[i].w * rstd * g.w);
      *(ushort4*)(P.hb + (size_t)row * DM + (lane + 64 * i) * 4) = o;
    }
    return;
  }
  it -= PREP_ROW_ITEMS;
  if (it >= PREP_WIN_TILES + PREP_WOUT_TILES) {
    it -= PREP_WIN_TILES + PREP_WOUT_TILES;
    const float* srcm = (it < 64) ? P.decay_up : P.iclr_up;
    bf16_t* dstm = (it < 64) ? P.dut : P.iut;
    const int e = (it & 63) * 512 + tid, chn = e >> 6, k = e & 63;
    dstm[e] = f2bf(srcm[k * 512 + chn]);
    return;
  }
  const float* src; bf16_t* dst; int ncols, kt, nt, scol;
  if (it < PREP_WIN_TILES) {
    src = P.w_in; dst = P.winT; ncols = NIN; kt = it / 68; nt = it % 68;
    const int n0 = nt * 64;
    scol = (n0 < 1664) ? n0 : (n0 < 3200) ? (n0 + 512) : (n0 < 3712) ? (n0 - 1536) : (n0 < 4224) ? n0 : -1;
  } else { it -= PREP_WIN_TILES; src = P.w_out; dst = P.woutT; ncols = DM; kt = it / 16; nt = it % 16; scol = nt * 64; }
#pragma unroll 4
  for (int i = 0; i < 8; ++i) {
    const int r = wv + 8 * i;
    sm[r * 65 + lane] = (scol >= 0) ? src[(size_t)(kt * 64 + r) * ncols + scol + lane] : 0.f;
  }
  __syncthreads();
#pragma unroll 4
  for (int i = 0; i < 8; ++i) {
    const int r = wv + 8 * i;
    dst[(size_t)(nt * 64 + r) * DM + kt * 64 + lane] = f2bf(sm[lane * 65 + r]);
  }
  __syncthreads();
}

namespace pg8 {
constexpr int BM = 256, BK = 64, HALF = 128, HTB = HALF * BK * 2, STAGE_BYTES = 8 * HTB, NXCD = 8, WGM = 8;
__host__ __device__ __forceinline__ int lds_byte(int r, int c) { const int st = (r >> 4) * 2 + (c >> 5), rr = r & 15, cc = c & 31, ob = rr * 64 + cc * 2; return st * 1024 + (ob ^ (((ob >> 9) & 1) << 5)); }
__host__ __device__ __forceinline__ void stage_rc(int b, int& R, int& C) { const int st = b / 1024, sb = b % 1024, swz = sb ^ (((sb >> 9) & 1) << 5); R = (st >> 1) * 16 + swz / 64; C = (st & 1) * 32 + (swz % 64) / 2; }
__host__ __device__ __forceinline__ int perm32(int rho) { const int n = rho >> 4, i = rho & 15; return 8 * (i >> 2) + 4 * n + (i & 3); }
struct Unit { int pm, pn; };
struct Gemm { const bf16_t* A; const bf16_t* Bt; int M, N, K, lda; };
struct StaticOrder {
  int nM, nN, nwg, G, c;
  __host__ __device__ void init(int M, int N, int G_, int c_) { nM = M / BM; nN = N / BM; nwg = nM * nN; G = G_; c = c_; }
  __host__ __device__ bool next(int i, Unit& u) const {
    const long L = (long)i * G + c; if (L >= nwg) return false;
    int wgid = (int)L; { const int q = nwg / NXCD, r = nwg % NXCD, xcd = wgid % NXCD, off = wgid / NXCD; wgid = (xcd < r ? xcd * (q + 1) : r * (q + 1) + (xcd - r) * q) + off; }
    const int nig = WGM * nN, gid = wgid / nig, fm = gid * WGM, gsz = (nM - fm) < WGM ? (nM - fm) : WGM;
    u.pm = fm + ((wgid % nig) % gsz); u.pn = (wgid % nig) / gsz; return true;
  }
};
template <class Epi>
__device__ __forceinline__ void gemm_phase(LAS unsigned char* lds, const Gemm g, const StaticOrder& S, const Epi& E) {
  const int tid = threadIdx.x, wid = __builtin_amdgcn_readfirstlane(tid >> 6), lane = tid & 63, wr = wid >> 2, wc = wid & 3, fr = lane & 15, fq = lane >> 4;
  const int K = g.K, nt = K / BK, lda = g.lda;
  unsigned voffA[2], voffB[2];
#pragma unroll
  for (int i = 0; i < 2; ++i) { int R, C; stage_rc(tid * 16 + i * 8192, R, C); const int Rb = (R & ~31) + perm32(R & 31);
    voffA[i] = (unsigned)(R * lda + C) * 2u; voffB[i] = (unsigned)(Rb * K + C) * 2u; }
  const size_t kstep = (size_t)(BK * 2);
  const size_t hstepA = (size_t)HALF * lda * 2, hstepB = (size_t)HALF * K * 2;
  const size_t tstepA = 2 * hstepA, tstepB = 2 * hstepB;
  const unsigned ldsw = (unsigned)wid * 1024u;
  const int aoff = lds_byte(wr * 64 + fr, fq * 8), boff = lds_byte(wc * 32 + fr, fq * 8);
#define PG8_SA(b, h) (((b) * 2 + (h)) * HTB)
#define PG8_SB(b, h) ((4 + (b) * 2 + (h)) * HTB)
#define PG8_STAGE(bufoff, gbase, voff) do { _Pragma("unroll") for (int _i = 0; _i < 2; ++_i) \
    __builtin_amdgcn_global_load_lds((const unsigned*)((const char*)(gbase) + (voff)[_i]), (LAS unsigned*)(lds + (bufoff) + ldsw + _i * 8192), 16, 0, 0); } while (0)
#define PG8_LDA(dst, b, h) do { _Pragma("unroll") for (int m = 0; m < 4; ++m) _Pragma("unroll") for (int k = 0; k < 2; ++k) dst[m][k] = *(const LAS bf16x8*)(lds + PG8_SA(b, h) + aoff + m * 2048 + k * 1024); } while (0)
#define PG8_LDB(dst, b, h) do { _Pragma("unroll") for (int n = 0; n < 2; ++n) _Pragma("unroll") for (int k = 0; k < 2; ++k) dst[n][k] = *(const LAS bf16x8*)(lds + PG8_SB(b, h) + boff + n * 2048 + k * 1024); } while (0)
#define PG8_MMA(ai, bj, At, Bt) do { __builtin_amdgcn_s_setprio(1); _Pragma("unroll") for (int m = 0; m < 4; ++m) _Pragma("unroll") for (int n = 0; n < 2; ++n) _Pragma("unroll") for (int k = 0; k < 2; ++k) \
    acc[ai][bj][m][n] = __builtin_amdgcn_mfma_f32_16x16x32_bf16(Bt[n][k], At[m][k], acc[ai][bj][m][n], 0, 0, 0); __builtin_amdgcn_s_setprio(0); } while (0)
#define PG8_WAIT_V(n) asm volatile("s_waitcnt vmcnt(" #n ")" ::: "memory")
#define PG8_WAIT_L(n) asm volatile("s_waitcnt lgkmcnt(" #n ")" ::: "memory")
#define PG8_BAR __builtin_amdgcn_s_barrier()
#define PG8_SCHED __builtin_amdgcn_sched_barrier(0)
  Unit cur, nxt; int ui = 0;
  if (!S.next(0, cur)) return;
  f32x4 acc[2][2][4][2];
#pragma unroll
  for (int a = 0; a < 2; ++a)
#pragma unroll
    for (int b = 0; b < 2; ++b)
#pragma unroll
      for (int m = 0; m < 4; ++m)
#pragma unroll
        for (int n = 0; n < 2; ++n) acc[a][b][m][n] = (f32x4){0.f, 0.f, 0.f, 0.f};
  bf16x8 At[4][2], B0[2][2], B1[2][2];
  const char* cA = (const char*)g.A + (size_t)cur.pm * tstepA; const char* cB = (const char*)g.Bt + (size_t)cur.pn * tstepB;
  PG8_STAGE(PG8_SB(0, 0), cB, voffB); PG8_STAGE(PG8_SB(0, 1), cB + hstepB, voffB); PG8_STAGE(PG8_SA(0, 0), cA, voffA); PG8_STAGE(PG8_SA(0, 1), cA + hstepA, voffA);
  if (wr == 1) PG8_BAR;
  PG8_WAIT_V(2); PG8_BAR;
  PG8_STAGE(PG8_SB(1, 0), cB + kstep, voffB); PG8_STAGE(PG8_SA(1, 0), cA + kstep, voffA); PG8_STAGE(PG8_SB(1, 1), cB + hstepB + kstep, voffB);
  PG8_WAIT_V(6); PG8_BAR;
  for (;;) {
    const bool has_next = S.next(ui + 1, nxt);
    const char* nA = has_next ? (const char*)g.A + (size_t)nxt.pm * tstepA : cA; const char* nB = has_next ? (const char*)g.Bt + (size_t)nxt.pn * tstepB : cB;
    for (int t = 0; t < nt; t += 2) {
      const bool last = (t == nt - 2);
      const char* a1 = cA + (size_t)(t + 1) * kstep;
      const char* a2 = last ? nA : cA + (size_t)(t + 2) * kstep; const char* b2 = last ? nB : cB + (size_t)(t + 2) * kstep;
      const char* a3 = a2 + kstep; const char* b3 = b2 + kstep;
      PG8_LDB(B0, 0, 0); PG8_LDB(B1, 0, 1); PG8_SCHED; PG8_LDA(At, 0, 0); PG8_STAGE(PG8_SA(1, 1), a1 + hstepA, voffA);
      PG8_WAIT_V(8); PG8_WAIT_L(0); PG8_BAR; PG8_MMA(0, 0, At, B0); PG8_MMA(0, 1, At, B1); PG8_BAR; PG8_SCHED;
      PG8_LDA(At, 0, 1); PG8_STAGE(PG8_SB(0, 0), b2, voffB); PG8_STAGE(PG8_SB(0, 1), b2 + hstepB, voffB); PG8_STAGE(PG8_SA(0, 0), a2, voffA);
      PG8_WAIT_V(8); PG8_WAIT_L(0); PG8_BAR; PG8_MMA(1, 0, At, B0); PG8_MMA(1, 1, At, B1); PG8_BAR; PG8_SCHED;
      PG8_LDB(B0, 1, 0); PG8_LDB(B1, 1, 1); PG8_SCHED; PG8_LDA(At, 1, 0); PG8_STAGE(PG8_SA(0, 1), a2 + hstepA, voffA);
      PG8_WAIT_V(8); PG8_WAIT_L(0); PG8_BAR; PG8_MMA(0, 0, At, B0); PG8_MMA(0, 1, At, B1); PG8_BAR; PG8_SCHED;
      PG8_LDA(At, 1, 1); PG8_STAGE(PG8_SB(1, 0), b3, voffB); PG8_STAGE(PG8_SB(1, 1), b3 + hstepB, voffB); PG8_STAGE(PG8_SA(1, 0), a3, voffA);
      PG8_WAIT_V(8); PG8_WAIT_L(0); PG8_BAR; PG8_MMA(1, 0, At, B0); PG8_MMA(1, 1, At, B1); PG8_BAR; PG8_SCHED;
    }
    if (wr == 0) PG8_BAR;
    E(acc, cur, wr, wc, fr, fq);
    if (!has_next) break;
#pragma unroll
    for (int a = 0; a < 2; ++a)
#pragma unroll
      for (int b = 0; b < 2; ++b)
#pragma unroll
        for (int m = 0; m < 4; ++m)
#pragma unroll
          for (int n = 0; n < 2; ++n) acc[a][b][m][n] = (f32x4){0.f, 0.f, 0.f, 0.f};
    cur = nxt; cA = nA; cB = nB; ++ui;
    if (wr == 1) PG8_BAR;
  }
  PG8_WAIT_V(0);
  PG8_BAR;
#undef PG8_SA
#undef PG8_SB
#undef PG8_STAGE
#undef PG8_LDA
#undef PG8_LDB
#undef PG8_MMA
#undef PG8_WAIT_V
#undef PG8_WAIT_L
#undef PG8_BAR
#undef PG8_SCHED
}
}

struct EpiProj {
  bf16_t* p;
  __device__ __forceinline__ void operator()(const f32x4 (&acc)[2][2][4][2], const pg8::Unit& u, int wr, int wc, int fr, int fq) const {
    const float inv[8] = {1.0f, 0.1939227432012558f, 0.03760603070259094f, 0.007292664609849453f, 0.0014142135623842478f, 0.00027424818836152554f, 5.3182957344688475e-05f, 1.0313385246263351e-05f};
#pragma unroll
    for (int bj = 0; bj < 2; ++bj) {
      const int wcol = u.pn * 256 + bj * 128 + wc * 32;
      if (wcol >= NIN) continue;
      const int col0 = wcol + 8 * fq;
      const bool wrope = (wcol >= OFF_Q) && (wcol < OFF_VB) && ((wcol & 63) == 0);
#pragma unroll
      for (int ai = 0; ai < 2; ++ai)
#pragma unroll
        for (int m = 0; m < 4; ++m) {
          const int row = u.pm * 256 + ai * 128 + wr * 64 + m * 16 + fr;
          float v[8];
#pragma unroll
          for (int e = 0; e < 4; ++e) { v[e] = acc[ai][bj][m][0][e]; v[4 + e] = acc[ai][bj][m][1][e]; }
          if (wrope) {
            const float pos = (float)(row & (SEQ - 1));
#pragma unroll
            for (int e = 0; e < 8; ++e) {
              const float other = __shfl_xor(v[e], 16);
              float rev = pos * inv[e] * 0.15915494309189535f;
              rev = (rev - rintf(rev)) * 6.283185307179586f;
              const float sn = __sinf(rev), cs = __cosf(rev);
              const float r0 = v[e] * cs - other * sn, r1 = other * sn + v[e] * cs;
              v[e] = (fq == 0) ? r0 : (fq == 1) ? r1 : v[e];
            }
          }
          u32x4 w;
          w.x = pk_bf16(v[0], v[1]); w.y = pk_bf16(v[2], v[3]); w.z = pk_bf16(v[4], v[5]); w.w = pk_bf16(v[6], v[7]);
          __builtin_nontemporal_store(w, (u32x4*)(p + (size_t)row * NIN + col0));
        }
    }
  }
};
struct EpiOut {
  const float* x; bf16_t* ybf;
  __device__ __forceinline__ void operator()(const f32x4 (&acc)[2][2][4][2], const pg8::Unit& u, int wr, int wc, int fr, int fq) const {
#pragma unroll
    for (int bj = 0; bj < 2; ++bj) {
      const int col0 = u.pn * 256 + bj * 128 + wc * 32 + 8 * fq;
#pragma unroll
      for (int ai = 0; ai < 2; ++ai)
#pragma unroll
        for (int m = 0; m < 4; ++m) {
          const int row = u.pm * 256 + ai * 128 + wr * 64 + m * 16 + fr;
          const size_t idx = (size_t)row * DM + col0;
          const f32x4 a0 = ldf_nt(x + idx) + acc[ai][bj][m][0], a1 = ldf_nt(x + idx + 4) + acc[ai][bj][m][1];
          u32x4 w; w.x = pk_bf16(a0[0], a0[1]); w.y = pk_bf16(a0[2], a0[3]); w.z = pk_bf16(a1[0], a1[1]); w.w = pk_bf16(a1[2], a1[3]);
          *(u32x4*)(ybf + idx) = w;
        }
    }
  }
};

constexpr int REC_BYTES = 12672, REC_M1 = 0, REC_R = 1024, REC_BK = 2048, REC_TA = 4096, REC_AR = 4608, REC_VB = 5120;
constexpr int REC_WC_B = 12288, REC_RKB_B = 12544;
constexpr int RPREP_ITEMS = 64 * 256;
constexpr int LS = 68;
__device__ __forceinline__ bf16x8 cvt8(const float* p) {
  const float4 a = *(const float4*)p, b = *(const float4*)(p + 4);
  u32x4 r; r.x = pk_bf16(a.x, a.y); r.y = pk_bf16(a.z, a.w); r.z = pk_bf16(b.x, b.y); r.w = pk_bf16(b.z, b.w);
  return as_frag(r);
}
__device__ __forceinline__ float fast_tanh(float x) { return 1.f - 2.f * __builtin_amdgcn_rcpf(1.f + __expf(2.f * x)); }
__device__ void rwkv_prep_block(const Params& P, int vb, float* sm, const int tid, const int half) {
  const int bh = vb >> 2, b = bh >> 3, h = bh & 7;
  const int lane = tid & 63, tt = tid >> 6, g = lane >> 4, i = lane & 15;
  float* s_r = sm;             float* s_k = sm + 1088;      float* s_at = sm + 2 * 1088;  float* s_bt = sm + 3 * 1088;
  float* s_lw = sm + 4 * 1088; float* s_an = sm + 5 * 1088; float* s_b = sm + 6 * 1088;   float* s_kt = sm + 7 * 1088;
  float* s_rt = sm + 8 * 1088; float* s_Aab = sm + 9 * 1088; float* s_Aak = s_Aab + 272;
  float* s_xw = s_at; float* s_xa = s_bt;
  bf16_t* s_twb = (bf16_t*)(sm + 9 * 1088 + 544);
  bf16_t* s_pab = s_twb + 16 * 72;
  bf16_t* rec = (bf16_t*)(sm + 9 * 1088 + 544 + 1152);
  bf16_t* s_raw = (bf16_t*)s_lw;
  const int c = h * 64 + lane;
  const float mix_r = P.shift_mix[OFF_R + c], mix_k = P.shift_mix[OFF_K + c], mix_v = P.shift_mix[OFF_V + c];
  const float mix_w = P.shift_mix[OFF_WLO + lane], mix_a = P.shift_mix[OFF_ALO + lane];
  const float dbase = P.decay_base[c], ibase = P.iclr_base[c], kns = P.key_norm_scale[c], kim = P.key_iclr_mix[c], bon = P.bonus[c];
  const bf16_t* dup = P.dut + (size_t)(h * 64 + 16 * tt + i) * 64 + 8 * g;
  const bf16_t* iup = P.iut + (size_t)(h * 64 + 16 * tt + i) * 64 + 8 * g;
  const bf16x8 bd0 = *(const bf16x8*)dup, bd1 = *(const bf16x8*)(dup + 32), bi0 = *(const bf16x8*)iup, bi1 = *(const bf16x8*)(iup + 32);
  int prow[3], pcol[3], plds[3];
#pragma unroll
  for (int u = 0; u < 3; ++u) {
    const int idx = tid + 256 * u, rr = idx / 40, q = idx - rr * 40, cg = q >> 3, sub = q & 7;
    prow[u] = (idx < 680) ? rr : -100000;
    pcol[u] = ((cg < 3) ? (cg * 512 + h * 64) : (cg == 3 ? OFF_WLO : OFF_ALO)) + sub * 8;
    plds[u] = rr * 328 + cg * 64 + sub * 8;
  }
  const bf16_t* pb = P.p + (size_t)(b * SEQ) * NIN;
  uint4 pre[3];
#define RP_PREFETCH(chunk) do { _Pragma("unroll") for (int u = 0; u < 3; ++u) { const int t_ = (chunk) * 16 - 1 + prow[u]; \
    pre[u] = (t_ >= 0) ? *(const uint4*)(pb + (size_t)t_ * NIN + pcol[u]) : make_uint4(0u, 0u, 0u, 0u); } } while (0)
  const int cbase = (vb & 3) * 64 + half;
  RP_PREFETCH(cbase);
#pragma unroll
  for (int u = 0; u < 3; ++u) if (prow[u] >= 0) *(uint4*)(s_raw + plds[u]) = pre[u];
  __syncthreads();
  for (int kk2 = 0; kk2 < 32; ++kk2) {
  const int ch = cbase + 2 * kk2;
  const int item = bh * 256 + ch;
  char* recb = P.rec + (size_t)item * REC_BYTES;
  if (kk2 + 1 < 32) RP_PREFETCH(ch + 2);
  {
#pragma unroll
    for (int q = 0; q < 4; ++q) {
      const int tl = tt + 4 * q;
      const bf16_t* row = s_raw + (tl + 1) * 328;
      const bf16_t* prw = s_raw + tl * 328;
      const float cr = bf2f(row[lane]), ck = bf2f(row[64 + lane]), cv = bf2f(row[128 + lane]), cw = bf2f(row[192 + lane]), ca = bf2f(row[256 + lane]);
      const float pr = bf2f(prw[lane]), pk = bf2f(prw[64 + lane]), pv = bf2f(prw[128 + lane]), pw = bf2f(prw[192 + lane]), pa = bf2f(prw[256 + lane]);
      s_r[tl * LS + lane] = cr + (pr - cr) * mix_r;
      s_k[tl * LS + lane] = ck + (pk - ck) * mix_k;
      s_twb[tl * 72 + lane] = f2bf(fast_tanh(cw + (pw - cw) * mix_w));
      s_pab[tl * 72 + lane] = f2bf(ca + (pa - ca) * mix_a);
      const float vv = cv + (pv - cv) * mix_v;
      rec[REC_VB + (lane >> 4) * 256 + (16 * (tl >> 2) + (lane & 15)) * 4 + (tl & 3)] = f2bf(vv);
    }
  }
  __syncthreads();
  {
    const bf16x8 aw0 = *(const bf16x8*)(s_twb + i * 72 + 8 * g), aw1 = *(const bf16x8*)(s_twb + i * 72 + 32 + 8 * g);
    const bf16x8 aa0 = *(const bf16x8*)(s_pab + i * 72 + 8 * g), aa1 = *(const bf16x8*)(s_pab + i * 72 + 32 + 8 * g);
    f32x4 xw = (f32x4){0.f, 0.f, 0.f, 0.f}, xa = (f32x4){0.f, 0.f, 0.f, 0.f};
    xw = __builtin_amdgcn_mfma_f32_16x16x32_bf16(aw0, bd0, xw, 0, 0, 0);
    xw = __builtin_amdgcn_mfma_f32_16x16x32_bf16(aw1, bd1, xw, 0, 0, 0);
    xa = __builtin_amdgcn_mfma_f32_16x16x32_bf16(aa0, bi0, xa, 0, 0, 0);
    xa = __builtin_amdgcn_mfma_f32_16x16x32_bf16(aa1, bi1, xa, 0, 0, 0);
#pragma unroll
    for (int j = 0; j < 4; ++j) {
      s_xw[(4 * g + j) * LS + 16 * tt + i] = xw[j];
      s_xa[(4 * g + j) * LS + 16 * tt + i] = xa[j];
    }
  }
  __syncthreads();
  {
#pragma unroll
    for (int q = 0; q < 4; ++q) {
      const int tl = tt + 4 * q;
      const float z = -(dbase + s_xw[tl * LS + lane]);
      const float sp = fmaxf(z, 0.f) + __logf(1.f + __expf(-fabsf(z)));
      const float lwv = -__expf(-sp - 0.5f);
      const float a = 1.f / (1.f + __expf(-(ibase + s_xa[tl * LS + lane])));
      const float pk = s_k[tl * LS + lane];
      const float kkr = pk * kns;
      const float ss = wave_sum(kkr * kkr);
      const float kk = kkr * rsqrtf(fmaxf(ss, 1e-24f));
      const float kmod = pk * (1.f + (a - 1.f) * kim);
      s_lw[tl * LS + lane] = lwv;
      s_k[tl * LS + lane] = kmod;
      s_an[tl * LS + lane] = -kk;
      s_b[tl * LS + lane] = kk * a;
      const float rk = wave_sum(s_r[tl * LS + lane] * kmod * bon);
      if (lane == 0) ((float*)(recb + REC_RKB_B))[tl] = rk;
    }
  }
  __syncthreads();
  {
    float run = 0.f, LWp[4], LW[4];
#pragma unroll
    for (int s2 = 0; s2 < 16; ++s2) {
      const float x = s_lw[s2 * LS + lane];
      if ((s2 & 3) == tt) { LWp[s2 >> 2] = run; LW[s2 >> 2] = run + x; }
      run += x;
    }
    const float LWC = run;
    if (tt == 0) ((float*)(recb + REC_WC_B))[lane] = __expf(LWC);
#pragma unroll
    for (int q = 0; q < 4; ++q) {
      const int tl = tt + 4 * q;
      const float e_p = __expf(LWp[q]), e_n = __expf(-LW[q]), e_r = __expf(LW[q]), e_c = __expf(LWC - LW[q]);
      const float an = s_an[tl * LS + lane], bb = s_b[tl * LS + lane], kmod = s_k[tl * LS + lane], rr = s_r[tl * LS + lane];
      s_at[tl * LS + lane] = an * e_p;
      s_bt[tl * LS + lane] = bb * e_n;
      s_kt[tl * LS + lane] = kmod * e_n;
      const float rt = rr * e_r;
      s_rt[tl * LS + lane] = rt;
      const int bkaddr = REC_BK + (lane >> 4) * 512 + (16 * (tl >> 2) + (lane & 15)) * 8 + (tl & 3);
      rec[bkaddr] = f2bf(bb * e_c);
      rec[bkaddr + 4] = f2bf(kmod * e_c);
      const int k5 = lane & 31;
      rec[REC_R + (lane >> 5) * 512 + (16 * ((k5 & 15) >> 2) + tl) * 8 + (k5 & 3) + 4 * (k5 >> 4)] = f2bf(rt);
    }
  }
  __syncthreads();
  {
    const float* X = (tt < 2) ? s_at : s_rt;
    const float* Y = (tt & 1) ? s_kt : s_bt;
    const bf16x8 a0 = cvt8(X + i * LS + 8 * g), a1 = cvt8(X + i * LS + 32 + 8 * g);
    const bf16x8 b0 = cvt8(Y + i * LS + 8 * g), b1 = cvt8(Y + i * LS + 32 + 8 * g);
    f32x4 acc = (f32x4){0.f, 0.f, 0.f, 0.f};
    acc = __builtin_amdgcn_mfma_f32_16x16x32_bf16(a0, b0, acc, 0, 0, 0);
    acc = __builtin_amdgcn_mfma_f32_16x16x32_bf16(a1, b1, acc, 0, 0, 0);
#pragma unroll
    for (int j = 0; j < 4; ++j) {
      const int t = 4 * g + j, s2 = i;
      const bool keep = (tt < 2) ? (s2 < t) : (s2 <= t);
      const float val = keep ? acc[j] : 0.f;
      if (tt == 0) s_Aab[t * 17 + s2] = val;
      else if (tt == 1) s_Aak[t * 17 + s2] = val;
      else rec[REC_AR + (16 * (s2 >> 2) + t) * 8 + (s2 & 3) + 4 * (tt & 1)] = f2bf(val);
    }
  }
  __syncthreads();
  if (tid < 80) {
    float X[16];
#pragma unroll
    for (int t = 0; t < 16; ++t) {
      float val = (tid < 64) ? s_at[t * LS + tid] : s_Aak[t * 17 + (tid - 64)];
#pragma unroll
      for (int s2 = 0; s2 < t; ++s2) val += s_Aab[t * 17 + s2] * X[s2];
      X[t] = val;
    }
    if (tid < 64) {
      const int k5 = tid & 31;
      const int base = REC_M1 + (tid >> 5) * 512 + (16 * ((k5 & 15) >> 2)) * 8 + (k5 & 3) + 4 * (k5 >> 4);
#pragma unroll
      for (int t = 0; t < 16; ++t) rec[base + t * 8] = f2bf(X[t]);
    } else {
      const int s2 = tid - 64;
      const int base = REC_TA + (16 * (s2 >> 2)) * 8 + (s2 & 3);
#pragma unroll
      for (int t = 0; t < 16; ++t) { rec[base + t * 8] = f2bf(X[t]); rec[base + t * 8 + 4] = 0; }
    }
  }
  __syncthreads();
  {
    const uint4* srcv = (const uint4*)rec;
    uint4* dstv = (uint4*)recb;
#pragma unroll
    for (int u = 0; u < 3; ++u) dstv[tid + 256 * u] = srcv[tid + 256 * u];
  }
#pragma unroll
  for (int u = 0; u < 3; ++u) if (prow[u] >= 0) *(uint4*)(s_raw + plds[u]) = pre[u];
  __syncthreads();
  }
#undef RP_PREFETCH
}


#define WAVE_FENCE() do { __builtin_amdgcn_wave_barrier(); asm volatile("s_waitcnt lgkmcnt(0)" ::: "memory"); __builtin_amdgcn_wave_barrier(); } while (0)
__device__ void rwkv_prep_waves(const Params& P, int vb, unsigned char* ldsb) {
  const int tid = threadIdx.x, lane = tid & 63, w = tid >> 6, g = lane >> 4, i = lane & 15;
  const int bh = vb >> 2, b = bh >> 3, h = bh & 7;
  bf16_t* s_du = (bf16_t*)ldsb;
  bf16_t* s_iu = s_du + 64 * 72;
  __syncthreads();
  {
    const int row = tid >> 3, pc = tid & 7;
    *(uint4*)(s_du + row * 72 + pc * 8) = *(const uint4*)(P.dut + (size_t)(h * 64 + row) * 64 + pc * 8);
    *(uint4*)(s_iu + row * 72 + pc * 8) = *(const uint4*)(P.iut + (size_t)(h * 64 + row) * 64 + pc * 8);
  }
  int2* ptab = (int2*)(ldsb + 18432 + 8 * 16384);
  for (int e = tid; e < 11 * 64; e += 512) {
    int q = e; const bool ok = q < 680; q = ok ? q : 679;
    const int rr = q / 40, qq = q - rr * 40, cg = qq >> 3, sub = qq & 7;
    const int col = ((cg < 3) ? (cg * 512 + h * 64) : (cg == 3 ? OFF_WLO : OFF_ALO)) + sub * 8;
    ptab[e] = make_int2((rr * 656 + cg * 128 + sub * 16) | (rr << 16) | (ok ? 0 : (int)0x80000000), col);
  }
  __syncthreads();
  unsigned char* wb = ldsb + 18432 + w * 16384;
  bf16_t* s_twb = (bf16_t*)wb;              bf16_t* s_pab = s_twb + 16 * 72;
  float* s_xw = (float*)(wb + 4608);        float* s_xa = s_xw + 16 * 68;
  bf16_t* im_a = (bf16_t*)(wb + 4608);      bf16_t* im_b = im_a + 1152; bf16_t* im_k = im_b + 1152; bf16_t* im_r = im_k + 1152;
  bf16_t* im_m1 = (bf16_t*)wb;              bf16_t* arim = (bf16_t*)(wb + 2304); bf16_t* taim = (bf16_t*)(wb + 3328);
  float* s_Aab = (float*)(wb + 14208);      float* s_Aak = s_Aab + 272;
  const int c = h * 64 + lane;
  const float mix_r = P.shift_mix[OFF_R + c], mix_k = P.shift_mix[OFF_K + c], mix_v = P.shift_mix[OFF_V + c];
  const float mix_w = P.shift_mix[OFF_WLO + lane], mix_a = P.shift_mix[OFF_ALO + lane];
  const float dbase = P.decay_base[c], ibase = P.iclr_base[c], kns = P.key_norm_scale[c], kim = P.key_iclr_mix[c], bon = P.bonus[c];
  const bf16_t* pb = P.p + (size_t)(b * SEQ) * NIN;
  bf16_t* rawb = (bf16_t*)(wb + 4608);
  u32x4 pre[11];
#define RAWP_LOAD(chn) do { _Pragma("unroll") for (int u = 0; u < 11; ++u) { const int2 e_ = ptab[u * 64 + lane]; \
    int t_ = (chn) * 16 - 1 + ((e_.x >> 16) & 0x7fff); t_ = (t_ < 0) ? 0 : t_; \
    pre[u] = ld_nt(pb + (size_t)t_ * NIN + e_.y); } } while (0)
  RAWP_LOAD((vb & 3) * 64 + w);
  for (int k8 = 0; k8 < 8; ++k8) {
    const int ch = (vb & 3) * 64 + w + 8 * k8;
    const int t0 = ch * 16;
    char* recb = P.rec + (size_t)(bh * 256 + ch) * REC_BYTES;
    float r[16], an[16], bb[16], km[16], LW[16];
#pragma unroll
    for (int u = 0; u < 11; ++u) {
      const int ex = ptab[u * 64 + lane].x;
      u32x4 val = pre[u];
      if (t0 == 0 && (ex & 0x7fff0000) == 0) val = (u32x4){0u, 0u, 0u, 0u};
      if (ex >= 0) *(u32x4*)((unsigned char*)rawb + (ex & 0xffff)) = val;
    }
    WAVE_FENCE();
    {
      float pr = bf2f(rawb[lane]), pk = bf2f(rawb[64 + lane]), pv = bf2f(rawb[128 + lane]), pw = bf2f(rawb[192 + lane]), pa = bf2f(rawb[256 + lane]);
      float vv[16];
#pragma unroll
      for (int t = 0; t < 16; ++t) {
        const bf16_t* row = rawb + (t + 1) * 328;
        const float cr = bf2f(row[lane]), ck = bf2f(row[64 + lane]), cv = bf2f(row[128 + lane]), cw = bf2f(row[192 + lane]), ca = bf2f(row[256 + lane]);
        r[t] = cr + (pr - cr) * mix_r;
        km[t] = ck + (pk - ck) * mix_k;
        vv[t] = cv + (pv - cv) * mix_v;
        s_twb[t * 72 + lane] = f2bf(fast_tanh(cw + (pw - cw) * mix_w));
        s_pab[t * 72 + lane] = f2bf(ca + (pa - ca) * mix_a);
        pr = cr; pk = ck; pv = cv; pw = cw; pa = ca;
      }
#pragma unroll
      for (int g2 = 0; g2 < 4; ++g2) {
        typedef unsigned u32x2_t __attribute__((ext_vector_type(2)));
        u32x2_t o; o.x = pk_bf16(vv[4 * g2], vv[4 * g2 + 1]); o.y = pk_bf16(vv[4 * g2 + 2], vv[4 * g2 + 3]);
        *(u32x2_t*)(recb + 10240 + (lane >> 4) * 512 + (16 * g2 + (lane & 15)) * 8) = o;
      }
    }
    WAVE_FENCE();
    {
      const bf16x8 aw0 = *(const bf16x8*)(s_twb + i * 72 + 8 * g), aw1 = *(const bf16x8*)(s_twb + i * 72 + 32 + 8 * g);
      const bf16x8 aa0 = *(const bf16x8*)(s_pab + i * 72 + 8 * g), aa1 = *(const bf16x8*)(s_pab + i * 72 + 32 + 8 * g);
#pragma unroll
      for (int nt = 0; nt < 4; ++nt) {
        const bf16x8 bd0 = *(const bf16x8*)(s_du + (16 * nt + i) * 72 + 8 * g), bd1 = *(const bf16x8*)(s_du + (16 * nt + i) * 72 + 32 + 8 * g);
        const bf16x8 bi0 = *(const bf16x8*)(s_iu + (16 * nt + i) * 72 + 8 * g), bi1 = *(const bf16x8*)(s_iu + (16 * nt + i) * 72 + 32 + 8 * g);
        f32x4 xw = (f32x4){0.f, 0.f, 0.f, 0.f}, xa = (f32x4){0.f, 0.f, 0.f, 0.f};
        xw = __builtin_amdgcn_mfma_f32_16x16x32_bf16(aw0, bd0, xw, 0, 0, 0);
        xw = __builtin_amdgcn_mfma_f32_16x16x32_bf16(aw1, bd1, xw, 0, 0, 0);
        xa = __builtin_amdgcn_mfma_f32_16x16x32_bf16(aa0, bi0, xa, 0, 0, 0);
        xa = __builtin_amdgcn_mfma_f32_16x16x32_bf16(aa1, bi1, xa, 0, 0, 0);
#pragma unroll
        for (int j = 0; j < 4; ++j) {
          s_xw[(4 * g + j) * 68 + 16 * nt + i] = xw[j];
          s_xa[(4 * g + j) * 68 + 16 * nt + i] = xa[j];
        }
      }
    }
    WAVE_FENCE();
    {
      float run = 0.f, myrk = 0.f;
#pragma unroll
      for (int t = 0; t < 16; ++t) {
        const float lwv = -0.6065306597126334f * __builtin_amdgcn_rcpf(1.f + __expf(-(dbase + s_xw[t * 68 + lane])));
        const float a = __builtin_amdgcn_rcpf(1.f + __expf(-(ibase + s_xa[t * 68 + lane])));
        const float pk = km[t];
        const float kkr = pk * kns;
        const float ss = wave_sum(kkr * kkr);
        const float kk = kkr * rsqrtf(fmaxf(ss, 1e-24f));
        const float kmod = pk * (1.f + (a - 1.f) * kim);
        km[t] = kmod; an[t] = -kk; bb[t] = kk * a;
        run += lwv; LW[t] = run;
        const float rk = wave_sum(r[t] * kmod * bon);
        if (lane == t) myrk = rk;
        if ((t & 7) == 7) __builtin_amdgcn_sched_barrier(0);
      }
      if (lane < 16) ((float*)(recb + REC_RKB_B))[lane] = myrk;
    }
    WAVE_FENCE();
    {
      const float LWC = LW[15];
      const float ewc = __expf(LWC);
      float e_prev = 1.f;
      ((float*)(recb + REC_WC_B))[lane] = ewc;
#pragma unroll
      for (int g2 = 0; g2 < 4; ++g2) {
        float Bp[4], Kp[4];
#pragma unroll
        for (int j = 0; j < 4; ++j) {
          const int t = 4 * g2 + j;
          const float e_p = e_prev, e_n = __expf(-LW[t]), e_r = __builtin_amdgcn_rcpf(e_n), e_c = ewc * e_n;
          e_prev = e_r;
          const float at = an[t] * e_p;
          an[t] = at;
          im_a[t * 72 + lane] = f2bf(at);
          im_b[t * 72 + lane] = f2bf(bb[t] * e_n);
          im_k[t * 72 + lane] = f2bf(km[t] * e_n);
          im_r[t * 72 + lane] = f2bf(r[t] * e_r);
          Bp[j] = bb[t] * e_c; Kp[j] = km[t] * e_c;
        }
        u32x4 o; o.x = pk_bf16(Bp[0], Bp[1]); o.y = pk_bf16(Bp[2], Bp[3]); o.z = pk_bf16(Kp[0], Kp[1]); o.w = pk_bf16(Kp[2], Kp[3]);
        *(u32x4*)(recb + 4096 + (lane >> 4) * 1024 + (16 * g2 + (lane & 15)) * 16) = o;
      }
    }
    WAVE_FENCE();
    { const int chn = (k8 < 7) ? ch + 8 : ch; RAWP_LOAD(chn); }
    float abm0, abm1, abm2, abm3;
    {
      const bf16x8 fa0 = *(const bf16x8*)(im_a + i * 72 + 8 * g), fa1 = *(const bf16x8*)(im_a + i * 72 + 32 + 8 * g);
      const bf16x8 fr0 = *(const bf16x8*)(im_r + i * 72 + 8 * g), fr1 = *(const bf16x8*)(im_r + i * 72 + 32 + 8 * g);
      const bf16x8 fb0 = *(const bf16x8*)(im_b + i * 72 + 8 * g), fb1 = *(const bf16x8*)(im_b + i * 72 + 32 + 8 * g);
      const bf16x8 fk0 = *(const bf16x8*)(im_k + i * 72 + 8 * g), fk1 = *(const bf16x8*)(im_k + i * 72 + 32 + 8 * g);
      const f32x4 z4 = (f32x4){0.f, 0.f, 0.f, 0.f};
      f32x4 ab = __builtin_amdgcn_mfma_f32_16x16x32_bf16(fa0, fb0, z4, 0, 0, 0); ab = __builtin_amdgcn_mfma_f32_16x16x32_bf16(fa1, fb1, ab, 0, 0, 0);
      f32x4 ak = __builtin_amdgcn_mfma_f32_16x16x32_bf16(fa0, fk0, z4, 0, 0, 0); ak = __builtin_amdgcn_mfma_f32_16x16x32_bf16(fa1, fk1, ak, 0, 0, 0);
      f32x4 rb = __builtin_amdgcn_mfma_f32_16x16x32_bf16(fr0, fb0, z4, 0, 0, 0); rb = __builtin_amdgcn_mfma_f32_16x16x32_bf16(fr1, fb1, rb, 0, 0, 0);
      f32x4 rk = __builtin_amdgcn_mfma_f32_16x16x32_bf16(fr0, fk0, z4, 0, 0, 0); rk = __builtin_amdgcn_mfma_f32_16x16x32_bf16(fr1, fk1, rk, 0, 0, 0);
      abm0 = (i < 4 * g + 0) ? ab[0] : 0.f; abm1 = (i < 4 * g + 1) ? ab[1] : 0.f;
      abm2 = (i < 4 * g + 2) ? ab[2] : 0.f; abm3 = (i < 4 * g + 3) ? ab[3] : 0.f;
#pragma unroll
      for (int j = 0; j < 4; ++j) {
        const int t = 4 * g + j, s2 = i;
        s_Aak[t * 17 + s2] = (s2 < t) ? ak[j] : 0.f;
        const int ara = (16 * (s2 >> 2) + t) * 8 + (s2 & 3);
        arim[ara] = f2bf((s2 <= t) ? rb[j] : 0.f);
        arim[ara + 4] = f2bf((s2 <= t) ? rk[j] : 0.f);
      }
    }
    WAVE_FENCE();
    {
      float X[16], Y[16];
      const int sc = lane & 15;
#pragma unroll
      for (int t = 0; t < 16; ++t) {
        float v1 = an[t], v2 = s_Aak[t * 17 + sc];
        const float arow = ((t & 3) == 0) ? abm0 : ((t & 3) == 1) ? abm1 : ((t & 3) == 2) ? abm2 : abm3;
#pragma unroll
        for (int s2 = 0; s2 < t; ++s2) {
          const float cf = __builtin_bit_cast(float, __builtin_amdgcn_readlane(__builtin_bit_cast(int, arow), 16 * (t >> 2) + s2));
          v1 += cf * X[s2]; v2 += cf * Y[s2];
        }
        X[t] = v1; Y[t] = v2;
        im_m1[t * 72 + lane] = f2bf(v1);
        if (lane < 16) { const int ta = (16 * (sc >> 2) + t) * 8 + (sc & 3); taim[ta] = f2bf(v2); taim[ta + 4] = 0; }
        __builtin_amdgcn_sched_barrier(0);
      }
    }
    WAVE_FENCE();
    {
      typedef unsigned u32x2_t __attribute__((ext_vector_type(2)));
#pragma unroll
      for (int ks = 0; ks < 2; ++ks) {
        const u32x2_t ml = *(const u32x2_t*)(im_m1 + i * 72 + 32 * ks + 4 * g), mh = *(const u32x2_t*)(im_m1 + i * 72 + 32 * ks + 16 + 4 * g);
        const u32x2_t rl = *(const u32x2_t*)(im_r + i * 72 + 32 * ks + 4 * g), rh = *(const u32x2_t*)(im_r + i * 72 + 32 * ks + 16 + 4 * g);
        u32x4 mo; mo.x = ml.x; mo.y = ml.y; mo.z = mh.x; mo.w = mh.y;
        u32x4 ro; ro.x = rl.x; ro.y = rl.y; ro.z = rh.x; ro.w = rh.y;
        *(u32x4*)(recb + ks * 1024 + lane * 16) = mo;
        *(u32x4*)(recb + 2048 + ks * 1024 + lane * 16) = ro;
      }
      *(u32x4*)(recb + 8192 + lane * 16) = *(const u32x4*)(taim + lane * 8);
      *(u32x4*)(recb + 9216 + lane * 16) = *(const u32x4*)(arim + lane * 8);
    }
    WAVE_FENCE();
  }
#undef RAWP_LOAD
}

constexpr int SCAN_SLOT = 13312, SCAN_D = 10;
__device__ void rwkv_scan_block(const Params& P, int bh, LAS unsigned char* lds) {
  const int tid = threadIdx.x, wave = __builtin_amdgcn_readfirstlane(tid >> 6), lane = tid & 63;
  const char* rec0 = P.rec + (size_t)(bh * 256) * REC_BYTES;
  if (wave >= 2) {
    const int lw = wave - 2;
    const char* src0 = rec0 + lw * 2048 + lane * 16;
#define SCAN_ISSUE(chsrc, slot) do { const char* src_ = src0 + (size_t)(chsrc) * REC_BYTES; LAS unsigned char* dst_ = lds + (slot) * SCAN_SLOT + lw * 2048; \
    _Pragma("unroll") for (int u_ = 0; u_ < 2; ++u_) __builtin_amdgcn_global_load_lds((const unsigned*)(src_ + u_ * 1024), (LAS unsigned*)(dst_ + u_ * 1024), 16, 0, 2); \
    if (lw == 0) __builtin_amdgcn_global_load_lds((const unsigned*)(src_ + 12288), (LAS unsigned*)(dst_ + 12288), 16, 0, 2); } while (0)
#define SCAN_WAITBAR() do { if (lw == 0) asm volatile("s_waitcnt vmcnt(21)\n\ts_barrier" ::: "memory"); else asm volatile("s_waitcnt vmcnt(14)\n\ts_barrier" ::: "memory"); } while (0)
#pragma unroll
    for (int c0 = 0; c0 < SCAN_D - 1; ++c0) SCAN_ISSUE(c0, c0);
    SCAN_WAITBAR();
    int slot = SCAN_D - 1;
    for (int ch = 0; ch < 256; ++ch) {
      const int nx = ch + SCAN_D - 1;
      SCAN_ISSUE((nx < 256 ? nx : 255), slot);
      slot = (slot == SCAN_D - 1) ? 0 : slot + 1;
      SCAN_WAITBAR();
    }
    asm volatile("s_waitcnt vmcnt(0)" ::: "memory");
#undef SCAN_ISSUE
#undef SCAN_WAITBAR
  } else {
    const int b = bh >> 3, h = bh & 7, cw = wave, g = lane >> 4, i = lane & 15;
    f32x4 sa[4], sbt[4];
#pragma unroll
    for (int kt = 0; kt < 4; ++kt) { sa[kt] = (f32x4){0.f, 0.f, 0.f, 0.f}; sbt[kt] = (f32x4){0.f, 0.f, 0.f, 0.f}; }
    const f32x4 zero4 = (f32x4){0.f, 0.f, 0.f, 0.f};
    typedef unsigned u32x2_t __attribute__((ext_vector_type(2)));
    struct Fr { u32x4 m1f0, m1f1, rf0, rf1, bk0, bk1, bk2, bk3, taf, arf; u32x2_t va, vb2; f32x4 wc0, wc1, wc2, wc3; };
#define SCAN_FR(F, slotv) do { const LAS unsigned char* sl_ = lds + (slotv) * SCAN_SLOT; const LAS u32x4* fr_ = (const LAS u32x4*)sl_; \
      F.m1f0 = fr_[lane]; F.m1f1 = fr_[64 + lane]; F.rf0 = fr_[128 + lane]; F.rf1 = fr_[192 + lane]; \
      F.bk0 = fr_[256 + lane]; F.bk1 = fr_[320 + lane]; F.bk2 = fr_[384 + lane]; F.bk3 = fr_[448 + lane]; F.taf = fr_[512 + lane]; F.arf = fr_[576 + lane]; \
      F.va = *(const LAS u32x2_t*)(sl_ + 10240 + (2 * cw) * 512 + lane * 8); F.vb2 = *(const LAS u32x2_t*)(sl_ + 10240 + (2 * cw + 1) * 512 + lane * 8); \
      const LAS f32x4* wc_ = (const LAS f32x4*)(sl_ + REC_WC_B); F.wc0 = wc_[g]; F.wc1 = wc_[4 + g]; F.wc2 = wc_[8 + g]; F.wc3 = wc_[12 + g]; } while (0)
#define SCAN_TILE(F, S, VBL, vtv, chv) do { \
      u32x4 sb0, sb1; \
      sb0.x = pk_bf16(S[0][0], S[0][1]); sb0.y = pk_bf16(S[0][2], S[0][3]); sb0.z = pk_bf16(S[1][0], S[1][1]); sb0.w = pk_bf16(S[1][2], S[1][3]); \
      sb1.x = pk_bf16(S[2][0], S[2][1]); sb1.y = pk_bf16(S[2][2], S[2][3]); sb1.z = pk_bf16(S[3][0], S[3][1]); sb1.w = pk_bf16(S[3][2], S[3][3]); \
      u32x4 vbz; vbz.x = VBL.x; vbz.y = VBL.y; vbz.z = 0u; vbz.w = 0u; \
      f32x4 u = __builtin_amdgcn_mfma_f32_16x16x32_bf16(as_frag(F.taf), as_frag(vbz), zero4, 0, 0, 0); \
      u = __builtin_amdgcn_mfma_f32_16x16x32_bf16(as_frag(F.m1f0), as_frag(sb0), u, 0, 0, 0); \
      u = __builtin_amdgcn_mfma_f32_16x16x32_bf16(as_frag(F.m1f1), as_frag(sb1), u, 0, 0, 0); \
      u32x4 uvb; uvb.x = pk_bf16(u[0], u[1]); uvb.y = pk_bf16(u[2], u[3]); uvb.z = VBL.x; uvb.w = VBL.y; \
      f32x4 y = __builtin_amdgcn_mfma_f32_16x16x32_bf16(as_frag(F.rf0), as_frag(sb0), zero4, 0, 0, 0); \
      y = __builtin_amdgcn_mfma_f32_16x16x32_bf16(as_frag(F.rf1), as_frag(sb1), y, 0, 0, 0); \
      y = __builtin_amdgcn_mfma_f32_16x16x32_bf16(as_frag(F.arf), as_frag(uvb), y, 0, 0, 0); \
      S[0] = __builtin_amdgcn_mfma_f32_16x16x32_bf16(as_frag(F.bk0), as_frag(uvb), S[0] * F.wc0, 0, 0, 0); \
      S[1] = __builtin_amdgcn_mfma_f32_16x16x32_bf16(as_frag(F.bk1), as_frag(uvb), S[1] * F.wc1, 0, 0, 0); \
      S[2] = __builtin_amdgcn_mfma_f32_16x16x32_bf16(as_frag(F.bk2), as_frag(uvb), S[2] * F.wc2, 0, 0, 0); \
      S[3] = __builtin_amdgcn_mfma_f32_16x16x32_bf16(as_frag(F.bk3), as_frag(uvb), S[3] * F.wc3, 0, 0, 0); \
      _Pragma("unroll") for (int j = 0; j < 4; ++j) (ystage + ((chv) & 1) * 512)[(4 * g + j) * 32 + 16 * ((vtv) & 1) + i] = f2bf(y[j]); } while (0)
#define SCAN_YOUT(chprev) do { const u32x4 yv_ = *(const LAS u32x4*)(ystage + ((chprev) & 1) * 512 + (lane >> 2) * 32 + (lane & 3) * 8); \
      *(u32x4*)(P.yraw + (size_t)(b * SEQ + (chprev) * 16 + (lane >> 2)) * 512 + h * 64 + 32 * cw + (lane & 3) * 8) = yv_; } while (0)
#define SCAN_STEP(F, chv) do { if ((chv) > 0) SCAN_YOUT((chv) - 1); SCAN_TILE(F, sa, F.va, 2 * cw, chv); SCAN_TILE(F, sbt, F.vb2, 2 * cw + 1, chv); } while (0)
    LAS bf16_t* ystage = (LAS bf16_t*)(lds + SCAN_D * SCAN_SLOT + cw * 2048);
    Fr FA, FB;
    asm volatile("s_barrier" ::: "memory");
    SCAN_FR(FA, 0);
    int slot = 1;
    for (int ch = 0; ch < 256; ch += 2) {
      SCAN_FR(FB, slot); slot = (slot == SCAN_D - 1) ? 0 : slot + 1;
      SCAN_STEP(FA, ch);
      asm volatile("s_waitcnt lgkmcnt(0)\n\ts_barrier" ::: "memory");
      SCAN_FR(FA, slot); slot = (slot == SCAN_D - 1) ? 0 : slot + 1;
      SCAN_STEP(FB, ch + 1);
      asm volatile("s_waitcnt lgkmcnt(0)\n\ts_barrier" ::: "memory");
    }
    SCAN_YOUT(255);
#undef SCAN_YOUT
#undef SCAN_FR
#undef SCAN_TILE
#undef SCAN_STEP
  }
  __syncthreads();
}

#ifndef ATT_TR
#define ATT_TR 1
#endif
constexpr int ATT_ITEMS = 64 * 3 * 32;
constexpr int KV_LD = 72;
typedef short v4i16_t __attribute__((ext_vector_type(4)));
__device__ __forceinline__ bf16x8 vfrag(const bf16_t* sV, int row0, int row1, int g, int i, int mt) {
  bf16x8 a;
#if ATT_TR
  typedef __attribute__((address_space(3))) v4i16_t* ldsp;
  const v4i16_t lo = __builtin_amdgcn_ds_read_tr16_b64_v4i16((ldsp)(sV + (row0 + 4 * g + (i >> 2)) * KV_LD + 16 * mt + 4 * (i & 3)));
  const v4i16_t hi = __builtin_amdgcn_ds_read_tr16_b64_v4i16((ldsp)(sV + (row1 + 4 * g + (i >> 2)) * KV_LD + 16 * mt + 4 * (i & 3)));
#pragma unroll
  for (int j = 0; j < 4; ++j) { a[j] = lo[j]; a[4 + j] = hi[j]; }
#else
#pragma unroll
  for (int j = 0; j < 4; ++j) {
    a[j] = (short)sV[(row0 + 4 * g + j) * KV_LD + 16 * mt + i];
    a[4 + j] = (short)sV[(row1 + 4 * g + j) * KV_LD + 16 * mt + i];
  }
#endif
  return a;
}
constexpr int ATT_ROWS = 256;
struct AttnRegs { u32x4 k0, k1, k2, k3, k4, k5, k6, k7, v0, v1, v2, v3, v4, v5, v6, v7; bf16x8 qa0, qa1, qb0, qb1; };
__device__ __forceinline__ void attn_load(const Params& P, int item, const int tid, AttnRegs& R) {
  const int lane = tid & 63, w = tid >> 6, g = lane >> 4, i = lane & 15;
  const int bh = item / 96, rem = item % 96, pat = rem >> 5, idx = rem & 31;
  const int b = bh >> 3, h = bh & 7;
  const int sh = 2 * pat, dil = 1 << sh;
  const int rho = idx & (dil - 1), qt = idx >> sh;
  const bf16_t* pb = P.p + (size_t)(b * SEQ) * NIN;
#define ATT_LD(u, KK, VV) do { const int c_ = tid + 256 * (u), row_ = c_ >> 3, cc_ = c_ & 7; int ik_ = 128 * qt - 128 + row_; if (ik_ < 0) ik_ = 0; \
    const bf16_t* src_ = pb + (size_t)(rho + (ik_ << sh)) * NIN + h * 64 + cc_ * 8; KK = *(const u32x4*)(src_ + OFF_KB); VV = *(const u32x4*)(src_ + OFF_VB); } while (0)
  ATT_LD(0, R.k0, R.v0); ATT_LD(1, R.k1, R.v1); ATT_LD(2, R.k2, R.v2); ATT_LD(3, R.k3, R.v3);
  ATT_LD(4, R.k4, R.v4); ATT_LD(5, R.k5, R.v5); ATT_LD(6, R.k6, R.v6); ATT_LD(7, R.k7, R.v7);
#undef ATT_LD
  const int qposa = rho + ((128 * qt + 32 * w + i) << sh);
  const bf16_t* qsrc = pb + (size_t)qposa * NIN + OFF_Q + h * 64 + 8 * g;
  R.qa0 = *(const bf16x8*)(qsrc); R.qa1 = *(const bf16x8*)(qsrc + 32);
  const bf16_t* qsrb = qsrc + (size_t)(16 << sh) * NIN;
  R.qb0 = *(const bf16x8*)(qsrb); R.qb1 = *(const bf16x8*)(qsrb + 32);
}
__device__ __forceinline__ void attn_stage(float* sm, const int tid, const AttnRegs& R) {
  bf16_t* sK = (bf16_t*)sm;
  bf16_t* sV = sK + ATT_ROWS * KV_LD;
#define ATT_ST(u, KK, VV) do { const int c_ = tid + 256 * (u), row_ = c_ >> 3, cc_ = c_ & 7; *(u32x4*)(sK + row_ * KV_LD + cc_ * 8) = KK; *(u32x4*)(sV + row_ * KV_LD + cc_ * 8) = VV; } while (0)
  ATT_ST(0, R.k0, R.v0); ATT_ST(1, R.k1, R.v1); ATT_ST(2, R.k2, R.v2); ATT_ST(3, R.k3, R.v3);
  ATT_ST(4, R.k4, R.v4); ATT_ST(5, R.k5, R.v5); ATT_ST(6, R.k6, R.v6); ATT_ST(7, R.k7, R.v7);
#undef ATT_ST
}
__device__ __forceinline__ void attn_compute(const Params& P, int item, float* sm, const int tid, const int weff, const bf16x8 qf0, const bf16x8 qf1) {
  bf16_t* sK = (bf16_t*)sm;
  bf16_t* sV = sK + ATT_ROWS * KV_LD;
  const int lane = tid & 63, g = lane >> 4, i = lane & 15;
  const int bh = item / 96, rem = item % 96, pat = rem >> 5, idx = rem & 31;
  const int b = bh >> 3, h = bh & 7;
  const int sh = 2 * pat, dil = 1 << sh;
  const int rho = idx & (dil - 1), qt = idx >> sh;
  const int qpos = rho + ((128 * qt + 16 * weff + i) << sh);
  f32x4 st[9];
#pragma unroll
  for (int kt = 0; kt < 9; ++kt) {
    const bf16_t* kr = sK + (16 * (weff + kt) + i) * KV_LD + 8 * g;
    f32x4 acc = (f32x4){0.f, 0.f, 0.f, 0.f};
    acc = __builtin_amdgcn_mfma_f32_16x16x32_bf16(*(const bf16x8*)(kr), qf0, acc, 0, 0, 0);
    acc = __builtin_amdgcn_mfma_f32_16x16x32_bf16(*(const bf16x8*)(kr + 32), qf1, acc, 0, 0, 0);
    st[kt] = acc;
  }
  float mx = -INFINITY;
#pragma unroll
  for (int j = 0; j < 4; ++j) {
    if (4 * g + j < i) st[0][j] = -INFINITY;
    if (4 * g + j > i) st[8][j] = -INFINITY;
  }
  if (qt == 0) {
#pragma unroll
    for (int kt = 0; kt < 9; ++kt)
#pragma unroll
      for (int j = 0; j < 4; ++j) if (16 * (weff + kt) + 4 * g + j < 128) st[kt][j] = -INFINITY;
  }
#pragma unroll
  for (int kt = 0; kt < 9; ++kt)
#pragma unroll
    for (int j = 0; j < 4; ++j) mx = fmaxf(mx, st[kt][j]);
  mx = fmaxf(mx, __shfl_xor(mx, 16));
  mx = fmaxf(mx, __shfl_xor(mx, 32));
  constexpr float C2 = 0.125f * 1.4426950408889634f;
  const float nm2 = -mx * C2;
  float l = 0.f;
#pragma unroll
  for (int kt = 0; kt < 9; ++kt)
#pragma unroll
    for (int j = 0; j < 4; ++j) {
      const float pe = __builtin_amdgcn_exp2f(__builtin_fmaf(st[kt][j], C2, nm2));
      st[kt][j] = pe;
      l += pe;
    }
  l += __shfl_xor(l, 16);
  l += __shfl_xor(l, 32);
  f32x4 o[4];
#pragma unroll
  for (int mt = 0; mt < 4; ++mt) o[mt] = (f32x4){0.f, 0.f, 0.f, 0.f};
#pragma unroll
  for (int s2 = 0; s2 < 5; ++s2) {
    const int t0 = 2 * s2, t1 = (2 * s2 + 1 < 9) ? (2 * s2 + 1) : t0;
    u32x4 pw;
    pw.x = pk_bf16(st[t0][0], st[t0][1]); pw.y = pk_bf16(st[t0][2], st[t0][3]);
    pw.z = (2 * s2 + 1 < 9) ? pk_bf16(st[t1][0], st[t1][1]) : 0u; pw.w = (2 * s2 + 1 < 9) ? pk_bf16(st[t1][2], st[t1][3]) : 0u;
    const bf16x8 pbv = as_frag(pw);
#pragma unroll
    for (int mt = 0; mt < 4; ++mt) {
      const bf16x8 a = vfrag(sV, 16 * (weff + t0), 16 * (weff + t1), g, i, mt);
      o[mt] = __builtin_amdgcn_mfma_f32_16x16x32_bf16(a, pbv, o[mt], 0, 0, 0);
    }
  }
  const float rl = 1.f / l;
  const size_t bt = (size_t)(b * SEQ + qpos);
  bf16_t* od = P.p + bt * NIN + pat * 512 + h * 64 + 4 * g;
#pragma unroll
  for (int mt = 0; mt < 4; ++mt) {
    typedef unsigned u32x2_t __attribute__((ext_vector_type(2)));
    u32x2_t ov; ov.x = pk_bf16(o[mt][0] * rl, o[mt][1] * rl); ov.y = pk_bf16(o[mt][2] * rl, o[mt][3] * rl);
    *(u32x2_t*)(od + 16 * mt) = ov;
  }
  if (g == 0) ((float*)(P.p + bt * NIN + 1536))[pat * 8 + h] = mx * 0.125f + __logf(l);
}

constexpr int MERGE_ITEMS = MTOK * 8 * 8 / 512;
__device__ __forceinline__ void merge_one(const Params& P, const int gid, const bool scratch) {
  const int dg = gid & 7, h = (gid >> 3) & 7, bt = gid >> 6;
  bf16_t* prow = P.p + (size_t)bt * NIN;
  {
    const float* lse = (const float*)(prow + 1536);
    const float l0 = lse[h], l1 = lse[8 + h], l2 = lse[16 + h];
    const float m = fmaxf(l0, fmaxf(l1, l2));
    float w0 = __expf(l0 - m), w1 = __expf(l1 - m), w2 = __expf(l2 - m);
    const float rs = 1.f / (w0 + w1 + w2);
    w0 *= rs; w1 *= rs; w2 *= rs;
    const int off = h * 64 + dg * 8;
    const u32x4 a0 = ld_nt(prow + off), a1 = ld_nt(prow + 512 + off), a2 = ld_nt(prow + 1024 + off);
    const u32x4 zz = ld_nt(prow + OFF_ZB + off);
    const unsigned av0[4] = {a0.x, a0.y, a0.z, a0.w}, av1[4] = {a1.x, a1.y, a1.z, a1.w}, av2[4] = {a2.x, a2.y, a2.z, a2.w}, zv[4] = {zz.x, zz.y, zz.z, zz.w};
    unsigned ov[4];
#pragma unroll
    for (int u = 0; u < 4; ++u) {
      const float lo = w0 * __uint_as_float(av0[u] << 16) + w1 * __uint_as_float(av1[u] << 16) + w2 * __uint_as_float(av2[u] << 16);
      const float hi = w0 * __uint_as_float(av0[u] & 0xffff0000u) + w1 * __uint_as_float(av1[u] & 0xffff0000u) + w2 * __uint_as_float(av2[u] & 0xffff0000u);
      const float zl = __uint_as_float(zv[u] << 16), zh = __uint_as_float(zv[u] & 0xffff0000u);
      ov[u] = (unsigned)f2bf(lo * silu(zl)) | ((unsigned)f2bf(hi * silu(zh)) << 16);
    }
    *(uint4*)((scratch ? (bf16_t*)P.out + (size_t)bt * DM + 512 : prow + OFF_ZB) + off) = make_uint4(ov[0], ov[1], ov[2], ov[3]);
  }
  {
    const int cb = h * 64 + dg * 8;
    const u32x4 yy = ld_nt(P.yraw + (size_t)bt * 512 + cb);
    const u32x4 zz = ld_nt(prow + OFF_ZA + cb);
    const unsigned yv[4] = {yy.x, yy.y, yy.z, yy.w}, zv[4] = {zz.x, zz.y, zz.z, zz.w};
    float y[8];
#pragma unroll
    for (int u = 0; u < 4; ++u) { y[2 * u] = __uint_as_float(yv[u] << 16); y[2 * u + 1] = __uint_as_float(yv[u] & 0xffff0000u); }
    float sm1 = 0.f;
#pragma unroll
    for (int u = 0; u < 8; ++u) sm1 += y[u];
    sm1 += __shfl_xor(sm1, 1); sm1 += __shfl_xor(sm1, 2); sm1 += __shfl_xor(sm1, 4);
    const float mu = sm1 * (1.f / 64.f);
    float sq = 0.f;
#pragma unroll
    for (int u = 0; u < 8; ++u) { const float d = y[u] - mu; sq += d * d; }
    sq += __shfl_xor(sq, 1); sq += __shfl_xor(sq, 2); sq += __shfl_xor(sq, 4);
    const float rstd = rsqrtf(sq * (1.f / 64.f) + 64e-5f);
    const int b = bt >> 12, t = bt & (SEQ - 1), tl = t & 15;
    const char* recb = P.rec + (size_t)((b * 8 + h) * 256 + (t >> 4)) * REC_BYTES;
    const float rkb = ((const float*)(recb + REC_RKB_B))[tl];
    const bf16_t* vbp = (const bf16_t*)recb + REC_VB;
    float o[8];
#pragma unroll
    for (int u = 0; u < 8; ++u) {
      const int v = dg * 8 + u;
      const float vv = bf2f(vbp[(v >> 4) * 256 + (16 * (tl >> 2) + (v & 15)) * 4 + (tl & 3)]);
      const float yn = (y[u] - mu) * rstd * P.gn_gain[cb + u] + P.gn_bias[cb + u];
      const float z = (u & 1) ? __uint_as_float(zv[u >> 1] & 0xffff0000u) : __uint_as_float(zv[u >> 1] << 16);
      o[u] = (yn + rkb * vv) * silu(z);
    }
    *(uint4*)((scratch ? (bf16_t*)P.out + (size_t)bt * DM : prow + OFF_ZA) + cb) = make_uint4(pk_bf16(o[0], o[1]), pk_bf16(o[2], o[3]), pk_bf16(o[4], o[5]), pk_bf16(o[6], o[7]));
  }
}

__device__ void merge_item(const Params& P, int item, const bool scratch) {
  const int gid = item * 512 + threadIdx.x;
  merge_one(P, gid, scratch);
  merge_one(P, gid + (MERGE_ITEMS / 2) * 512, scratch);
}

__device__ void final_norm_item(const Params& P, int it, const bool scratch) {
  const int lane = threadIdx.x & 63, wv = threadIdx.x >> 6;
  const int row = it * 16 + wv * 2;
  const bf16_t* yb = (const bf16_t*)P.rec + (size_t)row * DM;
  u32x4 raw[4];
#pragma unroll
  for (int i = 0; i < 4; ++i) raw[i] = ld_nt(yb + (i >> 1) * DM + (i & 1) * 512 + lane * 8);
  float v[4][8];
  float ss0 = 0.f, ss1 = 0.f;
#pragma unroll
  for (int i = 0; i < 4; ++i)
#pragma unroll
    for (int e = 0; e < 4; ++e) {
      v[i][2 * e] = __uint_as_float(raw[i][e] << 16); v[i][2 * e + 1] = __uint_as_float(raw[i][e] & 0xffff0000u);
      const float q = v[i][2 * e] * v[i][2 * e] + v[i][2 * e + 1] * v[i][2 * e + 1];
      if (i < 2) ss0 += q; else ss1 += q;
    }
  ss0 = wave_sum(ss0); ss1 = wave_sum(ss1);
  const float rstd0 = rsqrtf(ss0 * (1.0f / DM) + 1e-6f), rstd1 = rsqrtf(ss1 * (1.0f / DM) + 1e-6f);
#pragma unroll
  for (int i = 0; i < 4; ++i) {
    const int col = (i & 1) * 512 + lane * 8;
    const f32x4 g0 = *(const f32x4*)(P.final_gain + col), g1 = *(const f32x4*)(P.final_gain + col + 4);
    const float rstd = (i < 2) ? rstd0 : rstd1;
    f32x4 o0, o1;
#pragma unroll
    for (int e = 0; e < 4; ++e) { o0[e] = v[i][e] * rstd * g0[e]; o1[e] = v[i][4 + e] * rstd * g1[e]; }
    float* dst = P.out + (size_t)(row + (i >> 1)) * DM + col;
    __builtin_nontemporal_store(o0, (f32x4*)dst); __builtin_nontemporal_store(o1, (f32x4*)(dst + 4));
  }
}

#define XB_TMO      128
#define XB_XCNT(j)  (256  + 64 * (j))
#define XB_XSUB(j)  (1280 + 64 * (j))
#define XB_XGEN(j)  (2304 + 64 * (j))
#define XB_TOP      3328
#define XB_TOPGEN   3392
#define XCD_BAR_WORDS 3456
#define XB_SPIN_CAP (1u << 18)
__device__ __forceinline__ unsigned xb_ld(unsigned* p)              { return __hip_atomic_load(p, __ATOMIC_RELAXED, __HIP_MEMORY_SCOPE_AGENT); }
__device__ __forceinline__ unsigned xb_add(unsigned* p, unsigned v) { return __hip_atomic_fetch_add(p, v, __ATOMIC_RELAXED, __HIP_MEMORY_SCOPE_AGENT); }
__device__ __forceinline__ unsigned xb_xcc_id() { return (unsigned)__builtin_amdgcn_s_getreg((3 << 11) | 20) & 0xFu; }
#define XB_SPIN(cond, bar) do { unsigned _sp = 0; while (cond) { __builtin_amdgcn_s_sleep(1); \
    if ((++_sp & 255u) == 0u) { if (xb_ld(&(bar)[XB_TMO])) break; if (_sp > XB_SPIN_CAP) { atomicAdd(&(bar)[XB_TMO], 1u); break; } } } } while (0)
struct XcdBarrier { unsigned* bar; unsigned x; volatile LAS unsigned* st; };
__device__ __forceinline__ XcdBarrier xcd_barrier_post(unsigned* bar, volatile LAS unsigned* st) {
  XcdBarrier b; b.bar = bar; b.x = xb_xcc_id(); b.st = st;
  if (threadIdx.x == 0) (void)xb_add(&bar[XB_XCNT(b.x)], 1u);
  return b;
}
__device__ __forceinline__ void xcd_barrier_complete(unsigned* bar, unsigned x, unsigned& nloc, unsigned& nx) {
  const unsigned G = gridDim.x * gridDim.y * gridDim.z;
  unsigned sum, cnt, mine, sp = 0u;
  for (;;) {
    sum = 0u; cnt = 0u; mine = 0u;
#pragma unroll
    for (unsigned j = 0; j < 16; ++j) { const unsigned c = xb_ld(&bar[XB_XCNT(j)]); sum += c; cnt += (c > 0u) ? 1u : 0u; mine = (j == x) ? c : mine; }
    if (sum == G) break;
    __builtin_amdgcn_s_sleep(1);
    if ((++sp & 255u) == 0u) { if (xb_ld(&bar[XB_TMO])) break; if (sp > XB_SPIN_CAP) { atomicAdd(&bar[XB_TMO], 1u); break; } }
  }
  nloc = mine > 0u ? mine : 1u; nx = cnt > 0u ? cnt : 1u;
}
__device__ __forceinline__ void xcd_barrier(const XcdBarrier& b) {
  asm volatile("s_waitcnt vmcnt(0)" ::: "memory");
  __syncthreads();
  if (threadIdx.x == 0) {
    unsigned* bar = b.bar;
    __builtin_amdgcn_s_waitcnt(0);
    unsigned nloc = b.st[0], nx = b.st[1];
    if (nloc == 0u) { xcd_barrier_complete(bar, b.x, nloc, nx); b.st[0] = nloc; b.st[1] = nx; }
    const unsigned old = xb_add(&bar[XB_XSUB(b.x)], 1u);
    const unsigned gen = old / nloc;
    if (old + 1u == (gen + 1u) * nloc) {
      __builtin_amdgcn_fence(__ATOMIC_RELEASE, "agent");
      asm volatile("s_waitcnt vmcnt(0)" ::: "memory");
      const unsigned og = xb_add(&bar[XB_TOP], 1u);
      const unsigned tg = og / nx;
      if (og + 1u == (tg + 1u) * nx) xb_add(&bar[XB_TOPGEN], 1u);
      else XB_SPIN(xb_ld(&bar[XB_TOPGEN]) == tg, bar);
      __builtin_amdgcn_fence(__ATOMIC_ACQUIRE, "agent");
      xb_add(&bar[XB_XGEN(b.x)], 1u);
      asm volatile("s_waitcnt vmcnt(0)" ::: "memory");
    } else {
      XB_SPIN(xb_ld(&bar[XB_XGEN(b.x)]) == gen, bar);
      __builtin_amdgcn_fence(__ATOMIC_ACQUIRE, "agent");
      asm volatile("s_waitcnt vmcnt(0)" ::: "memory");
    }
  }
  __syncthreads();
}

constexpr int LDS_CTRL = 18432 + 8 * 16384 + 5632;
constexpr int LDS_BYTES = LDS_CTRL + 16;
constexpr int HALF_LDS_FLOATS = 18432;
constexpr int SCAN_BLOCKS = 64;
#ifndef PROBE
#define PROBE 0
#endif

__global__ void __launch_bounds__(512, 2) fwd_megakernel(Params P) {
  extern __shared__ __attribute__((aligned(16))) unsigned char lds[];
  float* sm = (float*)lds;
  cg::grid_group grid = cg::this_grid();
  const int nb = gridDim.x, bid = blockIdx.x, tid = threadIdx.x, half = tid >> 8, t8 = tid & 255;
  float* smh = sm + half * HALF_LDS_FLOATS;
  volatile LAS unsigned* xst = (volatile LAS unsigned*)((LAS unsigned char*)lds + LDS_CTRL);
  if (tid == 0) { xst[0] = 0u; xst[1] = 0u; }
  __syncthreads();
  const XcdBarrier xbar = xcd_barrier_post(P.barw, xst);
  for (int rep = 0; rep < (PROBE == 5 ? 2 : 1); ++rep)
  for (int it = bid; it < PREP_ITEMS; it += nb) prep_item(P, it, sm);
  if (P.out == nullptr) grid.sync();
  for (int r_ = 0; r_ < (PROBE == 10 ? 3 : 1); ++r_) xcd_barrier(xbar);
  {
    pg8::Gemm g; g.A = P.hb; g.Bt = P.winT; g.M = MTOK; g.N = NPAD; g.K = DM; g.lda = DM;
    pg8::StaticOrder S; S.init(MTOK, NPAD, nb, bid);
    EpiProj E; E.p = P.p;
    pg8::gemm_phase<EpiProj>((LAS unsigned char*)lds, g, S, E);
    if (PROBE == 4) pg8::gemm_phase<EpiProj>((LAS unsigned char*)lds, g, S, E);
  }
  for (int r_ = 0; r_ < (PROBE == 10 ? 3 : 1); ++r_) xcd_barrier(xbar);
  for (int rep = 0; rep < (PROBE == 3 ? 2 : 1); ++rep)
  for (int vb = bid; vb < 256; vb += nb) rwkv_prep_waves(P, vb, (unsigned char*)lds);
  for (int r_ = 0; r_ < (PROBE == 10 ? 3 : 1); ++r_) xcd_barrier(xbar);
  for (int rep = 0; rep < (PROBE == 7 ? 2 : 1); ++rep) {
  if (bid < SCAN_BLOCKS) rwkv_scan_block(P, bid, (LAS unsigned char*)lds);
  {
    volatile LAS int* qslot = (volatile LAS int*)((LAS unsigned char*)lds + LDS_CTRL + 8);
    unsigned* ctr = P.barw + XCD_BAR_WORDS + 64 + rep * 1024;
    int qx = (int)(xbar.x & 7u), tried = 0;
    constexpr int QPAIRS = ATT_ITEMS / 16;
#define ATT_FETCH(dst) do { dst = -1; while (tried < 8) { const int ix_ = (int)atomicAdd(ctr + qx * 64, 1u); if (ix_ < QPAIRS) { dst = qx * QPAIRS + ix_; break; } qx = (qx + 1) & 7; ++tried; } } while (0)
    int a1 = -1;
    if (tid == 0) { int a0; ATT_FETCH(a0); ATT_FETCH(a1); *qslot = a0; }
    __syncthreads();
    int it = *qslot;
    AttnRegs R;
#define ATT_ITEM(pr) ((8 * ((2 * ((pr) % QPAIRS)) / 96) + (pr) / QPAIRS) * 96 + (2 * ((pr) % QPAIRS)) % 96 + half)
    attn_load(P, ATT_ITEM(it >= 0 ? it : 0), t8, R);
    while (it >= 0) {
      __syncthreads();
      if (tid == 0) { *qslot = a1; ATT_FETCH(a1); }
      attn_stage(smh, t8, R);
      const bf16x8 qa0 = R.qa0, qa1 = R.qa1, qb0 = R.qb0, qb1 = R.qb1;
      __syncthreads();
      const int itn = *qslot;
      attn_load(P, ATT_ITEM(itn >= 0 ? itn : 0), t8, R);
      const int item = ATT_ITEM(it);
      attn_compute(P, item, smh, t8, 2 * (t8 >> 6), qa0, qa1);
      attn_compute(P, item, smh, t8, 2 * (t8 >> 6) + 1, qb0, qb1);
      it = itn;
    }
#undef ATT_FETCH
#undef ATT_ITEM
  }
  __syncthreads();
  }
  for (int r_ = 0; r_ < (PROBE == 10 ? 3 : 1); ++r_) xcd_barrier(xbar);
  if (PROBE == 9) for (int it = bid; it < MERGE_ITEMS / 2; it += nb) merge_item(P, it, true);
  for (int it = bid; it < MERGE_ITEMS / 2; it += nb) merge_item(P, it, false);
  for (int r_ = 0; r_ < (PROBE == 10 ? 3 : 1); ++r_) xcd_barrier(xbar);
  {
    pg8::Gemm g; g.A = P.p + OFF_ZA; g.Bt = P.woutT; g.M = MTOK; g.N = DM; g.K = DM; g.lda = NIN;
    pg8::StaticOrder S; S.init(MTOK, DM, nb, bid);
    EpiOut E; E.x = P.x; E.ybf = (bf16_t*)P.rec;
    pg8::gemm_phase<EpiOut>((LAS unsigned char*)lds, g, S, E);
    if (PROBE == 6) pg8::gemm_phase<EpiOut>((LAS unsigned char*)lds, g, S, E);
  }
  for (int r_ = 0; r_ < (PROBE == 10 ? 3 : 1); ++r_) xcd_barrier(xbar);
  for (int it = bid; it < MTOK / 16; it += nb) final_norm_item(P, it, false);
}

extern "C" void kernel_launch(void* const* d_in, const int* in_sizes, int n_in, void* d_out, int out_size, void* d_ws, size_t ws_size,
                              hipStream_t stream) {
  Params P{};
  P.x = (const float*)d_in[0]; P.norm_gain = (const float*)d_in[1]; P.w_in = (const float*)d_in[2]; P.shift_mix = (const float*)d_in[3];
  P.decay_base = (const float*)d_in[4]; P.decay_up = (const float*)d_in[5]; P.iclr_base = (const float*)d_in[6]; P.iclr_up = (const float*)d_in[7];
  P.key_norm_scale = (const float*)d_in[8]; P.key_iclr_mix = (const float*)d_in[9]; P.bonus = (const float*)d_in[10]; P.gn_gain = (const float*)d_in[11];
  P.gn_bias = (const float*)d_in[12]; P.w_out = (const float*)d_in[13]; P.final_gain = (const float*)d_in[14];
  P.out = (float*)d_out;
  char* ws = (char*)d_ws;
  const size_t MiB = 1024 * 1024;
  P.winT = (bf16_t*)(ws);
  P.woutT = (bf16_t*)(ws + 9 * MiB);
  P.dut = (bf16_t*)(ws + 11 * MiB);
  P.iut = (bf16_t*)(ws + 11 * MiB + 65536);
  P.p = (bf16_t*)(ws + 12 * MiB);
  P.hb = (bf16_t*)(ws + 276 * MiB);
  P.rec = ws + 276 * MiB;
  P.yraw = (bf16_t*)(ws + 474 * MiB);
  P.barw = (unsigned*)(ws + 506 * MiB);
  if (ws_size < 507 * MiB) { fprintf(stderr, "workspace too small\n"); return; }
  static int grid_blocks = 0;
  if (!grid_blocks) {
    int dev = 0, cus = 0, per_cu = 0;
    (void)hipGetDevice(&dev);
    (void)hipDeviceGetAttribute(&cus, hipDeviceAttributeMultiprocessorCount, dev);
    (void)hipFuncSetAttribute((const void*)fwd_megakernel, hipFuncAttributeMaxDynamicSharedMemorySize, LDS_BYTES);
    (void)hipOccupancyMaxActiveBlocksPerMultiprocessor(&per_cu, fwd_megakernel, 512, LDS_BYTES);
    if (per_cu > 1) per_cu = 1;
    grid_blocks = cus * per_cu;
  }
  (void)hipMemsetAsync(P.barw, 0, (XCD_BAR_WORDS + 64 + 2048) * sizeof(unsigned), stream);
  void* args[] = {&P};
  hipError_t e = hipLaunchCooperativeKernel((void*)fwd_megakernel, dim3(grid_blocks), dim3(512), args, LDS_BYTES, stream);
  if (e != hipSuccess) fprintf(stderr, "cooperative launch failed: %s (grid %d)\n", hipGetErrorString(e), grid_blocks);
}
```

```cpp
#include <hip/hip_runtime.h>
#include <hip/hip_cooperative_groups.h>
#include <stdint.h>
#include <cstdio>
namespace cg = cooperative_groups;

typedef unsigned short bf16_t;
typedef short bf16x8 __attribute__((ext_vector_type(8)));
typedef float f32x4 __attribute__((ext_vector_type(4)));
typedef unsigned u32x4 __attribute__((ext_vector_type(4)));
#define LAS __attribute__((address_space(3)))

constexpr int SEQ = 4096, DM = 1024, MTOK = 32768, NIN = 4224, NPAD = 4352;
constexpr int OFF_R = 0, OFF_K = 512, OFF_V = 1024, OFF_WLO = 1536, OFF_ALO = 1600;
constexpr int OFF_Q = 1664, OFF_KB = 2176, OFF_VB = 2688, OFF_ZA = 3200, OFF_ZB = 3712;

struct Params {
  const float *x, *norm_gain, *w_in, *shift_mix, *decay_base, *decay_up, *iclr_base, *iclr_up,
      *key_norm_scale, *key_iclr_mix, *bonus, *gn_gain, *gn_bias, *w_out, *final_gain;
  float* out;
  bf16_t *hb, *winT, *woutT, *p, *yraw, *dut, *iut;
  char* rec;
  unsigned* barw;
};

typedef float f32x2_t __attribute__((ext_vector_type(2)));
typedef __bf16 bf16x2_t __attribute__((ext_vector_type(2)));
__device__ __forceinline__ unsigned pk_bf16(float lo, float hi) { const f32x2_t v = {lo, hi}; return __builtin_bit_cast(unsigned, __builtin_convertvector(v, bf16x2_t)); }
__device__ __forceinline__ bf16_t f2bf(float f) { return (bf16_t)(pk_bf16(f, 0.f) & 0xffffu); }
__device__ __forceinline__ u32x4 ld_nt(const void* p) { return __builtin_nontemporal_load((const u32x4*)p); }
__device__ __forceinline__ f32x4 ldf_nt(const void* p) { return __builtin_nontemporal_load((const f32x4*)p); }
__device__ __forceinline__ float bf2f(bf16_t h) { return __uint_as_float(((unsigned)h) << 16); }
__device__ __forceinline__ float dpp_add(float v, const int ctrl_sel) {
  const int iv = __builtin_bit_cast(int, v);
  int o;
  if (ctrl_sel == 0) o = __builtin_amdgcn_update_dpp(iv, iv, 0xB1, 0xF, 0xF, false);
  else if (ctrl_sel == 1) o = __builtin_amdgcn_update_dpp(iv, iv, 0x4E, 0xF, 0xF, false);
  else if (ctrl_sel == 2) o = __builtin_amdgcn_update_dpp(iv, iv, 0x141, 0xF, 0xF, false);
  else o = __builtin_amdgcn_update_dpp(iv, iv, 0x140, 0xF, 0xF, false);
  return v + __builtin_bit_cast(float, o);
}
__device__ __forceinline__ float wave_sum(float v) {
  v = dpp_add(v, 0); v = dpp_add(v, 1); v = dpp_add(v, 2); v = dpp_add(v, 3);
  const int iv = __builtin_bit_cast(int, v);
  const float s0 = __builtin_bit_cast(float, __builtin_amdgcn_readlane(iv, 0)), s1 = __builtin_bit_cast(float, __builtin_amdgcn_readlane(iv, 16));
  const float s2 = __builtin_bit_cast(float, __builtin_amdgcn_readlane(iv, 32)), s3 = __builtin_bit_cast(float, __builtin_amdgcn_readlane(iv, 48));
  return (s0 + s1) + (s2 + s3);
}
__device__ __forceinline__ float silu(float z) { return z / (1.f + __expf(-z)); }
__device__ __forceinline__ bf16x8 as_frag(u32x4 v) { return __builtin_bit_cast(bf16x8, v); }

constexpr int PREP_ROW_ITEMS = MTOK / 16, PREP_WIN_TILES = 16 * 68, PREP_WOUT_TILES = 16 * 16;
constexpr int PREP_LR_ITEMS = 128;
constexpr int PREP_ITEMS = PREP_ROW_ITEMS + PREP_WIN_TILES + PREP_WOUT_TILES + PREP_LR_ITEMS;

__device__ void prep_item(const Params& P, int it, float* sm) {
  const int tid = threadIdx.x, lane = tid & 63, wv = tid >> 6;
  if (it < PREP_ROW_ITEMS) {
    const int row = it * 16 + wv * 2;
    const float4* xr = (const float4*)(P.x + (size_t)row * DM);
    const float4* g4 = (const float4*)P.norm_gain;
    float4 v[8];
    float ss0 = 0.f, ss1 = 0.f;
#pragma unroll
    for (int i = 0; i < 8; ++i) { const f32x4 t_ = ldf_nt(xr + lane + 64 * i); v[i] = make_float4(t_[0], t_[1], t_[2], t_[3]); }
#pragma unroll
    for (int i = 0; i < 4; ++i) {
      ss0 += v[i].x * v[i].x + v[i].y * v[i].y + v[i].z * v[i].z + v[i].w * v[i].w;
      ss1 += v[4 + i].x * v[4 + i].x + v[4 + i].y * v[4 + i].y + v[4 + i].z * v[4 + i].z + v[4 + i].w * v[4 + i].w;
    }
    ss0 = wave_sum(ss0); ss1 = wave_sum(ss1);
    const float rstd0 = rsqrtf(ss0 * (1.0f / DM) + 1e-6f), rstd1 = rsqrtf(ss1 * (1.0f / DM) + 1e-6f);
#pragma unroll
    for (int i = 0; i < 8; ++i) {
      const float4 g = g4[lane + 64 * (i & 3)];
      const float rstd = (i < 4) ? rstd0 : rstd1;
      ushort4 o;
      o.x = f2bf(v[i].x * rstd * g.x); o.y = f2bf(v[i].y * rstd * g.y);
      o.z = f2bf(v[i].z * rstd * g.z); o.w = f2bf(v[i].w * rstd * g.w);
      *(ushort4*)(P.hb + (size_t)row * DM + (lane + 64 * i) * 4) = o;
    }
    return;
  }
  it -= PREP_ROW_ITEMS;
  if (it >= PREP_WIN_TILES + PREP_WOUT_TILES) {
    it -= PREP_WIN_TILES + PREP_WOUT_TILES;
    const float* srcm = (it < 64) ? P.decay_up : P.iclr_up;
    bf16_t* dstm = (it < 64) ? P.dut : P.iut;
    const int e = (it & 63) * 512 + tid, chn = e >> 6, k = e & 63;
    dstm[e] = f2bf(srcm[k * 512 + chn]);
    return;
  }
  const float* src; bf16_t* dst; int ncols, kt, nt, scol;
  if (it < PREP_WIN_TILES) {
    src = P.w_in; dst = P.winT; ncols = NIN; kt = it / 68; nt = it % 68;
    const int n0 = nt * 64;
    scol = (n0 < 1664) ? n0 : (n0 < 3200) ? (n0 + 512) : (n0 < 3712) ? (n0 - 1536) : (n0 < 4224) ? n0 : -1;
  } else { it -= PREP_WIN_TILES; src = P.w_out; dst = P.woutT; ncols = DM; kt = it / 16; nt = it % 16; scol = nt * 64; }
#pragma unroll 4
  for (int i = 0; i < 8; ++i) {
    const int r = wv + 8 * i;
    sm[r * 65 + lane] = (scol >= 0) ? src[(size_t)(kt * 64 + r) * ncols + scol + lane] : 0.f;
  }
  __syncthreads();
#pragma unroll 4
  for (int i = 0; i < 8; ++i) {
    const int r = wv + 8 * i;
    dst[(size_t)(nt * 64 + r) * DM + kt * 64 + lane] = f2bf(sm[lane * 65 + r]);
  }
  __syncthreads();
}

namespace pg8 {
constexpr int BM = 256, BK = 64, HALF = 128, HTB = HALF * BK * 2, STAGE_BYTES = 8 * HTB, NXCD = 8, WGM = 8;
__host__ __device__ __forceinline__ int lds_byte(int r, int c) { const int st = (r >> 4) * 2 + (c >> 5), rr = r & 15, cc = c & 31, ob = rr * 64 + cc * 2; return st * 1024 + (ob ^ (((ob >> 9) & 1) << 5)); }
__host__ __device__ __forceinline__ void stage_rc(int b, int& R, int& C) { const int st = b / 1024, sb = b % 1024, swz = sb ^ (((sb >> 9) & 1) << 5); R = (st >> 1) * 16 + swz / 64; C = (st & 1) * 32 + (swz % 64) / 2; }
__host__ __device__ __forceinline__ int perm32(int rho) { const int n = rho >> 4, i = rho & 15; return 8 * (i >> 2) + 4 * n + (i & 3); }
struct Unit { int pm, pn; };
struct Gemm { const bf16_t* A; const bf16_t* Bt; int M, N, K, lda; };
struct StaticOrder {
  int nM, nN, nwg, G, c;
  __host__ __device__ void init(int M, int N, int G_, int c_) { nM = M / BM; nN = N / BM; nwg = nM * nN; G = G_; c = c_; }
  __host__ __device__ bool next(int i, Unit& u) const {
    const long L = (long)i * G + c; if (L >= nwg) return false;
    int wgid = (int)L; { const int q = nwg / NXCD, r = nwg % NXCD, xcd = wgid % NXCD, off = wgid / NXCD; wgid = (xcd < r ? xcd * (q + 1) : r * (q + 1) + (xcd - r) * q) + off; }
    const int nig = WGM * nN, gid = wgid / nig, fm = gid * WGM, gsz = (nM - fm) < WGM ? (nM - fm) : WGM;
    u.pm = fm + ((wgid % nig) % gsz); u.pn = (wgid % nig) / gsz; return true;
  }
};
template <class Epi>
__device__ __forceinline__ void gemm_phase(LAS unsigned char* lds, const Gemm g, const StaticOrder& S, const Epi& E) {
  const int tid = threadIdx.x, wid = __builtin_amdgcn_readfirstlane(tid >> 6), lane = tid & 63, wr = wid >> 2, wc = wid & 3, fr = lane & 15, fq = lane >> 4;
  const int K = g.K, nt = K / BK, lda = g.lda;
  unsigned voffA[2], voffB[2];
#pragma unroll
  for (int i = 0; i < 2; ++i) { int R, C; stage_rc(tid * 16 + i * 8192, R, C); const int Rb = (R & ~31) + perm32(R & 31);
    voffA[i] = (unsigned)(R * lda + C) * 2u; voffB[i] = (unsigned)(Rb * K + C) * 2u; }
  const size_t kstep = (size_t)(BK * 2);
  const size_t hstepA = (size_t)HALF * lda * 2, hstepB = (size_t)HALF * K * 2;
  const size_t tstepA = 2 * hstepA, tstepB = 2 * hstepB;
  const unsigned ldsw = (unsigned)wid * 1024u;
  const int aoff = lds_byte(wr * 64 + fr, fq * 8), boff = lds_byte(wc * 32 + fr, fq * 8);
#define PG8_SA(b, h) (((b) * 2 + (h)) * HTB)
#define PG8_SB(b, h) ((4 + (b) * 2 + (h)) * HTB)
#define PG8_STAGE(bufoff, gbase, voff) do { _Pragma("unroll") for (int _i = 0; _i < 2; ++_i) \
    __builtin_amdgcn_global_load_lds((const unsigned*)((const char*)(gbase) + (voff)[_i]), (LAS unsigned*)(lds + (bufoff) + ldsw + _i * 8192), 16, 0, 0); } while (0)
#define PG8_LDA(dst, b, h) do { _Pragma("unroll") for (int m = 0; m < 4; ++m) _Pragma("unroll") for (int k = 0; k < 2; ++k) dst[m][k] = *(const LAS bf16x8*)(lds + PG8_SA(b, h) + aoff + m * 2048 + k * 1024); } while (0)
#define PG8_LDB(dst, b, h) do { _Pragma("unroll") for (int n = 0; n < 2; ++n) _Pragma("unroll") for (int k = 0; k < 2; ++k) dst[n][k] = *(const LAS bf16x8*)(lds + PG8_SB(b, h) + boff + n * 2048 + k * 1024); } while (0)
#define PG8_MMA(ai, bj, At, Bt) do { __builtin_amdgcn_s_setprio(1); _Pragma("unroll") for (int m = 0; m < 4; ++m) _Pragma("unroll") for (int n = 0; n < 2; ++n) _Pragma("unroll") for (int k = 0; k < 2; ++k) \
    acc[ai][bj][m][n] = __builtin_amdgcn_mfma_f32_16x16x32_bf16(Bt[n][k], At[m][k], acc[ai][bj][m][n], 0, 0, 0); __builtin_amdgcn_s_setprio(0); } while (0)
#define PG8_WAIT_V(n) asm volatile("s_waitcnt vmcnt(" #n ")" ::: "memory")
#define PG8_WAIT_L(n) asm volatile("s_waitcnt lgkmcnt(" #n ")" ::: "memory")
#define PG8_BAR __builtin_amdgcn_s_barrier()
#define PG8_SCHED __builtin_amdgcn_sched_barrier(0)
  Unit cur, nxt; int ui = 0;
  if (!S.next(0, cur)) return;
  f32x4 acc[2][2][4][2];
#pragma unroll
  for (int a = 0; a < 2; ++a)
#pragma unroll
    for (int b = 0; b < 2; ++b)
#pragma unroll
      for (int m = 0; m < 4; ++m)
#pragma unroll
        for (int n = 0; n < 2; ++n) acc[a][b][m][n] = (f32x4){0.f, 0.f, 0.f, 0.f};
  bf16x8 At[4][2], B0[2][2], B1[2][2];
  const char* cA = (const char*)g.A + (size_t)cur.pm * tstepA; const char* cB = (const char*)g.Bt + (size_t)cur.pn * tstepB;
  PG8_STAGE(PG8_SB(0, 0), cB, voffB); PG8_STAGE(PG8_SB(0, 1), cB + hstepB, voffB); PG8_STAGE(PG8_SA(0, 0), cA, voffA); PG8_STAGE(PG8_SA(0, 1), cA + hstepA, voffA);
  if (wr == 1) PG8_BAR;
  PG8_WAIT_V(2); PG8_BAR;
  PG8_STAGE(PG8_SB(1, 0), cB + kstep, voffB); PG8_STAGE(PG8_SA(1, 0), cA + kstep, voffA); PG8_STAGE(PG8_SB(1, 1), cB + hstepB + kstep, voffB);
  PG8_WAIT_V(6); PG8_BAR;
  for (;;) {
    const bool has_next = S.next(ui + 1, nxt);
    const char* nA = has_next ? (const char*)g.A + (size_t)nxt.pm * tstepA : cA; const char* nB = has_next ? (const char*)g.Bt + (size_t)nxt.pn * tstepB : cB;
    for (int t = 0; t < nt; t += 2) {
      const bool last = (t == nt - 2);
      const char* a1 = cA + (size_t)(t + 1) * kstep;
      const char* a2 = last ? nA : cA + (size_t)(t + 2) * kstep; const char* b2 = last ? nB : cB + (size_t)(t + 2) * kstep;
      const char* a3 = a2 + kstep; const char* b3 = b2 + kstep;
      PG8_LDB(B0, 0, 0); PG8_LDB(B1, 0, 1); PG8_SCHED; PG8_LDA(At, 0, 0); PG8_STAGE(PG8_SA(1, 1), a1 + hstepA, voffA);
      PG8_WAIT_V(8); PG8_WAIT_L(0); PG8_BAR; PG8_MMA(0, 0, At, B0); PG8_MMA(0, 1, At, B1); PG8_BAR; PG8_SCHED;
      PG8_LDA(At, 0, 1); PG8_STAGE(PG8_SB(0, 0), b2, voffB); PG8_STAGE(PG8_SB(0, 1), b2 + hstepB, voffB); PG8_STAGE(PG8_SA(0, 0), a2, voffA);
      PG8_WAIT_V(8); PG8_WAIT_L(0); PG8_BAR; PG8_MMA(1, 0, At, B0); PG8_MMA(1, 1, At, B1); PG8_BAR; PG8_SCHED;
      PG8_LDB(B0, 1, 0); PG8_LDB(B1, 1, 1); PG8_SCHED; PG8_LDA(At, 1, 0); PG8_STAGE(PG8_SA(0, 1), a2 + hstepA, voffA);
      PG8_WAIT_V(8); PG8_WAIT_L(0); PG8_BAR; PG8_MMA(0, 0, At, B0); PG8_MMA(0, 1, At, B1); PG8_BAR; PG8_SCHED;
      PG8_LDA(At, 1, 1); PG8_STAGE(PG8_SB(1, 0), b3, voffB); PG8_STAGE(PG8_SB(1, 1), b3 + hstepB, voffB); PG8_STAGE(PG8_SA(1, 0), a3, voffA);
      PG8_WAIT_V(8); PG8_WAIT_L(0); PG8_BAR; PG8_MMA(1, 0, At, B0); PG8_MMA(1, 1, At, B1); PG8_BAR; PG8_SCHED;
    }
    if (wr == 0) PG8_BAR;
    E(acc, cur, wr, wc, fr, fq);
    if (!has_next) break;
#pragma unroll
    for (int a = 0; a < 2; ++a)
#pragma unroll
      for (int b = 0; b < 2; ++b)
#pragma unroll
        for (int m = 0; m < 4; ++m)
#pragma unroll
          for (int n = 0; n < 2; ++n) acc[a][b][m][n] = (f32x4){0.f, 0.f, 0.f, 0.f};
    cur = nxt; cA = nA; cB = nB; ++ui;
    if (wr == 1) PG8_BAR;
  }
  PG8_WAIT_V(0);
  PG8_BAR;
#undef PG8_SA
#undef PG8_SB
#undef PG8_STAGE
#undef PG8_LDA
#undef PG8_LDB
#undef PG8_MMA
#undef PG8_WAIT_V
#undef PG8_WAIT_L
#undef PG8_BAR
#undef PG8_SCHED
}
}

struct EpiProj {
  bf16_t* p;
  __device__ __forceinline__ void operator()(const f32x4 (&acc)[2][2][4][2], const pg8::Unit& u, int wr, int wc, int fr, int fq) const {
    const float inv[8] = {1.0f, 0.1939227432012558f, 0.03760603070259094f, 0.007292664609849453f, 0.0014142135623842478f, 0.00027424818836152554f, 5.3182957344688475e-05f, 1.0313385246263351e-05f};
#pragma unroll
    for (int bj = 0; bj < 2; ++bj) {
      const int wcol = u.pn * 256 + bj * 128 + wc * 32;
      if (wcol >= NIN) continue;
      const int col0 = wcol + 8 * fq;
      const bool wrope = (wcol >= OFF_Q) && (wcol < OFF_VB) && ((wcol & 63) == 0);
#pragma unroll
      for (int ai = 0; ai < 2; ++ai)
#pragma unroll
        for (int m = 0; m < 4; ++m) {
          const int row = u.pm * 256 + ai * 128 + wr * 64 + m * 16 + fr;
          float v[8];
#pragma unroll
          for (int e = 0; e < 4; ++e) { v[e] = acc[ai][bj][m][0][e]; v[4 + e] = acc[ai][bj][m][1][e]; }
          if (wrope) {
            const float pos = (float)(row & (SEQ - 1));
#pragma unroll
            for (int e = 0; e < 8; ++e) {
              const float other = __shfl_xor(v[e], 16);
              float rev = pos * inv[e] * 0.15915494309189535f;
              rev = (rev - rintf(rev)) * 6.283185307179586f;
              const float sn = __sinf(rev), cs = __cosf(rev);
              const float r0 = v[e] * cs - other * sn, r1 = other * sn + v[e] * cs;
              v[e] = (fq == 0) ? r0 : (fq == 1) ? r1 : v[e];
            }
          }
          u32x4 w;
          w.x = pk_bf16(v[0], v[1]); w.y = pk_bf16(v[2], v[3]); w.z = pk_bf16(v[4], v[5]); w.w = pk_bf16(v[6], v[7]);
          __builtin_nontemporal_store(w, (u32x4*)(p + (size_t)row * NIN + col0));
        }
    }
  }
};
struct EpiOut {
  const float* x; bf16_t* ybf;
  __device__ __forceinline__ void operator()(const f32x4 (&acc)[2][2][4][2], const pg8::Unit& u, int wr, int wc, int fr, int fq) const {
#pragma unroll
    for (int bj = 0; bj < 2; ++bj) {
      const int col0 = u.pn * 256 + bj * 128 + wc * 32 + 8 * fq;
#pragma unroll
      for (int ai = 0; ai < 2; ++ai)
#pragma unroll
        for (int m = 0; m < 4; ++m) {
          const int row = u.pm * 256 + ai * 128 + wr * 64 + m * 16 + fr;
          const size_t idx = (size_t)row * DM + col0;
          const f32x4 a0 = ldf_nt(x + idx) + acc[ai][bj][m][0], a1 = ldf_nt(x + idx + 4) + acc[ai][bj][m][1];
          u32x4 w; w.x = pk_bf16(a0[0], a0[1]); w.y = pk_bf16(a0[2], a0[3]); w.z = pk_bf16(a1[0], a1[1]); w.w = pk_bf16(a1[2], a1[3]);
          *(u32x4*)(ybf + idx) = w;
        }
    }
  }
};

constexpr int REC_BYTES = 12672, REC_M1 = 0, REC_R = 1024, REC_BK = 2048, REC_TA = 4096, REC_AR = 4608, REC_VB = 5120;
constexpr int REC_WC_B = 12288, REC_RKB_B = 12544;
constexpr int RPREP_ITEMS = 64 * 256;
constexpr int LS = 68;
__device__ __forceinline__ bf16x8 cvt8(const float* p) {
  const float4 a = *(const float4*)p, b = *(const float4*)(p + 4);
  u32x4 r; r.x = pk_bf16(a.x, a.y); r.y = pk_bf16(a.z, a.w); r.z = pk_bf16(b.x, b.y); r.w = pk_bf16(b.z, b.w);
  return as_frag(r);
}
__device__ __forceinline__ float fast_tanh(float x) { return 1.f - 2.f * __builtin_amdgcn_rcpf(1.f + __expf(2.f * x)); }
__device__ void rwkv_prep_block(const Params& P, int vb, float* sm, const int tid, const int half) {
  const int bh = vb >> 2, b = bh >> 3, h = bh & 7;
  const int lane = tid & 63, tt = tid >> 6, g = lane >> 4, i = lane & 15;
  float* s_r = sm;             float* s_k = sm + 1088;      float* s_at = sm + 2 * 1088;  float* s_bt = sm + 3 * 1088;
  float* s_lw = sm + 4 * 1088; float* s_an = sm + 5 * 1088; float* s_b = sm + 6 * 1088;   float* s_kt = sm + 7 * 1088;
  float* s_rt = sm + 8 * 1088; float* s_Aab = sm + 9 * 1088; float* s_Aak = s_Aab + 272;
  float* s_xw = s_at; float* s_xa = s_bt;
  bf16_t* s_twb = (bf16_t*)(sm + 9 * 1088 + 544);
  bf16_t* s_pab = s_twb + 16 * 72;
  bf16_t* rec = (bf16_t*)(sm + 9 * 1088 + 544 + 1152);
  bf16_t* s_raw = (bf16_t*)s_lw;
  const int c = h * 64 + lane;
  const float mix_r = P.shift_mix[OFF_R + c], mix_k = P.shift_mix[OFF_K + c], mix_v = P.shift_mix[OFF_V + c];
  const float mix_w = P.shift_mix[OFF_WLO + lane], mix_a = P.shift_mix[OFF_ALO + lane];
  const float dbase = P.decay_base[c], ibase = P.iclr_base[c], kns = P.key_norm_scale[c], kim = P.key_iclr_mix[c], bon = P.bonus[c];
  const bf16_t* dup = P.dut + (size_t)(h * 64 + 16 * tt + i) * 64 + 8 * g;
  const bf16_t* iup = P.iut + (size_t)(h * 64 + 16 * tt + i) * 64 + 8 * g;
  const bf16x8 bd0 = *(const bf16x8*)dup, bd1 = *(const bf16x8*)(dup + 32), bi0 = *(const bf16x8*)iup, bi1 = *(const bf16x8*)(iup + 32);
  int prow[3], pcol[3], plds[3];
#pragma unroll
  for (int u = 0; u < 3; ++u) {
    const int idx = tid + 256 * u, rr = idx / 40, q = idx - rr * 40, cg = q >> 3, sub = q & 7;
    prow[u] = (idx < 680) ? rr : -100000;
    pcol[u] = ((cg < 3) ? (cg * 512 + h * 64) : (cg == 3 ? OFF_WLO : OFF_ALO)) + sub * 8;
    plds[u] = rr * 328 + cg * 64 + sub * 8;
  }
  const bf16_t* pb = P.p + (size_t)(b * SEQ) * NIN;
  uint4 pre[3];
#define RP_PREFETCH(chunk) do { _Pragma("unroll") for (int u = 0; u < 3; ++u) { const int t_ = (chunk) * 16 - 1 + prow[u]; \
    pre[u] = (t_ >= 0) ? *(const uint4*)(pb + (size_t)t_ * NIN + pcol[u]) : make_uint4(0u, 0u, 0u, 0u); } } while (0)
  const int cbase = (vb & 3) * 64 + half;
  RP_PREFETCH(cbase);
#pragma unroll
  for (int u = 0; u < 3; ++u) if (prow[u] >= 0) *(uint4*)(s_raw + plds[u]) = pre[u];
  __syncthreads();
  for (int kk2 = 0; kk2 < 32; ++kk2) {
  const int ch = cbase + 2 * kk2;
  const int item = bh * 256 + ch;
  char* recb = P.rec + (size_t)item * REC_BYTES;
  if (kk2 + 1 < 32) RP_PREFETCH(ch + 2);
  {
#pragma unroll
    for (int q = 0; q < 4; ++q) {
      const int tl = tt + 4 * q;
      const bf16_t* row = s_raw + (tl + 1) * 328;
      const bf16_t* prw = s_raw + tl * 328;
      const float cr = bf2f(row[lane]), ck = bf2f(row[64 + lane]), cv = bf2f(row[128 + lane]), cw = bf2f(row[192 + lane]), ca = bf2f(row[256 + lane]);
      const float pr = bf2f(prw[lane]), pk = bf2f(prw[64 + lane]), pv = bf2f(prw[128 + lane]), pw = bf2f(prw[192 + lane]), pa = bf2f(prw[256 + lane]);
      s_r[tl * LS + lane] = cr + (pr - cr) * mix_r;
      s_k[tl * LS + lane] = ck + (pk - ck) * mix_k;
      s_twb[tl * 72 + lane] = f2bf(fast_tanh(cw + (pw - cw) * mix_w));
      s_pab[tl * 72 + lane] = f2bf(ca + (pa - ca) * mix_a);
      const float vv = cv + (pv - cv) * mix_v;
      rec[REC_VB + (lane >> 4) * 256 + (16 * (tl >> 2) + (lane & 15)) * 4 + (tl & 3)] = f2bf(vv);
    }
  }
  __syncthreads();
  {
    const bf16x8 aw0 = *(const bf16x8*)(s_twb + i * 72 + 8 * g), aw1 = *(const bf16x8*)(s_twb + i * 72 + 32 + 8 * g);
    const bf16x8 aa0 = *(const bf16x8*)(s_pab + i * 72 + 8 * g), aa1 = *(const bf16x8*)(s_pab + i * 72 + 32 + 8 * g);
    f32x4 xw = (f32x4){0.f, 0.f, 0.f, 0.f}, xa = (f32x4){0.f, 0.f, 0.f, 0.f};
    xw = __builtin_amdgcn_mfma_f32_16x16x32_bf16(aw0, bd0, xw, 0, 0, 0);
    xw = __builtin_amdgcn_mfma_f32_16x16x32_bf16(aw1, bd1, xw, 0, 0, 0);
    xa = __builtin_amdgcn_mfma_f32_16x16x32_bf16(aa0, bi0, xa, 0, 0, 0);
    xa = __builtin_amdgcn_mfma_f32_16x16x32_bf16(aa1, bi1, xa, 0, 0, 0);
#pragma unroll
    for (int j = 0; j < 4; ++j) {
      s_xw[(4 * g + j) * LS + 16 * tt + i] = xw[j];
      s_xa[(4 * g + j) * LS + 16 * tt + i] = xa[j];
    }
  }
  __syncthreads();
  {
#pragma unroll
    for (int q = 0; q < 4; ++q) {
      const int tl = tt + 4 * q;
      const float z = -(dbase + s_xw[tl * LS + lane]);
      const float sp = fmaxf(z, 0.f) + __logf(1.f + __expf(-fabsf(z)));
      const float lwv = -__expf(-sp - 0.5f);
      const float a = 1.f / (1.f + __expf(-(ibase + s_xa[tl * LS + lane])));
      const float pk = s_k[tl * LS + lane];
      const float kkr = pk * kns;
      const float ss = wave_sum(kkr * kkr);
      const float kk = kkr * rsqrtf(fmaxf(ss, 1e-24f));
      const float kmod = pk * (1.f + (a - 1.f) * kim);
      s_lw[tl * LS + lane] = lwv;
      s_k[tl * LS + lane] = kmod;
      s_an[tl * LS + lane] = -kk;
      s_b[tl * LS + lane] = kk * a;
      const float rk = wave_sum(s_r[tl * LS + lane] * kmod * bon);
      if (lane == 0) ((float*)(recb + REC_RKB_B))[tl] = rk;
    }
  }
  __syncthreads();
  {
    float run = 0.f, LWp[4], LW[4];
#pragma unroll
    for (int s2 = 0; s2 < 16; ++s2) {
      const float x = s_lw[s2 * LS + lane];
      if ((s2 & 3) == tt) { LWp[s2 >> 2] = run; LW[s2 >> 2] = run + x; }
      run += x;
    }
    const float LWC = run;
    if (tt == 0) ((float*)(recb + REC_WC_B))[lane] = __expf(LWC);
#pragma unroll
    for (int q = 0; q < 4; ++q) {
      const int tl = tt + 4 * q;
      const float e_p = __expf(LWp[q]), e_n = __expf(-LW[q]), e_r = __expf(LW[q]), e_c = __expf(LWC - LW[q]);
      const float an = s_an[tl * LS + lane], bb = s_b[tl * LS + lane], kmod = s_k[tl * LS + lane], rr = s_r[tl * LS + lane];
      s_at[tl * LS + lane] = an * e_p;
      s_bt[tl * LS + lane] = bb * e_n;
      s_kt[tl * LS + lane] = kmod * e_n;
      const float rt = rr * e_r;
      s_rt[tl * LS + lane] = rt;
      const int bkaddr = REC_BK + (lane >> 4) * 512 + (16 * (tl >> 2) + (lane & 15)) * 8 + (tl & 3);
      rec[bkaddr] = f2bf(bb * e_c);
      rec[bkaddr + 4] = f2bf(kmod * e_c);
      const int k5 = lane & 31;
      rec[REC_R + (lane >> 5) * 512 + (16 * ((k5 & 15) >> 2) + tl) * 8 + (k5 & 3) + 4 * (k5 >> 4)] = f2bf(rt);
    }
  }
  __syncthreads();
  {
    const float* X = (tt < 2) ? s_at : s_rt;
    const float* Y = (tt & 1) ? s_kt : s_bt;
    const bf16x8 a0 = cvt8(X + i * LS + 8 * g), a1 = cvt8(X + i * LS + 32 + 8 * g);
    const bf16x8 b0 = cvt8(Y + i * LS + 8 * g), b1 = cvt8(Y + i * LS + 32 + 8 * g);
    f32x4 acc = (f32x4){0.f, 0.f, 0.f, 0.f};
    acc = __builtin_amdgcn_mfma_f32_16x16x32_bf16(a0, b0, acc, 0, 0, 0);
    acc = __builtin_amdgcn_mfma_f32_16x16x32_bf16(a1, b1, acc, 0, 0, 0);
#pragma unroll
    for (int j = 0; j < 4; ++j) {
      const int t = 4 * g + j, s2 = i;
      const bool keep = (tt < 2) ? (s2 < t) : (s2 <= t);
      const float val = keep ? acc[j] : 0.f;
      if (tt == 0) s_Aab[t * 17 + s2] = val;
      else if (tt == 1) s_Aak[t * 17 + s2] = val;
      else rec[REC_AR + (16 * (s2 >> 2) + t) * 8 + (s2 & 3) + 4 * (tt & 1)] = f2bf(val);
    }
  }
  __syncthreads();
  if (tid < 80) {
    float X[16];
#pragma unroll
    for (int t = 0; t < 16; ++t) {
      float val = (tid < 64) ? s_at[t * LS + tid] : s_Aak[t * 17 + (tid - 64)];
#pragma unroll
      for (int s2 = 0; s2 < t; ++s2) val += s_Aab[t * 17 + s2] * X[s2];
      X[t] = val;
    }
    if (tid < 64) {
      const int k5 = tid & 31;
      const int base = REC_M1 + (tid >> 5) * 512 + (16 * ((k5 & 15) >> 2)) * 8 + (k5 & 3) + 4 * (k5 >> 4);
#pragma unroll
      for (int t = 0; t < 16; ++t) rec[base + t * 8] = f2bf(X[t]);
    } else {
      const int s2 = tid - 64;
      const int base = REC_TA + (16 * (s2 >> 2)) * 8 + (s2 & 3);
#pragma unroll
      for (int t = 0; t < 16; ++t) { rec[base + t * 8] = f2bf(X[t]); rec[base + t * 8 + 4] = 0; }
    }
  }
  __syncthreads();
  {
    const uint4* srcv = (const uint4*)rec;
    uint4* dstv = (uint4*)recb;
#pragma unroll
    for (int u = 0; u < 3; ++u) dstv[tid + 256 * u] = srcv[tid + 256 * u];
  }
#pragma unroll
  for (int u = 0; u < 3; ++u) if (prow[u] >= 0) *(uint4*)(s_raw + plds[u]) = pre[u];
  __syncthreads();
  }
#undef RP_PREFETCH
}


#define WAVE_FENCE() do { __builtin_amdgcn_wave_barrier(); asm volatile("s_waitcnt lgkmcnt(0)" ::: "memory"); __builtin_amdgcn_wave_barrier(); } while (0)
__device__ void rwkv_prep_waves(const Params& P, int vb, unsigned char* ldsb) {
  const int tid = threadIdx.x, lane = tid & 63, w = tid >> 6, g = lane >> 4, i = lane & 15;
  const int bh = vb >> 2, b = bh >> 3, h = bh & 7;
  bf16_t* s_du = (bf16_t*)ldsb;
  bf16_t* s_iu = s_du + 64 * 72;
  __syncthreads();
  {
    const int row = tid >> 3, pc = tid & 7;
    *(uint4*)(s_du + row * 72 + pc * 8) = *(const uint4*)(P.dut + (size_t)(h * 64 + row) * 64 + pc * 8);
    *(uint4*)(s_iu + row * 72 + pc * 8) = *(const uint4*)(P.iut + (size_t)(h * 64 + row) * 64 + pc * 8);
  }
  int2* ptab = (int2*)(ldsb + 18432 + 8 * 16384);
  for (int e = tid; e < 11 * 64; e += 512) {
    int q = e; const bool ok = q < 680; q = ok ? q : 679;
    const int rr = q / 40, qq = q - rr * 40, cg = qq >> 3, sub = qq & 7;
    const int col = ((cg < 3) ? (cg * 512 + h * 64) : (cg == 3 ? OFF_WLO : OFF_ALO)) + sub * 8;
    ptab[e] = make_int2((rr * 656 + cg * 128 + sub * 16) | (rr << 16) | (ok ? 0 : (int)0x80000000), col);
  }
  __syncthreads();
  unsigned char* wb = ldsb + 18432 + w * 16384;
  bf16_t* s_twb = (bf16_t*)wb;              bf16_t* s_pab = s_twb + 16 * 72;
  float* s_xw = (float*)(wb + 4608);        float* s_xa = s_xw + 16 * 68;
  bf16_t* im_a = (bf16_t*)(wb + 4608);      bf16_t* im_b = im_a + 1152; bf16_t* im_k = im_b + 1152; bf16_t* im_r = im_k + 1152;
  bf16_t* im_m1 = (bf16_t*)wb;              bf16_t* arim = (bf16_t*)(wb + 2304); bf16_t* taim = (bf16_t*)(wb + 3328);
  bf16_t* im_kb = (bf16_t*)wb;
  float* s_Aab = (float*)(wb + 14208);      float* s_Aak = s_Aab + 272;
  const int c = h * 64 + lane;
  const float mix_r = P.shift_mix[OFF_R + c], mix_k = P.shift_mix[OFF_K + c], mix_v = P.shift_mix[OFF_V + c];
  const float mix_w = P.shift_mix[OFF_WLO + lane], mix_a = P.shift_mix[OFF_ALO + lane];
  const float dbase = P.decay_base[c], ibase = P.iclr_base[c], kns = P.key_norm_scale[c], kim = P.key_iclr_mix[c], bon = P.bonus[c];
  const bf16_t* pb = P.p + (size_t)(b * SEQ) * NIN;
  bf16_t* rawb = (bf16_t*)(wb + 4608);
  u32x4 pre[11];
#define RAWP_LOAD(chn) do { _Pragma("unroll") for (int u = 0; u < 11; ++u) { const int2 e_ = ptab[u * 64 + lane]; \
    int t_ = (chn) * 16 - 1 + ((e_.x >> 16) & 0x7fff); t_ = (t_ < 0) ? 0 : t_; \
    pre[u] = ld_nt(pb + (size_t)t_ * NIN + e_.y); } } while (0)
  RAWP_LOAD((vb & 3) * 64 + w);
  for (int k8 = 0; k8 < 8; ++k8) {
    const int ch = (vb & 3) * 64 + w + 8 * k8;
    const int t0 = ch * 16;
    char* recb = P.rec + (size_t)(bh * 256 + ch) * REC_BYTES;
    float r[16], an[16], bb[16], km[16], LW[16];
#pragma unroll
    for (int u = 0; u < 11; ++u) {
      const int ex = ptab[u * 64 + lane].x;
      u32x4 val = pre[u];
      if (t0 == 0 && (ex & 0x7fff0000) == 0) val = (u32x4){0u, 0u, 0u, 0u};
      if (ex >= 0) *(u32x4*)((unsigned char*)rawb + (ex & 0xffff)) = val;
    }
    WAVE_FENCE();
    {
      float pr = bf2f(rawb[lane]), pk = bf2f(rawb[64 + lane]), pv = bf2f(rawb[128 + lane]), pw = bf2f(rawb[192 + lane]), pa = bf2f(rawb[256 + lane]);
      float vv[16];
#pragma unroll
      for (int t = 0; t < 16; ++t) {
        const bf16_t* row = rawb + (t + 1) * 328;
        const float cr = bf2f(row[lane]), ck = bf2f(row[64 + lane]), cv = bf2f(row[128 + lane]), cw = bf2f(row[192 + lane]), ca = bf2f(row[256 + lane]);
        r[t] = cr + (pr - cr) * mix_r;
        km[t] = ck + (pk - ck) * mix_k;
        vv[t] = cv + (pv - cv) * mix_v;
        s_twb[t * 72 + lane] = f2bf(fast_tanh(cw + (pw - cw) * mix_w));
        s_pab[t * 72 + lane] = f2bf(ca + (pa - ca) * mix_a);
        pr = cr; pk = ck; pv = cv; pw = cw; pa = ca;
      }
#pragma unroll
      for (int g2 = 0; g2 < 4; ++g2) {
        typedef unsigned u32x2_t __attribute__((ext_vector_type(2)));
        u32x2_t o; o.x = pk_bf16(vv[4 * g2], vv[4 * g2 + 1]); o.y = pk_bf16(vv[4 * g2 + 2], vv[4 * g2 + 3]);
        *(u32x2_t*)(recb + 10240 + (lane >> 4) * 512 + (16 * g2 + (lane & 15)) * 8) = o;
      }
    }
    WAVE_FENCE();
    {
      const bf16x8 aw0 = *(const bf16x8*)(s_twb + i * 72 + 8 * g), aw1 = *(const bf16x8*)(s_twb + i * 72 + 32 + 8 * g);
      const bf16x8 aa0 = *(const bf16x8*)(s_pab + i * 72 + 8 * g), aa1 = *(const bf16x8*)(s_pab + i * 72 + 32 + 8 * g);
#pragma unroll
      for (int nt = 0; nt < 4; ++nt) {
        const bf16x8 bd0 = *(const bf16x8*)(s_du + (16 * nt + i) * 72 + 8 * g), bd1 = *(const bf16x8*)(s_du + (16 * nt + i) * 72 + 32 + 8 * g);
        const bf16x8 bi0 = *(const bf16x8*)(s_iu + (16 * nt + i) * 72 + 8 * g), bi1 = *(const bf16x8*)(s_iu + (16 * nt + i) * 72 + 32 + 8 * g);
        f32x4 xw = (f32x4){0.f, 0.f, 0.f, 0.f}, xa = (f32x4){0.f, 0.f, 0.f, 0.f};
        xw = __builtin_amdgcn_mfma_f32_16x16x32_bf16(aw0, bd0, xw, 0, 0, 0);
        xw = __builtin_amdgcn_mfma_f32_16x16x32_bf16(aw1, bd1, xw, 0, 0, 0);
        xa = __builtin_amdgcn_mfma_f32_16x16x32_bf16(aa0, bi0, xa, 0, 0, 0);
        xa = __builtin_amdgcn_mfma_f32_16x16x32_bf16(aa1, bi1, xa, 0, 0, 0);
#pragma unroll
        for (int j = 0; j < 4; ++j) {
          s_xw[(4 * g + j) * 68 + 16 * nt + i] = xw[j];
          s_xa[(4 * g + j) * 68 + 16 * nt + i] = xa[j];
        }
      }
    }
    WAVE_FENCE();
    {
      float run = 0.f;
#pragma unroll
      for (int t = 0; t < 16; ++t) {
        const float lwv = -0.6065306597126334f * __builtin_amdgcn_rcpf(1.f + __expf(-(dbase + s_xw[t * 68 + lane])));
        const float a = __builtin_amdgcn_rcpf(1.f + __expf(-(ibase + s_xa[t * 68 + lane])));
        const float pk = km[t];
        const float kkr = pk * kns;
        const float ss = wave_sum(kkr * kkr);
        const float kk = kkr * rsqrtf(fmaxf(ss, 1e-24f));
        const float kmod = pk * (1.f + (a - 1.f) * kim);
        km[t] = kmod; an[t] = -kk; bb[t] = kk * a;
        run += lwv; LW[t] = run;
        if ((t & 7) == 7) __builtin_amdgcn_sched_barrier(0);
      }
    }
    WAVE_FENCE();
    {
      const float LWC = LW[15];
      const float ewc = __expf(LWC);
      float e_prev = 1.f;
      ((float*)(recb + REC_WC_B))[lane] = ewc;
#pragma unroll
      for (int g2 = 0; g2 < 4; ++g2) {
        float Bp[4], Kp[4];
#pragma unroll
        for (int j = 0; j < 4; ++j) {
          const int t = 4 * g2 + j;
          const float e_p = e_prev, e_n = __expf(-LW[t]), e_r = __builtin_amdgcn_rcpf(e_n), e_c = ewc * e_n;
          e_prev = e_r;
          const float at = an[t] * e_p;
          an[t] = at;
          im_a[t * 72 + lane] = f2bf(at);
          im_b[t * 72 + lane] = f2bf(bb[t] * e_n);
          im_k[t * 72 + lane] = f2bf(km[t] * e_n);
          im_kb[t * 72 + lane] = f2bf(km[t] * e_n * bon);
          im_r[t * 72 + lane] = f2bf(r[t] * e_r);
          Bp[j] = bb[t] * e_c; Kp[j] = km[t] * e_c;
        }
        u32x4 o; o.x = pk_bf16(Bp[0], Bp[1]); o.y = pk_bf16(Bp[2], Bp[3]); o.z = pk_bf16(Kp[0], Kp[1]); o.w = pk_bf16(Kp[2], Kp[3]);
        *(u32x4*)(recb + 4096 + (lane >> 4) * 1024 + (16 * g2 + (lane & 15)) * 16) = o;
      }
    }
    WAVE_FENCE();
    { const int chn = (k8 < 7) ? ch + 8 : ch; RAWP_LOAD(chn); }
    float abm0, abm1, abm2, abm3;
    {
      const bf16x8 fa0 = *(const bf16x8*)(im_a + i * 72 + 8 * g), fa1 = *(const bf16x8*)(im_a + i * 72 + 32 + 8 * g);
      const bf16x8 fr0 = *(const bf16x8*)(im_r + i * 72 + 8 * g), fr1 = *(const bf16x8*)(im_r + i * 72 + 32 + 8 * g);
      const bf16x8 fb0 = *(const bf16x8*)(im_b + i * 72 + 8 * g), fb1 = *(const bf16x8*)(im_b + i * 72 + 32 + 8 * g);
      const bf16x8 fk0 = *(const bf16x8*)(im_k + i * 72 + 8 * g), fk1 = *(const bf16x8*)(im_k + i * 72 + 32 + 8 * g);
      const f32x4 z4 = (f32x4){0.f, 0.f, 0.f, 0.f};
      f32x4 ab = __builtin_amdgcn_mfma_f32_16x16x32_bf16(fa0, fb0, z4, 0, 0, 0); ab = __builtin_amdgcn_mfma_f32_16x16x32_bf16(fa1, fb1, ab, 0, 0, 0);
      f32x4 ak = __builtin_amdgcn_mfma_f32_16x16x32_bf16(fa0, fk0, z4, 0, 0, 0); ak = __builtin_amdgcn_mfma_f32_16x16x32_bf16(fa1, fk1, ak, 0, 0, 0);
      f32x4 rb = __builtin_amdgcn_mfma_f32_16x16x32_bf16(fr0, fb0, z4, 0, 0, 0); rb = __builtin_amdgcn_mfma_f32_16x16x32_bf16(fr1, fb1, rb, 0, 0, 0);
      f32x4 rk = __builtin_amdgcn_mfma_f32_16x16x32_bf16(fr0, fk0, z4, 0, 0, 0); rk = __builtin_amdgcn_mfma_f32_16x16x32_bf16(fr1, fk1, rk, 0, 0, 0);
      const bf16x8 fq0 = *(const bf16x8*)(im_kb + i * 72 + 8 * g), fq1 = *(const bf16x8*)(im_kb + i * 72 + 32 + 8 * g);
      f32x4 rq = __builtin_amdgcn_mfma_f32_16x16x32_bf16(fr0, fq0, z4, 0, 0, 0); rq = __builtin_amdgcn_mfma_f32_16x16x32_bf16(fr1, fq1, rq, 0, 0, 0);
      if ((i >> 2) == g) {
        const int jd = i & 3;
        const float dv = (jd == 0) ? rq[0] : (jd == 1) ? rq[1] : (jd == 2) ? rq[2] : rq[3];
        ((float*)(recb + REC_RKB_B))[i] = dv;
      }
      abm0 = (i < 4 * g + 0) ? ab[0] : 0.f; abm1 = (i < 4 * g + 1) ? ab[1] : 0.f;
      abm2 = (i < 4 * g + 2) ? ab[2] : 0.f; abm3 = (i < 4 * g + 3) ? ab[3] : 0.f;
#pragma unroll
      for (int j = 0; j < 4; ++j) {
        const int t = 4 * g + j, s2 = i;
        s_Aak[t * 17 + s2] = (s2 < t) ? ak[j] : 0.f;
        const int ara = (16 * (s2 >> 2) + t) * 8 + (s2 & 3);
        arim[ara] = f2bf((s2 <= t) ? rb[j] : 0.f);
        arim[ara + 4] = f2bf((s2 <= t) ? rk[j] : 0.f);
      }
    }
    WAVE_FENCE();
    {
      float X[16], Y[16];
      const int sc = lane & 15;
#pragma unroll
      for (int t = 0; t < 16; ++t) {
        float v1 = an[t], v2 = s_Aak[t * 17 + sc];
        const float arow = ((t & 3) == 0) ? abm0 : ((t & 3) == 1) ? abm1 : ((t & 3) == 2) ? abm2 : abm3;
#pragma unroll
        for (int s2 = 0; s2 < t; ++s2) {
          const float cf = __builtin_bit_cast(float, __builtin_amdgcn_readlane(__builtin_bit_cast(int, arow), 16 * (t >> 2) + s2));
          v1 += cf * X[s2]; v2 += cf * Y[s2];
        }
        X[t] = v1; Y[t] = v2;
        im_m1[t * 72 + lane] = f2bf(v1);
        if (lane < 16) { const int ta = (16 * (sc >> 2) + t) * 8 + (sc & 3); taim[ta] = f2bf(v2); taim[ta + 4] = 0; }
        __builtin_amdgcn_sched_barrier(0);
      }
    }
    WAVE_FENCE();
    {
      typedef unsigned u32x2_t __attribute__((ext_vector_type(2)));
#pragma unroll
      for (int ks = 0; ks < 2; ++ks) {
        const u32x2_t ml = *(const u32x2_t*)(im_m1 + i * 72 + 32 * ks + 4 * g), mh = *(const u32x2_t*)(im_m1 + i * 72 + 32 * ks + 16 + 4 * g);
        const u32x2_t rl = *(const u32x2_t*)(im_r + i * 72 + 32 * ks + 4 * g), rh = *(const u32x2_t*)(im_r + i * 72 + 32 * ks + 16 + 4 * g);
        u32x4 mo; mo.x = ml.x; mo.y = ml.y; mo.z = mh.x; mo.w = mh.y;
        u32x4 ro; ro.x = rl.x; ro.y = rl.y; ro.z = rh.x; ro.w = rh.y;
        *(u32x4*)(recb + ks * 1024 + lane * 16) = mo;
        *(u32x4*)(recb + 2048 + ks * 1024 + lane * 16) = ro;
      }
      *(u32x4*)(recb + 8192 + lane * 16) = *(const u32x4*)(taim + lane * 8);
      *(u32x4*)(recb + 9216 + lane * 16) = *(const u32x4*)(arim + lane * 8);
    }
    WAVE_FENCE();
  }
#undef RAWP_LOAD
}

constexpr int SCAN_SLOT = 13312, SCAN_D = 10;
__device__ void rwkv_scan_block(const Params& P, int bh, LAS unsigned char* lds) {
  const int tid = threadIdx.x, wave = __builtin_amdgcn_readfirstlane(tid >> 6), lane = tid & 63;
  const char* rec0 = P.rec + (size_t)(bh * 256) * REC_BYTES;
  if (wave >= 2) {
    const int lw = wave - 2;
    const char* src0 = rec0 + lw * 2048 + lane * 16;
#define SCAN_ISSUE(chsrc, slot) do { const char* src_ = src0 + (size_t)(chsrc) * REC_BYTES; LAS unsigned char* dst_ = lds + (slot) * SCAN_SLOT + lw * 2048; \
    _Pragma("unroll") for (int u_ = 0; u_ < 2; ++u_) __builtin_amdgcn_global_load_lds((const unsigned*)(src_ + u_ * 1024), (LAS unsigned*)(dst_ + u_ * 1024), 16, 0, 2); \
    if (lw == 0) __builtin_amdgcn_global_load_lds((const unsigned*)(src_ + 12288), (LAS unsigned*)(dst_ + 12288), 16, 0, 2); } while (0)
#define SCAN_WAITBAR() do { if (lw == 0) asm volatile("s_waitcnt vmcnt(21)\n\ts_barrier" ::: "memory"); else asm volatile("s_waitcnt vmcnt(14)\n\ts_barrier" ::: "memory"); } while (0)
#pragma unroll
    for (int c0 = 0; c0 < SCAN_D - 1; ++c0) SCAN_ISSUE(c0, c0);
    SCAN_WAITBAR();
    int slot = SCAN_D - 1;
    for (int ch = 0; ch < 256; ++ch) {
      const int nx = ch + SCAN_D - 1;
      SCAN_ISSUE((nx < 256 ? nx : 255), slot);
      slot = (slot == SCAN_D - 1) ? 0 : slot + 1;
      SCAN_WAITBAR();
    }
    asm volatile("s_waitcnt vmcnt(0)" ::: "memory");
#undef SCAN_ISSUE
#undef SCAN_WAITBAR
  } else {
    const int b = bh >> 3, h = bh & 7, cw = wave, g = lane >> 4, i = lane & 15;
    f32x4 sa[4], sbt[4];
#pragma unroll
    for (int kt = 0; kt < 4; ++kt) { sa[kt] = (f32x4){0.f, 0.f, 0.f, 0.f}; sbt[kt] = (f32x4){0.f, 0.f, 0.f, 0.f}; }
    const f32x4 zero4 = (f32x4){0.f, 0.f, 0.f, 0.f};
    typedef unsigned u32x2_t __attribute__((ext_vector_type(2)));
    struct Fr { u32x4 m1f0, m1f1, rf0, rf1, bk0, bk1, bk2, bk3, taf, arf; u32x2_t va, vb2; f32x4 wc0, wc1, wc2, wc3; };
#define SCAN_FR(F, slotv) do { const LAS unsigned char* sl_ = lds + (slotv) * SCAN_SLOT; const LAS u32x4* fr_ = (const LAS u32x4*)sl_; \
      F.m1f0 = fr_[lane]; F.m1f1 = fr_[64 + lane]; F.rf0 = fr_[128 + lane]; F.rf1 = fr_[192 + lane]; \
      F.bk0 = fr_[256 + lane]; F.bk1 = fr_[320 + lane]; F.bk2 = fr_[384 + lane]; F.bk3 = fr_[448 + lane]; F.taf = fr_[512 + lane]; F.arf = fr_[576 + lane]; \
      F.va = *(const LAS u32x2_t*)(sl_ + 10240 + (2 * cw) * 512 + lane * 8); F.vb2 = *(const LAS u32x2_t*)(sl_ + 10240 + (2 * cw + 1) * 512 + lane * 8); \
      const LAS f32x4* wc_ = (const LAS f32x4*)(sl_ + REC_WC_B); F.wc0 = wc_[g]; F.wc1 = wc_[4 + g]; F.wc2 = wc_[8 + g]; F.wc3 = wc_[12 + g]; } while (0)
#define SCAN_TILE(F, S, VBL, vtv, chv) do { \
      u32x4 sb0, sb1; \
      sb0.x = pk_bf16(S[0][0], S[0][1]); sb0.y = pk_bf16(S[0][2], S[0][3]); sb0.z = pk_bf16(S[1][0], S[1][1]); sb0.w = pk_bf16(S[1][2], S[1][3]); \
      sb1.x = pk_bf16(S[2][0], S[2][1]); sb1.y = pk_bf16(S[2][2], S[2][3]); sb1.z = pk_bf16(S[3][0], S[3][1]); sb1.w = pk_bf16(S[3][2], S[3][3]); \
      u32x4 vbz; vbz.x = VBL.x; vbz.y = VBL.y; vbz.z = 0u; vbz.w = 0u; \
      f32x4 u = __builtin_amdgcn_mfma_f32_16x16x32_bf16(as_frag(F.taf), as_frag(vbz), zero4, 0, 0, 0); \
      u = __builtin_amdgcn_mfma_f32_16x16x32_bf16(as_frag(F.m1f0), as_frag(sb0), u, 0, 0, 0); \
      u = __builtin_amdgcn_mfma_f32_16x16x32_bf16(as_frag(F.m1f1), as_frag(sb1), u, 0, 0, 0); \
      u32x4 uvb; uvb.x = pk_bf16(u[0], u[1]); uvb.y = pk_bf16(u[2], u[3]); uvb.z = VBL.x; uvb.w = VBL.y; \
      f32x4 y = __builtin_amdgcn_mfma_f32_16x16x32_bf16(as_frag(F.rf0), as_frag(sb0), zero4, 0, 0, 0); \
      y = __builtin_amdgcn_mfma_f32_16x16x32_bf16(as_frag(F.rf1), as_frag(sb1), y, 0, 0, 0); \
      y = __builtin_amdgcn_mfma_f32_16x16x32_bf16(as_frag(F.arf), as_frag(uvb), y, 0, 0, 0); \
      S[0] = __builtin_amdgcn_mfma_f32_16x16x32_bf16(as_frag(F.bk0), as_frag(uvb), S[0] * F.wc0, 0, 0, 0); \
      S[1] = __builtin_amdgcn_mfma_f32_16x16x32_bf16(as_frag(F.bk1), as_frag(uvb), S[1] * F.wc1, 0, 0, 0); \
      S[2] = __builtin_amdgcn_mfma_f32_16x16x32_bf16(as_frag(F.bk2), as_frag(uvb), S[2] * F.wc2, 0, 0, 0); \
      S[3] = __builtin_amdgcn_mfma_f32_16x16x32_bf16(as_frag(F.bk3), as_frag(uvb), S[3] * F.wc3, 0, 0, 0); \
      _Pragma("unroll") for (int j = 0; j < 4; ++j) (ystage + ((chv) & 1) * 512)[(4 * g + j) * 32 + 16 * ((vtv) & 1) + i] = f2bf(y[j]); } while (0)
#define SCAN_YOUT(chprev) do { const u32x4 yv_ = *(const LAS u32x4*)(ystage + ((chprev) & 1) * 512 + (lane >> 2) * 32 + (lane & 3) * 8); \
      *(u32x4*)(P.yraw + (size_t)(b * SEQ + (chprev) * 16 + (lane >> 2)) * 512 + h * 64 + 32 * cw + (lane & 3) * 8) = yv_; } while (0)
#define SCAN_STEP(F, chv) do { if ((chv) > 0) SCAN_YOUT((chv) - 1); SCAN_TILE(F, sa, F.va, 2 * cw, chv); SCAN_TILE(F, sbt, F.vb2, 2 * cw + 1, chv); } while (0)
    LAS bf16_t* ystage = (LAS bf16_t*)(lds + SCAN_D * SCAN_SLOT + cw * 2048);
    Fr FA, FB;
    asm volatile("s_barrier" ::: "memory");
    SCAN_FR(FA, 0);
    int slot = 1;
    for (int ch = 0; ch < 256; ch += 2) {
      SCAN_FR(FB, slot); slot = (slot == SCAN_D - 1) ? 0 : slot + 1;
      SCAN_STEP(FA, ch);
      asm volatile("s_waitcnt lgkmcnt(0)\n\ts_barrier" ::: "memory");
      SCAN_FR(FA, slot); slot = (slot == SCAN_D - 1) ? 0 : slot + 1;
      SCAN_STEP(FB, ch + 1);
      asm volatile("s_waitcnt lgkmcnt(0)\n\ts_barrier" ::: "memory");
    }
    SCAN_YOUT(255);
#undef SCAN_YOUT
#undef SCAN_FR
#undef SCAN_TILE
#undef SCAN_STEP
  }
  __syncthreads();
}

#ifndef ATT_TR
#define ATT_TR 1
#endif
constexpr int ATT_ITEMS = 64 * 3 * 32;
constexpr int KV_LD = 72;
typedef short v4i16_t __attribute__((ext_vector_type(4)));
__device__ __forceinline__ bf16x8 vfrag(const bf16_t* sV, int row0, int row1, int g, int i, int mt) {
  bf16x8 a;
#if ATT_TR
  typedef __attribute__((address_space(3))) v4i16_t* ldsp;
  const v4i16_t lo = __builtin_amdgcn_ds_read_tr16_b64_v4i16((ldsp)(sV + (row0 + 4 * g + (i >> 2)) * KV_LD + 16 * mt + 4 * (i & 3)));
  const v4i16_t hi = __builtin_amdgcn_ds_read_tr16_b64_v4i16((ldsp)(sV + (row1 + 4 * g + (i >> 2)) * KV_LD + 16 * mt + 4 * (i & 3)));
#pragma unroll
  for (int j = 0; j < 4; ++j) { a[j] = lo[j]; a[4 + j] = hi[j]; }
#else
#pragma unroll
  for (int j = 0; j < 4; ++j) {
    a[j] = (short)sV[(row0 + 4 * g + j) * KV_LD + 16 * mt + i];
    a[4 + j] = (short)sV[(row1 + 4 * g + j) * KV_LD + 16 * mt + i];
  }
#endif
  return a;
}
constexpr int ATT_ROWS = 256;
struct AttnRegs { u32x4 k0, k1, k2, k3, k4, k5, k6, k7, v0, v1, v2, v3, v4, v5, v6, v7; bf16x8 qa0, qa1, qb0, qb1; };
__device__ __forceinline__ void attn_load(const Params& P, int item, const int tid, AttnRegs& R) {
  const int lane = tid & 63, w = tid >> 6, g = lane >> 4, i = lane & 15;
  const int bh = item / 96, rem = item % 96, pat = rem >> 5, idx = rem & 31;
  const int b = bh >> 3, h = bh & 7;
  const int sh = 2 * pat, dil = 1 << sh;
  const int rho = idx & (dil - 1), qt = idx >> sh;
  const bf16_t* pb = P.p + (size_t)(b * SEQ) * NIN;
#define ATT_LD(u, KK, VV) do { const int c_ = tid + 256 * (u), row_ = c_ >> 3, cc_ = c_ & 7; int ik_ = 128 * qt - 128 + row_; if (ik_ < 0) ik_ = 0; \
    const bf16_t* src_ = pb + (size_t)(rho + (ik_ << sh)) * NIN + h * 64 + cc_ * 8; KK = *(const u32x4*)(src_ + OFF_KB); VV = *(const u32x4*)(src_ + OFF_VB); } while (0)
  ATT_LD(0, R.k0, R.v0); ATT_LD(1, R.k1, R.v1); ATT_LD(2, R.k2, R.v2); ATT_LD(3, R.k3, R.v3);
  ATT_LD(4, R.k4, R.v4); ATT_LD(5, R.k5, R.v5); ATT_LD(6, R.k6, R.v6); ATT_LD(7, R.k7, R.v7);
#undef ATT_LD
  const int qposa = rho + ((128 * qt + 32 * w + i) << sh);
  const bf16_t* qsrc = pb + (size_t)qposa * NIN + OFF_Q + h * 64 + 8 * g;
  R.qa0 = *(const bf16x8*)(qsrc); R.qa1 = *(const bf16x8*)(qsrc + 32);
  const bf16_t* qsrb = qsrc + (size_t)(16 << sh) * NIN;
  R.qb0 = *(const bf16x8*)(qsrb); R.qb1 = *(const bf16x8*)(qsrb + 32);
}
__device__ __forceinline__ void attn_stage(float* sm, const int tid, const AttnRegs& R) {
  bf16_t* sK = (bf16_t*)sm;
  bf16_t* sV = sK + ATT_ROWS * KV_LD;
#define ATT_ST(u, KK, VV) do { const int c_ = tid + 256 * (u), row_ = c_ >> 3, cc_ = c_ & 7; *(u32x4*)(sK + row_ * KV_LD + cc_ * 8) = KK; *(u32x4*)(sV + row_ * KV_LD + cc_ * 8) = VV; } while (0)
  ATT_ST(0, R.k0, R.v0); ATT_ST(1, R.k1, R.v1); ATT_ST(2, R.k2, R.v2); ATT_ST(3, R.k3, R.v3);
  ATT_ST(4, R.k4, R.v4); ATT_ST(5, R.k5, R.v5); ATT_ST(6, R.k6, R.v6); ATT_ST(7, R.k7, R.v7);
#undef ATT_ST
}
__device__ __forceinline__ void attn_compute(const Params& P, int item, float* sm, const int tid, const int weff, const bf16x8 qf0, const bf16x8 qf1) {
  bf16_t* sK = (bf16_t*)sm;
  bf16_t* sV = sK + ATT_ROWS * KV_LD;
  const int lane = tid & 63, g = lane >> 4, i = lane & 15;
  const int bh = item / 96, rem = item % 96, pat = rem >> 5, idx = rem & 31;
  const int b = bh >> 3, h = bh & 7;
  const int sh = 2 * pat, dil = 1 << sh;
  const int rho = idx & (dil - 1), qt = idx >> sh;
  const int qpos = rho + ((128 * qt + 16 * weff + i) << sh);
  f32x4 st[9];
#pragma unroll
  for (int kt = 0; kt < 9; ++kt) {
    const bf16_t* kr = sK + (16 * (weff + kt) + i) * KV_LD + 8 * g;
    f32x4 acc = (f32x4){0.f, 0.f, 0.f, 0.f};
    acc = __builtin_amdgcn_mfma_f32_16x16x32_bf16(*(const bf16x8*)(kr), qf0, acc, 0, 0, 0);
    acc = __builtin_amdgcn_mfma_f32_16x16x32_bf16(*(const bf16x8*)(kr + 32), qf1, acc, 0, 0, 0);
    st[kt] = acc;
  }
  float mx = -INFINITY;
#pragma unroll
  for (int j = 0; j < 4; ++j) {
    if (4 * g + j < i) st[0][j] = -INFINITY;
    if (4 * g + j > i) st[8][j] = -INFINITY;
  }
  if (qt == 0) {
#pragma unroll
    for (int kt = 0; kt < 9; ++kt)
#pragma unroll
      for (int j = 0; j < 4; ++j) if (16 * (weff + kt) + 4 * g + j < 128) st[kt][j] = -INFINITY;
  }
#pragma unroll
  for (int kt = 0; kt < 9; ++kt)
#pragma unroll
    for (int j = 0; j < 4; ++j) mx = fmaxf(mx, st[kt][j]);
  mx = fmaxf(mx, __shfl_xor(mx, 16));
  mx = fmaxf(mx, __shfl_xor(mx, 32));
  constexpr float C2 = 0.125f * 1.4426950408889634f;
  const float nm2 = -mx * C2;
  float l = 0.f;
#pragma unroll
  for (int kt = 0; kt < 9; ++kt)
#pragma unroll
    for (int j = 0; j < 4; ++j) {
      const float pe = __builtin_amdgcn_exp2f(__builtin_fmaf(st[kt][j], C2, nm2));
      st[kt][j] = pe;
      l += pe;
    }
  l += __shfl_xor(l, 16);
  l += __shfl_xor(l, 32);
  f32x4 o[4];
#pragma unroll
  for (int mt = 0; mt < 4; ++mt) o[mt] = (f32x4){0.f, 0.f, 0.f, 0.f};
#pragma unroll
  for (int s2 = 0; s2 < 5; ++s2) {
    const int t0 = 2 * s2, t1 = (2 * s2 + 1 < 9) ? (2 * s2 + 1) : t0;
    u32x4 pw;
    pw.x = pk_bf16(st[t0][0], st[t0][1]); pw.y = pk_bf16(st[t0][2], st[t0][3]);
    pw.z = (2 * s2 + 1 < 9) ? pk_bf16(st[t1][0], st[t1][1]) : 0u; pw.w = (2 * s2 + 1 < 9) ? pk_bf16(st[t1][2], st[t1][3]) : 0u;
    const bf16x8 pbv = as_frag(pw);
#pragma unroll
    for (int mt = 0; mt < 4; ++mt) {
      const bf16x8 a = vfrag(sV, 16 * (weff + t0), 16 * (weff + t1), g, i, mt);
      o[mt] = __builtin_amdgcn_mfma_f32_16x16x32_bf16(a, pbv, o[mt], 0, 0, 0);
    }
  }
  const float rl = 1.f / l;
  const size_t bt = (size_t)(b * SEQ + qpos);
  bf16_t* od = P.p + bt * NIN + pat * 512 + h * 64 + 4 * g;
#pragma unroll
  for (int mt = 0; mt < 4; ++mt) {
    typedef unsigned u32x2_t __attribute__((ext_vector_type(2)));
    u32x2_t ov; ov.x = pk_bf16(o[mt][0] * rl, o[mt][1] * rl); ov.y = pk_bf16(o[mt][2] * rl, o[mt][3] * rl);
    *(u32x2_t*)(od + 16 * mt) = ov;
  }
  if (g == 0) ((float*)(P.p + bt * NIN + 1536))[pat * 8 + h] = mx * 0.125f + __logf(l);
}

constexpr int MERGE_ITEMS = MTOK * 8 * 8 / 512;
__device__ __forceinline__ void merge_one(const Params& P, const int gid, const bool scratch) {
  const int dg = gid & 7, h = (gid >> 3) & 7, bt = gid >> 6;
  bf16_t* prow = P.p + (size_t)bt * NIN;
  {
    const float* lse = (const float*)(prow + 1536);
    const float l0 = lse[h], l1 = lse[8 + h], l2 = lse[16 + h];
    const float m = fmaxf(l0, fmaxf(l1, l2));
    float w0 = __expf(l0 - m), w1 = __expf(l1 - m), w2 = __expf(l2 - m);
    const float rs = 1.f / (w0 + w1 + w2);
    w0 *= rs; w1 *= rs; w2 *= rs;
    const int off = h * 64 + dg * 8;
    const u32x4 a0 = ld_nt(prow + off), a1 = ld_nt(prow + 512 + off), a2 = ld_nt(prow + 1024 + off);
    const u32x4 zz = ld_nt(prow + OFF_ZB + off);
    const unsigned av0[4] = {a0.x, a0.y, a0.z, a0.w}, av1[4] = {a1.x, a1.y, a1.z, a1.w}, av2[4] = {a2.x, a2.y, a2.z, a2.w}, zv[4] = {zz.x, zz.y, zz.z, zz.w};
    unsigned ov[4];
#pragma unroll
    for (int u = 0; u < 4; ++u) {
      const float lo = w0 * __uint_as_float(av0[u] << 16) + w1 * __uint_as_float(av1[u] << 16) + w2 * __uint_as_float(av2[u] << 16);
      const float hi = w0 * __uint_as_float(av0[u] & 0xffff0000u) + w1 * __uint_as_float(av1[u] & 0xffff0000u) + w2 * __uint_as_float(av2[u] & 0xffff0000u);
      const float zl = __uint_as_float(zv[u] << 16), zh = __uint_as_float(zv[u] & 0xffff0000u);
      ov[u] = (unsigned)f2bf(lo * silu(zl)) | ((unsigned)f2bf(hi * silu(zh)) << 16);
    }
    *(uint4*)((scratch ? (bf16_t*)P.out + (size_t)bt * DM + 512 : prow + OFF_ZB) + off) = make_uint4(ov[0], ov[1], ov[2], ov[3]);
  }
  {
    const int cb = h * 64 + dg * 8;
    const u32x4 yy = ld_nt(P.yraw + (size_t)bt * 512 + cb);
    const u32x4 zz = ld_nt(prow + OFF_ZA + cb);
    const unsigned yv[4] = {yy.x, yy.y, yy.z, yy.w}, zv[4] = {zz.x, zz.y, zz.z, zz.w};
    float y[8];
#pragma unroll
    for (int u = 0; u < 4; ++u) { y[2 * u] = __uint_as_float(yv[u] << 16); y[2 * u + 1] = __uint_as_float(yv[u] & 0xffff0000u); }
    float sm1 = 0.f;
#pragma unroll
    for (int u = 0; u < 8; ++u) sm1 += y[u];
    sm1 += __shfl_xor(sm1, 1); sm1 += __shfl_xor(sm1, 2); sm1 += __shfl_xor(sm1, 4);
    const float mu = sm1 * (1.f / 64.f);
    float sq = 0.f;
#pragma unroll
    for (int u = 0; u < 8; ++u) { const float d = y[u] - mu; sq += d * d; }
    sq += __shfl_xor(sq, 1); sq += __shfl_xor(sq, 2); sq += __shfl_xor(sq, 4);
    const float rstd = rsqrtf(sq * (1.f / 64.f) + 64e-5f);
    const int b = bt >> 12, t = bt & (SEQ - 1), tl = t & 15;
    const char* recb = P.rec + (size_t)((b * 8 + h) * 256 + (t >> 4)) * REC_BYTES;
    const float rkb = ((const float*)(recb + REC_RKB_B))[tl];
    const bf16_t* vbp = (const bf16_t*)recb + REC_VB;
    float o[8];
#pragma unroll
    for (int u = 0; u < 8; ++u) {
      const int v = dg * 8 + u;
      const float vv = bf2f(vbp[(v >> 4) * 256 + (16 * (tl >> 2) + (v & 15)) * 4 + (tl & 3)]);
      const float yn = (y[u] - mu) * rstd * P.gn_gain[cb + u] + P.gn_bias[cb + u];
      const float z = (u & 1) ? __uint_as_float(zv[u >> 1] & 0xffff0000u) : __uint_as_float(zv[u >> 1] << 16);
      o[u] = (yn + rkb * vv) * silu(z);
    }
    *(uint4*)((scratch ? (bf16_t*)P.out + (size_t)bt * DM : prow + OFF_ZA) + cb) = make_uint4(pk_bf16(o[0], o[1]), pk_bf16(o[2], o[3]), pk_bf16(o[4], o[5]), pk_bf16(o[6], o[7]));
  }
}

__device__ void merge_item(const Params& P, int item, const bool scratch) {
  const int gid = item * 512 + threadIdx.x;
  merge_one(P, gid, scratch);
  merge_one(P, gid + (MERGE_ITEMS / 2) * 512, scratch);
}

__device__ void final_norm_item(const Params& P, int it, const bool scratch) {
  const int lane = threadIdx.x & 63, wv = threadIdx.x >> 6;
  const int row = it * 16 + wv * 2;
  const bf16_t* yb = (const bf16_t*)P.rec + (size_t)row * DM;
  u32x4 raw[4];
#pragma unroll
  for (int i = 0; i < 4; ++i) raw[i] = ld_nt(yb + (i >> 1) * DM + (i & 1) * 512 + lane * 8);
  float v[4][8];
  float ss0 = 0.f, ss1 = 0.f;
#pragma unroll
  for (int i = 0; i < 4; ++i)
#pragma unroll
    for (int e = 0; e < 4; ++e) {
      v[i][2 * e] = __uint_as_float(raw[i][e] << 16); v[i][2 * e + 1] = __uint_as_float(raw[i][e] & 0xffff0000u);
      const float q = v[i][2 * e] * v[i][2 * e] + v[i][2 * e + 1] * v[i][2 * e + 1];
      if (i < 2) ss0 += q; else ss1 += q;
    }
  ss0 = wave_sum(ss0); ss1 = wave_sum(ss1);
  const float rstd0 = rsqrtf(ss0 * (1.0f / DM) + 1e-6f), rstd1 = rsqrtf(ss1 * (1.0f / DM) + 1e-6f);
#pragma unroll
  for (int i = 0; i < 4; ++i) {
    const int col = (i & 1) * 512 + lane * 8;
    const f32x4 g0 = *(const f32x4*)(P.final_gain + col), g1 = *(const f32x4*)(P.final_gain + col + 4);
    const float rstd = (i < 2) ? rstd0 : rstd1;
    f32x4 o0, o1;
#pragma unroll
    for (int e = 0; e < 4; ++e) { o0[e] = v[i][e] * rstd * g0[e]; o1[e] = v[i][4 + e] * rstd * g1[e]; }
    float* dst = P.out + (size_t)(row + (i >> 1)) * DM + col;
    __builtin_nontemporal_store(o0, (f32x4*)dst); __builtin_nontemporal_store(o1, (f32x4*)(dst + 4));
  }
}

#define XB_TMO      128
#define XB_XCNT(j)  (256  + 64 * (j))
#define XB_XSUB(j)  (1280 + 64 * (j))
#define XB_XGEN(j)  (2304 + 64 * (j))
#define XB_TOP      3328
#define XB_TOPGEN   3392
#define XCD_BAR_WORDS 3456
#define XB_SPIN_CAP (1u << 18)
__device__ __forceinline__ unsigned xb_ld(unsigned* p)              { return __hip_atomic_load(p, __ATOMIC_RELAXED, __HIP_MEMORY_SCOPE_AGENT); }
__device__ __forceinline__ unsigned xb_add(unsigned* p, unsigned v) { return __hip_atomic_fetch_add(p, v, __ATOMIC_RELAXED, __HIP_MEMORY_SCOPE_AGENT); }
__device__ __forceinline__ unsigned xb_xcc_id() { return (unsigned)__builtin_amdgcn_s_getreg((3 << 11) | 20) & 0xFu; }
#define XB_SPIN(cond, bar) do { unsigned _sp = 0; while (cond) { __builtin_amdgcn_s_sleep(1); \
    if ((++_sp & 255u) == 0u) { if (xb_ld(&(bar)[XB_TMO])) break; if (_sp > XB_SPIN_CAP) { atomicAdd(&(bar)[XB_TMO], 1u); break; } } } } while (0)
struct XcdBarrier { unsigned* bar; unsigned x; volatile LAS unsigned* st; };
__device__ __forceinline__ XcdBarrier xcd_barrier_post(unsigned* bar, volatile LAS unsigned* st) {
  XcdBarrier b; b.bar = bar; b.x = xb_xcc_id(); b.st = st;
  if (threadIdx.x == 0) (void)xb_add(&bar[XB_XCNT(b.x)], 1u);
  return b;
}
__device__ __forceinline__ void xcd_barrier_complete(unsigned* bar, unsigned x, unsigned& nloc, unsigned& nx) {
  const unsigned G = gridDim.x * gridDim.y * gridDim.z;
  unsigned sum, cnt, mine, sp = 0u;
  for (;;) {
    sum = 0u; cnt = 0u; mine = 0u;
#pragma unroll
    for (unsigned j = 0; j < 16; ++j) { const unsigned c = xb_ld(&bar[XB_XCNT(j)]); sum += c; cnt += (c > 0u) ? 1u : 0u; mine = (j == x) ? c : mine; }
    if (sum == G) break;
    __builtin_amdgcn_s_sleep(1);
    if ((++sp & 255u) == 0u) { if (xb_ld(&bar[XB_TMO])) break; if (sp > XB_SPIN_CAP) { atomicAdd(&bar[XB_TMO], 1u); break; } }
  }
  nloc = mine > 0u ? mine : 1u; nx = cnt > 0u ? cnt : 1u;
}
__device__ __forceinline__ void xcd_barrier(const XcdBarrier& b) {
  asm volatile("s_waitcnt vmcnt(0)" ::: "memory");
  __syncthreads();
  if (threadIdx.x == 0) {
    unsigned* bar = b.bar;
    __builtin_amdgcn_s_waitcnt(0);
    unsigned nloc = b.st[0], nx = b.st[1];
    if (nloc == 0u) { xcd_barrier_complete(bar, b.x, nloc, nx); b.st[0] = nloc; b.st[1] = nx; }
    const unsigned old = xb_add(&bar[XB_XSUB(b.x)], 1u);
    const unsigned gen = old / nloc;
    if (old + 1u == (gen + 1u) * nloc) {
      __builtin_amdgcn_fence(__ATOMIC_RELEASE, "agent");
      asm volatile("s_waitcnt vmcnt(0)" ::: "memory");
      const unsigned og = xb_add(&bar[XB_TOP], 1u);
      const unsigned tg = og / nx;
      if (og + 1u == (tg + 1u) * nx) xb_add(&bar[XB_TOPGEN], 1u);
      else XB_SPIN(xb_ld(&bar[XB_TOPGEN]) == tg, bar);
      __builtin_amdgcn_fence(__ATOMIC_ACQUIRE, "agent");
      xb_add(&bar[XB_XGEN(b.x)], 1u);
      asm volatile("s_waitcnt vmcnt(0)" ::: "memory");
    } else {
      XB_SPIN(xb_ld(&bar[XB_XGEN(b.x)]) == gen, bar);
      __builtin_amdgcn_fence(__ATOMIC_ACQUIRE, "agent");
      asm volatile("s_waitcnt vmcnt(0)" ::: "memory");
    }
  }
  __syncthreads();
}

constexpr int LDS_CTRL = 18432 + 8 * 16384 + 5632;
constexpr int LDS_BYTES = LDS_CTRL + 16;
constexpr int HALF_LDS_FLOATS = 18432;
constexpr int SCAN_BLOCKS = 64;
#ifndef PROBE
#define PROBE 0
#endif

__global__ void __launch_bounds__(512, 2) fwd_megakernel(Params P) {
  extern __shared__ __attribute__((aligned(16))) unsigned char lds[];
  float* sm = (float*)lds;
  cg::grid_group grid = cg::this_grid();
  const int nb = gridDim.x, bid = blockIdx.x, tid = threadIdx.x, half = tid >> 8, t8 = tid & 255;
  float* smh = sm + half * HALF_LDS_FLOATS;
  volatile LAS unsigned* xst = (volatile LAS unsigned*)((LAS unsigned char*)lds + LDS_CTRL);
  if (tid == 0) { xst[0] = 0u; xst[1] = 0u; }
  __syncthreads();
  const XcdBarrier xbar = xcd_barrier_post(P.barw, xst);
  for (int rep = 0; rep < (PROBE == 5 ? 2 : 1); ++rep)
  for (int it = bid; it < PREP_ITEMS; it += nb) prep_item(P, it, sm);
  if (P.out == nullptr) grid.sync();
  for (int r_ = 0; r_ < (PROBE == 10 ? 3 : 1); ++r_) xcd_barrier(xbar);
  {
    pg8::Gemm g; g.A = P.hb; g.Bt = P.winT; g.M = MTOK; g.N = NPAD; g.K = DM; g.lda = DM;
    pg8::StaticOrder S; S.init(MTOK, NPAD, nb, bid);
    EpiProj E; E.p = P.p;
    pg8::gemm_phase<EpiProj>((LAS unsigned char*)lds, g, S, E);
    if (PROBE == 4) pg8::gemm_phase<EpiProj>((LAS unsigned char*)lds, g, S, E);
  }
  for (int r_ = 0; r_ < (PROBE == 10 ? 3 : 1); ++r_) xcd_barrier(xbar);
  for (int rep = 0; rep < (PROBE == 3 ? 2 : 1); ++rep)
  for (int vb = bid; vb < 256; vb += nb) rwkv_prep_waves(P, vb, (unsigned char*)lds);
  for (int r_ = 0; r_ < (PROBE == 10 ? 3 : 1); ++r_) xcd_barrier(xbar);
  for (int rep = 0; rep < (PROBE == 7 ? 2 : 1); ++rep) {
  if (bid < SCAN_BLOCKS) rwkv_scan_block(P, bid, (LAS unsigned char*)lds);
  {
    volatile LAS int* qslot = (volatile LAS int*)((LAS unsigned char*)lds + LDS_CTRL + 8);
    unsigned* ctr = P.barw + XCD_BAR_WORDS + 64 + rep * 1024;
    int qx = (int)(xbar.x & 7u), tried = 0;
    constexpr int QPAIRS = ATT_ITEMS / 16;
#define ATT_FETCH(dst) do { dst = -1; while (tried < 8) { const int ix_ = (int)atomicAdd(ctr + qx * 64, 1u); if (ix_ < QPAIRS) { dst = qx * QPAIRS + ix_; break; } qx = (qx + 1) & 7; ++tried; } } while (0)
    int a1 = -1;
    if (tid == 0) { int a0; ATT_FETCH(a0); ATT_FETCH(a1); *qslot = a0; }
    __syncthreads();
    int it = *qslot;
    AttnRegs R;
#define ATT_ITEM(pr) ((8 * ((2 * ((pr) % QPAIRS)) / 96) + (pr) / QPAIRS) * 96 + (2 * ((pr) % QPAIRS)) % 96 + half)
    attn_load(P, ATT_ITEM(it >= 0 ? it : 0), t8, R);
    while (it >= 0) {
      __syncthreads();
      if (tid == 0) { *qslot = a1; ATT_FETCH(a1); }
      attn_stage(smh, t8, R);
      const bf16x8 qa0 = R.qa0, qa1 = R.qa1, qb0 = R.qb0, qb1 = R.qb1;
      __syncthreads();
      const int itn = *qslot;
      attn_load(P, ATT_ITEM(itn >= 0 ? itn : 0), t8, R);
      const int item = ATT_ITEM(it);
      attn_compute(P, item, smh, t8, 2 * (t8 >> 6), qa0, qa1);
      attn_compute(P, item, smh, t8, 2 * (t8 >> 6) + 1, qb0, qb1);
      it = itn;
    }
#undef ATT_FETCH
#undef ATT_ITEM
  }
  __syncthreads();
  }
  for (int r_ = 0; r_ < (PROBE == 10 ? 3 : 1); ++r_) xcd_barrier(xbar);
  if (PROBE == 9) for (int it = bid; it < MERGE_ITEMS / 2; it += nb) merge_item(P, it, true);
  for (int it = bid; it < MERGE_ITEMS / 2; it += nb) merge_item(P, it, false);
  for (int r_ = 0; r_ < (PROBE == 10 ? 3 : 1); ++r_) xcd_barrier(xbar);
  {
    pg8::Gemm g; g.A = P.p + OFF_ZA; g.Bt = P.woutT; g.M = MTOK; g.N = DM; g.K = DM; g.lda = NIN;
    pg8::StaticOrder S; S.init(MTOK, DM, nb, bid);
    EpiOut E; E.x = P.x; E.ybf = (bf16_t*)P.rec;
    pg8::gemm_phase<EpiOut>((LAS unsigned char*)lds, g, S, E);
    if (PROBE == 6) pg8::gemm_phase<EpiOut>((LAS unsigned char*)lds, g, S, E);
  }
  for (int r_ = 0; r_ < (PROBE == 10 ? 3 : 1); ++r_) xcd_barrier(xbar);
  for (int it = bid; it < MTOK / 16; it += nb) final_norm_item(P, it, false);
}

extern "C" void kernel_launch(void* const* d_in, const int* in_sizes, int n_in, void* d_out, int out_size, void* d_ws, size_t ws_size,
                              hipStream_t stream) {
  Params P{};
  P.x = (const float*)d_in[0]; P.norm_gain = (const float*)d_in[1]; P.w_in = (const float*)d_in[2]; P.shift_mix = (const float*)d_in[3];
  P.decay_base = (const float*)d_in[4]; P.decay_up = (const float*)d_in[5]; P.iclr_base = (const float*)d_in[6]; P.iclr_up = (const float*)d_in[7];
  P.key_norm_scale = (const float*)d_in[8]; P.key_iclr_mix = (const float*)d_in[9]; P.bonus = (const float*)d_in[10]; P.gn_gain = (const float*)d_in[11];
  P.gn_bias = (const float*)d_in[12]; P.w_out = (const float*)d_in[13]; P.final_gain = (const float*)d_in[14];
  P.out = (float*)d_out;
  char* ws = (char*)d_ws;
  const size_t MiB = 1024 * 1024;
  P.winT = (bf16_t*)(ws);
  P.woutT = (bf16_t*)(ws + 9 * MiB);
  P.dut = (bf16_t*)(ws + 11 * MiB);
  P.iut = (bf16_t*)(ws + 11 * MiB + 65536);
  P.p = (bf16_t*)(ws + 12 * MiB);
  P.hb = (bf16_t*)(ws + 276 * MiB);
  P.rec = ws + 276 * MiB;
  P.yraw = (bf16_t*)(ws + 474 * MiB);
  P.barw = (unsigned*)(ws + 506 * MiB);
  if (ws_size < 507 * MiB) { fprintf(stderr, "workspace too small\n"); return; }
  static int grid_blocks = 0;
  if (!grid_blocks) {
    int dev = 0, cus = 0, per_cu = 0;
    (void)hipGetDevice(&dev);
    (void)hipDeviceGetAttribute(&cus, hipDeviceAttributeMultiprocessorCount, dev);
    (void)hipFuncSetAttribute((const void*)fwd_megakernel, hipFuncAttributeMaxDynamicSharedMemorySize, LDS_BYTES);
    (void)hipOccupancyMaxActiveBlocksPerMultiprocessor(&per_cu, fwd_megakernel, 512, LDS_BYTES);
    if (per_cu > 1) per_cu = 1;
    grid_blocks = cus * per_cu;
  }
  (void)hipMemsetAsync(P.barw, 0, (XCD_BAR_WORDS + 64 + 2048) * sizeof(unsigned), stream);
  void* args[] = {&P};
  hipError_t e = hipLaunchCooperativeKernel((void*)fwd_megakernel, dim3(grid_blocks), dim3(512), args, LDS_BYTES, stream);
  if (e != hipSuccess) fprintf(stderr, "cooperative launch failed: %s (grid %d)\n", hipGetErrorString(e), grid_blocks);
}
```

```cpp
#include <hip/hip_runtime.h>
#include <hip/hip_cooperative_groups.h>
#include <stdint.h>
#include <cstdio>
namespace cg = cooperative_groups;

typedef unsigned short bf16_t;
typedef short bf16x8 __attribute__((ext_vector_type(8)));
typedef float f32x4 __attribute__((ext_vector_type(4)));
typedef unsigned u32x4 __attribute__((ext_vector_type(4)));
#define LAS __attribute__((address_space(3)))

constexpr int SEQ = 4096, DM = 1024, MTOK = 32768, NIN = 4224, NPAD = 4352;
constexpr int OFF_R = 0, OFF_K = 512, OFF_V = 1024, OFF_WLO = 1536, OFF_ALO = 1600;
constexpr int OFF_Q = 1664, OFF_KB = 2176, OFF_VB = 2688, OFF_ZA = 3200, OFF_ZB = 3712;

struct Params {
  const float *x, *norm_gain, *w_in, *shift_mix, *decay_base, *decay_up, *iclr_base, *iclr_up,
      *key_norm_scale, *key_iclr_mix, *bonus, *gn_gain, *gn_bias, *w_out, *final_gain;
  float* out;
  bf16_t *hb, *winT, *woutT, *p, *yraw, *dut, *iut;
  char* rec;
  unsigned* barw;
};

typedef float f32x2_t __attribute__((ext_vector_type(2)));
typedef __bf16 bf16x2_t __attribute__((ext_vector_type(2)));
__device__ __forceinline__ unsigned pk_bf16(float lo, float hi) { const f32x2_t v = {lo, hi}; return __builtin_bit_cast(unsigned, __builtin_convertvector(v, bf16x2_t)); }
__device__ __forceinline__ bf16_t f2bf(float f) { return (bf16_t)(pk_bf16(f, 0.f) & 0xffffu); }
__device__ __forceinline__ u32x4 ld_nt(const void* p) { return __builtin_nontemporal_load((const u32x4*)p); }
__device__ __forceinline__ f32x4 ldf_nt(const void* p) { return __builtin_nontemporal_load((const f32x4*)p); }
__device__ __forceinline__ float bf2f(bf16_t h) { return __uint_as_float(((unsigned)h) << 16); }
__device__ __forceinline__ float dpp_add(float v, const int ctrl_sel) {
  const int iv = __builtin_bit_cast(int, v);
  int o;
  if (ctrl_sel == 0) o = __builtin_amdgcn_update_dpp(iv, iv, 0xB1, 0xF, 0xF, false);
  else if (ctrl_sel == 1) o = __builtin_amdgcn_update_dpp(iv, iv, 0x4E, 0xF, 0xF, false);
  else if (ctrl_sel == 2) o = __builtin_amdgcn_update_dpp(iv, iv, 0x141, 0xF, 0xF, false);
  else o = __builtin_amdgcn_update_dpp(iv, iv, 0x140, 0xF, 0xF, false);
  return v + __builtin_bit_cast(float, o);
}
__device__ __forceinline__ float wave_sum(float v) {
  v = dpp_add(v, 0); v = dpp_add(v, 1); v = dpp_add(v, 2); v = dpp_add(v, 3);
  const int iv = __builtin_bit_cast(int, v);
  const float s0 = __builtin_bit_cast(float, __builtin_amdgcn_readlane(iv, 0)), s1 = __builtin_bit_cast(float, __builtin_amdgcn_readlane(iv, 16));
  const float s2 = __builtin_bit_cast(float, __builtin_amdgcn_readlane(iv, 32)), s3 = __builtin_bit_cast(float, __builtin_amdgcn_readlane(iv, 48));
  return (s0 + s1) + (s2 + s3);
}
__device__ __forceinline__ float silu(float z) { return z / (1.f + __expf(-z)); }
__device__ __forceinline__ bf16x8 as_frag(u32x4 v) { return __builtin_bit_cast(bf16x8, v); }

constexpr int PREP_ROW_ITEMS = MTOK / 16, PREP_WIN_TILES = 16 * 68, PREP_WOUT_TILES = 16 * 16;
constexpr int PREP_LR_ITEMS = 128;
constexpr int PREP_ITEMS = PREP_ROW_ITEMS + PREP_WIN_TILES + PREP_WOUT_TILES + PREP_LR_ITEMS;

__device__ void prep_item(const Params& P, int it, float* sm) {
  const int tid = threadIdx.x, lane = tid & 63, wv = tid >> 6;
  if (it < PREP_ROW_ITEMS) {
    const int row = it * 16 + wv * 2;
    const float4* xr = (const float4*)(P.x + (size_t)row * DM);
    const float4* g4 = (const float4*)P.norm_gain;
    float4 v[8];
    float ss0 = 0.f, ss1 = 0.f;
#pragma unroll
    for (int i = 0; i < 8; ++i) { const f32x4 t_ = ldf_nt(xr + lane + 64 * i); v[i] = make_float4(t_[0], t_[1], t_[2], t_[3]); }
#pragma unroll
    for (int i = 0; i < 4; ++i) {
      ss0 += v[i].x * v[i].x + v[i].y * v[i].y + v[i].z * v[i].z + v[i].w * v[i].w;
      ss1 += v[4 + i].x * v[4 + i].x + v[4 + i].y * v[4 + i].y + v[4 + i].z * v[4 + i].z + v[4 + i].w * v[4 + i].w;
    }
    ss0 = wave_sum(ss0); ss1 = wave_sum(ss1);
    const float rstd0 = rsqrtf(ss0 * (1.0f / DM) + 1e-6f), rstd1 = rsqrtf(ss1 * (1.0f / DM) + 1e-6f);
#pragma unroll
    for (int i = 0; i < 8; ++i) {
      const float4 g = g4[lane + 64 * (i & 3)];
      const float rstd = (i < 4) ? rstd0 : rstd1;
      ushort4 o;
      o.x = f2bf(v[i].x * rstd * g.x); o.y = f2bf(v[i].y * rstd * g.y);
      o.z = f2bf(v[i].z * rstd * g.z); o.w = f2bf(v[i].w * rstd * g.w);
      *(ushort4*)(P.hb + (size_t)row * DM + (lane + 64 * i) * 4) = o;
    }
    return;
  }
  it -= PREP_ROW_ITEMS;
  if (it >= PREP_WIN_TILES + PREP_WOUT_TILES) {
    it -= PREP_WIN_TILES + PREP_WOUT_TILES;
    const float* srcm = (it < 64) ? P.decay_up : P.iclr_up;
    bf16_t* dstm = (it < 64) ? P.dut : P.iut;
    const int e = (it & 63) * 512 + tid, chn = e >> 6, k = e & 63;
    dstm[e] = f2bf(srcm[k * 512 + chn]);
    return;
  }
  const float* src; bf16_t* dst; int ncols, kt, nt, scol;
  if (it < PREP_WIN_TILES) {
    src = P.w_in; dst = P.winT; ncols = NIN; kt = it / 68; nt = it % 68;
    const int n0 = nt * 64;
    scol = (n0 < 1664) ? n0 : (n0 < 3200) ? (n0 + 512) : (n0 < 3712) ? (n0 - 1536) : (n0 < 4224) ? n0 : -1;
  } else { it -= PREP_WIN_TILES; src = P.w_out; dst = P.woutT; ncols = DM; kt = it / 16; nt = it % 16; scol = nt * 64; }
#pragma unroll 4
  for (int i = 0; i < 8; ++i) {
    const int r = wv + 8 * i;
    sm[r * 65 + lane] = (scol >= 0) ? src[(size_t)(kt * 64 + r) * ncols + scol + lane] : 0.f;
  }
  __syncthreads();
#pragma unroll 4
  for (int i = 0; i < 8; ++i) {
    const int r = wv + 8 * i;
    dst[(size_t)(nt * 64 + r) * DM + kt * 64 + lane] = f2bf(sm[lane * 65 + r]);
  }
  __syncthreads();
}

namespace pg8 {
constexpr int BM = 256, BK = 64, HALF = 128, HTB = HALF * BK * 2, STAGE_BYTES = 8 * HTB, NXCD = 8, WGM = 8;
__host__ __device__ __forceinline__ int lds_byte(int r, int c) { const int st = (r >> 4) * 2 + (c >> 5), rr = r & 15, cc = c & 31, ob = rr * 64 + cc * 2; return st * 1024 + (ob ^ (((ob >> 9) & 1) << 5)); }
__host__ __device__ __forceinline__ void stage_rc(int b, int& R, int& C) { const int st = b / 1024, sb = b % 1024, swz = sb ^ (((sb >> 9) & 1) << 5); R = (st >> 1) * 16 + swz / 64; C = (st & 1) * 32 + (swz % 64) / 2; }
__host__ __device__ __forceinline__ int perm32(int rho) { const int n = rho >> 4, i = rho & 15; return 8 * (i >> 2) + 4 * n + (i & 3); }
struct Unit { int pm, pn; };
struct Gemm { const bf16_t* A; const bf16_t* Bt; int M, N, K, lda; };
struct StaticOrder {
  int nM, nN, nwg, G, c;
  __host__ __device__ void init(int M, int N, int G_, int c_) { nM = M / BM; nN = N / BM; nwg = nM * nN; G = G_; c = c_; }
  __host__ __device__ bool next(int i, Unit& u) const {
    const long L = (long)i * G + c; if (L >= nwg) return false;
    int wgid = (int)L; { const int q = nwg / NXCD, r = nwg % NXCD, xcd = wgid % NXCD, off = wgid / NXCD; wgid = (xcd < r ? xcd * (q + 1) : r * (q + 1) + (xcd - r) * q) + off; }
    const int nig = WGM * nN, gid = wgid / nig, fm = gid * WGM, gsz = (nM - fm) < WGM ? (nM - fm) : WGM;
    u.pm = fm + ((wgid % nig) % gsz); u.pn = (wgid % nig) / gsz; return true;
  }
};
template <class Epi>
__device__ __forceinline__ void gemm_phase(LAS unsigned char* lds, const Gemm g, const StaticOrder& S, const Epi& E) {
  const int tid = threadIdx.x, wid = __builtin_amdgcn_readfirstlane(tid >> 6), lane = tid & 63, wr = wid >> 2, wc = wid & 3, fr = lane & 15, fq = lane >> 4;
  const int K = g.K, nt = K / BK, lda = g.lda;
  unsigned voffA[2], voffB[2];
#pragma unroll
  for (int i = 0; i < 2; ++i) { int R, C; stage_rc(tid * 16 + i * 8192, R, C); const int Rb = (R & ~31) + perm32(R & 31);
    voffA[i] = (unsigned)(R * lda + C) * 2u; voffB[i] = (unsigned)(Rb * K + C) * 2u; }
  const size_t kstep = (size_t)(BK * 2);
  const size_t hstepA = (size_t)HALF * lda * 2, hstepB = (size_t)HALF * K * 2;
  const size_t tstepA = 2 * hstepA, tstepB = 2 * hstepB;
  const unsigned ldsw = (unsigned)wid * 1024u;
  const int aoff = lds_byte(wr * 64 + fr, fq * 8), boff = lds_byte(wc * 32 + fr, fq * 8);
#define PG8_SA(b, h) (((b) * 2 + (h)) * HTB)
#define PG8_SB(b, h) ((4 + (b) * 2 + (h)) * HTB)
#define PG8_STAGE(bufoff, gbase, voff) do { _Pragma("unroll") for (int _i = 0; _i < 2; ++_i) \
    __builtin_amdgcn_global_load_lds((const unsigned*)((const char*)(gbase) + (voff)[_i]), (LAS unsigned*)(lds + (bufoff) + ldsw + _i * 8192), 16, 0, 0); } while (0)
#define PG8_LDA(dst, b, h) do { _Pragma("unroll") for (int m = 0; m < 4; ++m) _Pragma("unroll") for (int k = 0; k < 2; ++k) dst[m][k] = *(const LAS bf16x8*)(lds + PG8_SA(b, h) + aoff + m * 2048 + k * 1024); } while (0)
#define PG8_LDB(dst, b, h) do { _Pragma("unroll") for (int n = 0; n < 2; ++n) _Pragma("unroll") for (int k = 0; k < 2; ++k) dst[n][k] = *(const LAS bf16x8*)(lds + PG8_SB(b, h) + boff + n * 2048 + k * 1024); } while (0)
#define PG8_MMA(ai, bj, At, Bt) do { __builtin_amdgcn_s_setprio(1); _Pragma("unroll") for (int m = 0; m < 4; ++m) _Pragma("unroll") for (int n = 0; n < 2; ++n) _Pragma("unroll") for (int k = 0; k < 2; ++k) \
    acc[ai][bj][m][n] = __builtin_amdgcn_mfma_f32_16x16x32_bf16(Bt[n][k], At[m][k], acc[ai][bj][m][n], 0, 0, 0); __builtin_amdgcn_s_setprio(0); } while (0)
#define PG8_WAIT_V(n) asm volatile("s_waitcnt vmcnt(" #n ")" ::: "memory")
#define PG8_WAIT_L(n) asm volatile("s_waitcnt lgkmcnt(" #n ")" ::: "memory")
#define PG8_BAR __builtin_amdgcn_s_barrier()
#define PG8_SCHED __builtin_amdgcn_sched_barrier(0)
  Unit cur, nxt; int ui = 0;
  if (!S.next(0, cur)) return;
  f32x4 acc[2][2][4][2];
#pragma unroll
  for (int a = 0; a < 2; ++a)
#pragma unroll
    for (int b = 0; b < 2; ++b)
#pragma unroll
      for (int m = 0; m < 4; ++m)
#pragma unroll
        for (int n = 0; n < 2; ++n) acc[a][b][m][n] = (f32x4){0.f, 0.f, 0.f, 0.f};
  bf16x8 At[4][2], B0[2][2], B1[2][2];
  const char* cA = (const char*)g.A + (size_t)cur.pm * tstepA; const char* cB = (const char*)g.Bt + (size_t)cur.pn * tstepB;
  PG8_STAGE(PG8_SB(0, 0), cB, voffB); PG8_STAGE(PG8_SB(0, 1), cB + hstepB, voffB); PG8_STAGE(PG8_SA(0, 0), cA, voffA); PG8_STAGE(PG8_SA(0, 1), cA + hstepA, voffA);
  if (wr == 1) PG8_BAR;
  PG8_WAIT_V(2); PG8_BAR;
  PG8_STAGE(PG8_SB(1, 0), cB + kstep, voffB); PG8_STAGE(PG8_SA(1, 0), cA + kstep, voffA); PG8_STAGE(PG8_SB(1, 1), cB + hstepB + kstep, voffB);
  PG8_WAIT_V(6); PG8_BAR;
  for (;;) {
    const bool has_next = S.next(ui + 1, nxt);
    const char* nA = has_next ? (const char*)g.A + (size_t)nxt.pm * tstepA : cA; const char* nB = has_next ? (const char*)g.Bt + (size_t)nxt.pn * tstepB : cB;
    for (int t = 0; t < nt; t += 2) {
      const bool last = (t == nt - 2);
      const char* a1 = cA + (size_t)(t + 1) * kstep;
      const char* a2 = last ? nA : cA + (size_t)(t + 2) * kstep; const char* b2 = last ? nB : cB + (size_t)(t + 2) * kstep;
      const char* a3 = a2 + kstep; const char* b3 = b2 + kstep;
      PG8_LDB(B0, 0, 0); PG8_LDB(B1, 0, 1); PG8_SCHED; PG8_LDA(At, 0, 0); PG8_STAGE(PG8_SA(1, 1), a1 + hstepA, voffA);
      PG8_WAIT_V(8); PG8_WAIT_L(0); PG8_BAR; PG8_MMA(0, 0, At, B0); PG8_MMA(0, 1, At, B1); PG8_BAR; PG8_SCHED;
      PG8_LDA(At, 0, 1); PG8_STAGE(PG8_SB(0, 0), b2, voffB); PG8_STAGE(PG8_SB(0, 1), b2 + hstepB, voffB); PG8_STAGE(PG8_SA(0, 0), a2, voffA);
      PG8_WAIT_V(8); PG8_WAIT_L(0); PG8_BAR; PG8_MMA(1, 0, At, B0); PG8_MMA(1, 1, At, B1); PG8_BAR; PG8_SCHED;
      PG8_LDB(B0, 1, 0); PG8_LDB(B1, 1, 1); PG8_SCHED; PG8_LDA(At, 1, 0); PG8_STAGE(PG8_SA(0, 1), a2 + hstepA, voffA);
      PG8_WAIT_V(8); PG8_WAIT_L(0); PG8_BAR; PG8_MMA(0, 0, At, B0); PG8_MMA(0, 1, At, B1); PG8_BAR; PG8_SCHED;
      PG8_LDA(At, 1, 1); PG8_STAGE(PG8_SB(1, 0), b3, voffB); PG8_STAGE(PG8_SB(1, 1), b3 + hstepB, voffB); PG8_STAGE(PG8_SA(1, 0), a3, voffA);
      PG8_WAIT_V(8); PG8_WAIT_L(0); PG8_BAR; PG8_MMA(1, 0, At, B0); PG8_MMA(1, 1, At, B1); PG8_BAR; PG8_SCHED;
    }
    if (wr == 0) PG8_BAR;
    E(acc, cur, wr, wc, fr, fq);
    if (!has_next) break;
#pragma unroll
    for (int a = 0; a < 2; ++a)
#pragma unroll
      for (int b = 0; b < 2; ++b)
#pragma unroll
        for (int m = 0; m < 4; ++m)
#pragma unroll
          for (int n = 0; n < 2; ++n) acc[a][b][m][n] = (f32x4){0.f, 0.f, 0.f, 0.f};
    cur = nxt; cA = nA; cB = nB; ++ui;
    if (wr == 1) PG8_BAR;
  }
  PG8_WAIT_V(0);
  PG8_BAR;
#undef PG8_SA
#undef PG8_SB
#undef PG8_STAGE
#undef PG8_LDA
#undef PG8_LDB
#undef PG8_MMA
#undef PG8_WAIT_V
#undef PG8_WAIT_L
#undef PG8_BAR
#undef PG8_SCHED
}
}

struct EpiProj {
  bf16_t* p;
  __device__ __forceinline__ void operator()(const f32x4 (&acc)[2][2][4][2], const pg8::Unit& u, int wr, int wc, int fr, int fq) const {
    const float inv[8] = {1.0f, 0.1939227432012558f, 0.03760603070259094f, 0.007292664609849453f, 0.0014142135623842478f, 0.00027424818836152554f, 5.3182957344688475e-05f, 1.0313385246263351e-05f};
#pragma unroll
    for (int bj = 0; bj < 2; ++bj) {
      const int wcol = u.pn * 256 + bj * 128 + wc * 32;
      if (wcol >= NIN) continue;
      const int col0 = wcol + 8 * fq;
      const bool wrope = (wcol >= OFF_Q) && (wcol < OFF_VB) && ((wcol & 63) == 0);
#pragma unroll
      for (int ai = 0; ai < 2; ++ai)
#pragma unroll
        for (int m = 0; m < 4; ++m) {
          const int row = u.pm * 256 + ai * 128 + wr * 64 + m * 16 + fr;
          float v[8];
#pragma unroll
          for (int e = 0; e < 4; ++e) { v[e] = acc[ai][bj][m][0][e]; v[4 + e] = acc[ai][bj][m][1][e]; }
          if (wrope) {
            const float pos = (float)(row & (SEQ - 1));
#pragma unroll
            for (int e = 0; e < 8; ++e) {
              const float other = __shfl_xor(v[e], 16);
              float rev = pos * inv[e] * 0.15915494309189535f;
              rev = (rev - rintf(rev)) * 6.283185307179586f;
              const float sn = __sinf(rev), cs = __cosf(rev);
              const float r0 = v[e] * cs - other * sn, r1 = other * sn + v[e] * cs;
              v[e] = (fq == 0) ? r0 : (fq == 1) ? r1 : v[e];
            }
          }
          u32x4 w;
          w.x = pk_bf16(v[0], v[1]); w.y = pk_bf16(v[2], v[3]); w.z = pk_bf16(v[4], v[5]); w.w = pk_bf16(v[6], v[7]);
          __builtin_nontemporal_store(w, (u32x4*)(p + (size_t)row * NIN + col0));
        }
    }
  }
};
struct EpiOut {
  const float* x; bf16_t* ybf;
  __device__ __forceinline__ void operator()(const f32x4 (&acc)[2][2][4][2], const pg8::Unit& u, int wr, int wc, int fr, int fq) const {
#pragma unroll
    for (int bj = 0; bj < 2; ++bj) {
      const int col0 = u.pn * 256 + bj * 128 + wc * 32 + 8 * fq;
#pragma unroll
      for (int ai = 0; ai < 2; ++ai)
#pragma unroll
        for (int m = 0; m < 4; ++m) {
          const int row = u.pm * 256 + ai * 128 + wr * 64 + m * 16 + fr;
          const size_t idx = (size_t)row * DM + col0;
          const f32x4 a0 = ldf_nt(x + idx) + acc[ai][bj][m][0], a1 = ldf_nt(x + idx + 4) + acc[ai][bj][m][1];
          u32x4 w; w.x = pk_bf16(a0[0], a0[1]); w.y = pk_bf16(a0[2], a0[3]); w.z = pk_bf16(a1[0], a1[1]); w.w = pk_bf16(a1[2], a1[3]);
          *(u32x4*)(ybf + idx) = w;
        }
    }
  }
};

constexpr int REC_BYTES = 12672, REC_M1 = 0, REC_R = 1024, REC_BK = 2048, REC_TA = 4096, REC_AR = 4608, REC_VB = 5120;
constexpr int REC_WC_B = 12288, REC_RKB_B = 12544;
constexpr int RPREP_ITEMS = 64 * 256;
constexpr int LS = 68;
__device__ __forceinline__ bf16x8 cvt8(const float* p) {
  const float4 a = *(const float4*)p, b = *(const float4*)(p + 4);
  u32x4 r; r.x = pk_bf16(a.x, a.y); r.y = pk_bf16(a.z, a.w); r.z = pk_bf16(b.x, b.y); r.w = pk_bf16(b.z, b.w);
  return as_frag(r);
}
__device__ __forceinline__ float fast_tanh(float x) { return 1.f - 2.f * __builtin_amdgcn_rcpf(1.f + __expf(2.f * x)); }
__device__ void rwkv_prep_block(const Params& P, int vb, float* sm, const int tid, const int half) {
  const int bh = vb >> 2, b = bh >> 3, h = bh & 7;
  const int lane = tid & 63, tt = tid >> 6, g = lane >> 4, i = lane & 15;
  float* s_r = sm;             float* s_k = sm + 1088;      float* s_at = sm + 2 * 1088;  float* s_bt = sm + 3 * 1088;
  float* s_lw = sm + 4 * 1088; float* s_an = sm + 5 * 1088; float* s_b = sm + 6 * 1088;   float* s_kt = sm + 7 * 1088;
  float* s_rt = sm + 8 * 1088; float* s_Aab = sm + 9 * 1088; float* s_Aak = s_Aab + 272;
  float* s_xw = s_at; float* s_xa = s_bt;
  bf16_t* s_twb = (bf16_t*)(sm + 9 * 1088 + 544);
  bf16_t* s_pab = s_twb + 16 * 72;
  bf16_t* rec = (bf16_t*)(sm + 9 * 1088 + 544 + 1152);
  bf16_t* s_raw = (bf16_t*)s_lw;
  const int c = h * 64 + lane;
  const float mix_r = P.shift_mix[OFF_R + c], mix_k = P.shift_mix[OFF_K + c], mix_v = P.shift_mix[OFF_V + c];
  const float mix_w = P.shift_mix[OFF_WLO + lane], mix_a = P.shift_mix[OFF_ALO + lane];
  const float dbase = P.decay_base[c], ibase = P.iclr_base[c], kns = P.key_norm_scale[c], kim = P.key_iclr_mix[c], bon = P.bonus[c];
  const bf16_t* dup = P.dut + (size_t)(h * 64 + 16 * tt + i) * 64 + 8 * g;
  const bf16_t* iup = P.iut + (size_t)(h * 64 + 16 * tt + i) * 64 + 8 * g;
  const bf16x8 bd0 = *(const bf16x8*)dup, bd1 = *(const bf16x8*)(dup + 32), bi0 = *(const bf16x8*)iup, bi1 = *(const bf16x8*)(iup + 32);
  int prow[3], pcol[3], plds[3];
#pragma unroll
  for (int u = 0; u < 3; ++u) {
    const int idx = tid + 256 * u, rr = idx / 40, q = idx - rr * 40, cg = q >> 3, sub = q & 7;
    prow[u] = (idx < 680) ? rr : -100000;
    pcol[u] = ((cg < 3) ? (cg * 512 + h * 64) : (cg == 3 ? OFF_WLO : OFF_ALO)) + sub * 8;
    plds[u] = rr * 328 + cg * 64 + sub * 8;
  }
  const bf16_t* pb = P.p + (size_t)(b * SEQ) * NIN;
  uint4 pre[3];
#define RP_PREFETCH(chunk) do { _Pragma("unroll") for (int u = 0; u < 3; ++u) { const int t_ = (chunk) * 16 - 1 + prow[u]; \
    pre[u] = (t_ >= 0) ? *(const uint4*)(pb + (size_t)t_ * NIN + pcol[u]) : make_uint4(0u, 0u, 0u, 0u); } } while (0)
  const int cbase = (vb & 3) * 64 + half;
  RP_PREFETCH(cbase);
#pragma unroll
  for (int u = 0; u < 3; ++u) if (prow[u] >= 0) *(uint4*)(s_raw + plds[u]) = pre[u];
  __syncthreads();
  for (int kk2 = 0; kk2 < 32; ++kk2) {
  const int ch = cbase + 2 * kk2;
  const int item = bh * 256 + ch;
  char* recb = P.rec + (size_t)item * REC_BYTES;
  if (kk2 + 1 < 32) RP_PREFETCH(ch + 2);
  {
#pragma unroll
    for (int q = 0; q < 4; ++q) {
      const int tl = tt + 4 * q;
      const bf16_t* row = s_raw + (tl + 1) * 328;
      const bf16_t* prw = s_raw + tl * 328;
      const float cr = bf2f(row[lane]), ck = bf2f(row[64 + lane]), cv = bf2f(row[128 + lane]), cw = bf2f(row[192 + lane]), ca = bf2f(row[256 + lane]);
      const float pr = bf2f(prw[lane]), pk = bf2f(prw[64 + lane]), pv = bf2f(prw[128 + lane]), pw = bf2f(prw[192 + lane]), pa = bf2f(prw[256 + lane]);
      s_r[tl * LS + lane] = cr + (pr - cr) * mix_r;
      s_k[tl * LS + lane] = ck + (pk - ck) * mix_k;
      s_twb[tl * 72 + lane] = f2bf(fast_tanh(cw + (pw - cw) * mix_w));
      s_pab[tl * 72 + lane] = f2bf(ca + (pa - ca) * mix_a);
      const float vv = cv + (pv - cv) * mix_v;
      rec[REC_VB + (lane >> 4) * 256 + (16 * (tl >> 2) + (lane & 15)) * 4 + (tl & 3)] = f2bf(vv);
    }
  }
  __syncthreads();
  {
    const bf16x8 aw0 = *(const bf16x8*)(s_twb + i * 72 + 8 * g), aw1 = *(const bf16x8*)(s_twb + i * 72 + 32 + 8 * g);
    const bf16x8 aa0 = *(const bf16x8*)(s_pab + i * 72 + 8 * g), aa1 = *(const bf16x8*)(s_pab + i * 72 + 32 + 8 * g);
    f32x4 xw = (f32x4){0.f, 0.f, 0.f, 0.f}, xa = (f32x4){0.f, 0.f, 0.f, 0.f};
    xw = __builtin_amdgcn_mfma_f32_16x16x32_bf16(aw0, bd0, xw, 0, 0, 0);
    xw = __builtin_amdgcn_mfma_f32_16x16x32_bf16(aw1, bd1, xw, 0, 0, 0);
    xa = __builtin_amdgcn_mfma_f32_16x16x32_bf16(aa0, bi0, xa, 0, 0, 0);
    xa = __builtin_amdgcn_mfma_f32_16x16x32_bf16(aa1, bi1, xa, 0, 0, 0);
#pragma unroll
    for (int j = 0; j < 4; ++j) {
      s_xw[(4 * g + j) * LS + 16 * tt + i] = xw[j];
      s_xa[(4 * g + j) * LS + 16 * tt + i] = xa[j];
    }
  }
  __syncthreads();
  {
#pragma unroll
    for (int q = 0; q < 4; ++q) {
      const int tl = tt + 4 * q;
      const float z = -(dbase + s_xw[tl * LS + lane]);
      const float sp = fmaxf(z, 0.f) + __logf(1.f + __expf(-fabsf(z)));
      const float lwv = -__expf(-sp - 0.5f);
      const float a = 1.f / (1.f + __expf(-(ibase + s_xa[tl * LS + lane])));
      const float pk = s_k[tl * LS + lane];
      const float kkr = pk * kns;
      const float ss = wave_sum(kkr * kkr);
      const float kk = kkr * rsqrtf(fmaxf(ss, 1e-24f));
      const float kmod = pk * (1.f + (a - 1.f) * kim);
      s_lw[tl * LS + lane] = lwv;
      s_k[tl * LS + lane] = kmod;
      s_an[tl * LS + lane] = -kk;
      s_b[tl * LS + lane] = kk * a;
      const float rk = wave_sum(s_r[tl * LS + lane] * kmod * bon);
      if (lane == 0) ((float*)(recb + REC_RKB_B))[tl] = rk;
    }
  }
  __syncthreads();
  {
    float run = 0.f, LWp[4], LW[4];
#pragma unroll
    for (int s2 = 0; s2 < 16; ++s2) {
      const float x = s_lw[s2 * LS + lane];
      if ((s2 & 3) == tt) { LWp[s2 >> 2] = run; LW[s2 >> 2] = run + x; }
      run += x;
    }
    const float LWC = run;
    if (tt == 0) ((float*)(recb + REC_WC_B))[lane] = __expf(LWC);
#pragma unroll
    for (int q = 0; q < 4; ++q) {
      const int tl = tt + 4 * q;
      const float e_p = __expf(LWp[q]), e_n = __expf(-LW[q]), e_r = __expf(LW[q]), e_c = __expf(LWC - LW[q]);
      const float an = s_an[tl * LS + lane], bb = s_b[tl * LS + lane], kmod = s_k[tl * LS + lane], rr = s_r[tl * LS + lane];
      s_at[tl * LS + lane] = an * e_p;
      s_bt[tl * LS + lane] = bb * e_n;
      s_kt[tl * LS + lane] = kmod * e_n;
      const float rt = rr * e_r;
      s_rt[tl * LS + lane] = rt;
      const int bkaddr = REC_BK + (lane >> 4) * 512 + (16 * (tl >> 2) + (lane & 15)) * 8 + (tl & 3);
      rec[bkaddr] = f2bf(bb * e_c);
      rec[bkaddr + 4] = f2bf(kmod * e_c);
      const int k5 = lane & 31;
      rec[REC_R + (lane >> 5) * 512 + (16 * ((k5 & 15) >> 2) + tl) * 8 + (k5 & 3) + 4 * (k5 >> 4)] = f2bf(rt);
    }
  }
  __syncthreads();
  {
    const float* X = (tt < 2) ? s_at : s_rt;
    const float* Y = (tt & 1) ? s_kt : s_bt;
    const bf16x8 a0 = cvt8(X + i * LS + 8 * g), a1 = cvt8(X + i * LS + 32 + 8 * g);
    const bf16x8 b0 = cvt8(Y + i * LS + 8 * g), b1 = cvt8(Y + i * LS + 32 + 8 * g);
    f32x4 acc = (f32x4){0.f, 0.f, 0.f, 0.f};
    acc = __builtin_amdgcn_mfma_f32_16x16x32_bf16(a0, b0, acc, 0, 0, 0);
    acc = __builtin_amdgcn_mfma_f32_16x16x32_bf16(a1, b1, acc, 0, 0, 0);
#pragma unroll
    for (int j = 0; j < 4; ++j) {
      const int t = 4 * g + j, s2 = i;
      const bool keep = (tt < 2) ? (s2 < t) : (s2 <= t);
      const float val = keep ? acc[j] : 0.f;
      if (tt == 0) s_Aab[t * 17 + s2] = val;
      else if (tt == 1) s_Aak[t * 17 + s2] = val;
      else rec[REC_AR + (16 * (s2 >> 2) + t) * 8 + (s2 & 3) + 4 * (tt & 1)] = f2bf(val);
    }
  }
  __syncthreads();
  if (tid < 80) {
    float X[16];
#pragma unroll
    for (int t = 0; t < 16; ++t) {
      float val = (tid < 64) ? s_at[t * LS + tid] : s_Aak[t * 17 + (tid - 64)];
#pragma unroll
      for (int s2 = 0; s2 < t; ++s2) val += s_Aab[t * 17 + s2] * X[s2];
      X[t] = val;
    }
    if (tid < 64) {
      const int k5 = tid & 31;
      const int base = REC_M1 + (tid >> 5) * 512 + (16 * ((k5 & 15) >> 2)) * 8 + (k5 & 3) + 4 * (k5 >> 4);
#pragma unroll
      for (int t = 0; t < 16; ++t) rec[base + t * 8] = f2bf(X[t]);
    } else {
      const int s2 = tid - 64;
      const int base = REC_TA + (16 * (s2 >> 2)) * 8 + (s2 & 3);
#pragma unroll
      for (int t = 0; t < 16; ++t) { rec[base + t * 8] = f2bf(X[t]); rec[base + t * 8 + 4] = 0; }
    }
  }
  __syncthreads();
  {
    const uint4* srcv = (const uint4*)rec;
    uint4* dstv = (uint4*)recb;
#pragma unroll
    for (int u = 0; u < 3; ++u) dstv[tid + 256 * u] = srcv[tid + 256 * u];
  }
#pragma unroll
  for (int u = 0; u < 3; ++u) if (prow[u] >= 0) *(uint4*)(s_raw + plds[u]) = pre[u];
  __syncthreads();
  }
#undef RP_PREFETCH
}


#define WAVE_FENCE() do { __builtin_amdgcn_wave_barrier(); asm volatile("s_waitcnt lgkmcnt(0)" ::: "memory"); __builtin_amdgcn_wave_barrier(); } while (0)
__device__ void rwkv_prep_waves(const Params& P, int vb, unsigned char* ldsb) {
  const int tid = threadIdx.x, lane = tid & 63, w = tid >> 6, g = lane >> 4, i = lane & 15;
  const int bh = vb >> 2, b = bh >> 3, h = bh & 7;
  bf16_t* s_du = (bf16_t*)ldsb;
  bf16_t* s_iu = s_du + 64 * 72;
  __syncthreads();
  {
    const int row = tid >> 3, pc = tid & 7;
    *(uint4*)(s_du + row * 72 + pc * 8) = *(const uint4*)(P.dut + (size_t)(h * 64 + row) * 64 + pc * 8);
    *(uint4*)(s_iu + row * 72 + pc * 8) = *(const uint4*)(P.iut + (size_t)(h * 64 + row) * 64 + pc * 8);
  }
  int2* ptab = (int2*)(ldsb + 18432 + 8 * 16384);
  for (int e = tid; e < 11 * 64; e += 512) {
    int q = e; const bool ok = q < 680; q = ok ? q : 679;
    const int rr = q / 40, qq = q - rr * 40, cg = qq >> 3, sub = qq & 7;
    const int col = ((cg < 3) ? (cg * 512 + h * 64) : (cg == 3 ? OFF_WLO : OFF_ALO)) + sub * 8;
    ptab[e] = make_int2((rr * 656 + cg * 128 + sub * 16) | (rr << 16) | (ok ? 0 : (int)0x80000000), col);
  }
  __syncthreads();
  unsigned char* wb = ldsb + 18432 + w * 16384;
  bf16_t* s_twb = (bf16_t*)wb;              bf16_t* s_pab = s_twb + 16 * 72;
  float* s_xw = (float*)(wb + 4608);        float* s_xa = s_xw + 16 * 68;
  bf16_t* im_a = (bf16_t*)(wb + 4608);      bf16_t* im_b = im_a + 1152; bf16_t* im_k = im_b + 1152; bf16_t* im_r = im_k + 1152;
  bf16_t* im_m1 = (bf16_t*)wb;              bf16_t* arim = (bf16_t*)(wb + 2304); bf16_t* taim = (bf16_t*)(wb + 3328);
  bf16_t* im_kb = (bf16_t*)wb;
  float* s_Aab = (float*)(wb + 14208);      float* s_Aak = s_Aab + 272;
  const int c = h * 64 + lane;
  const float mix_r = P.shift_mix[OFF_R + c], mix_k = P.shift_mix[OFF_K + c], mix_v = P.shift_mix[OFF_V + c];
  const float mix_w = P.shift_mix[OFF_WLO + lane], mix_a = P.shift_mix[OFF_ALO + lane];
  const float dbase = P.decay_base[c], ibase = P.iclr_base[c], kns = P.key_norm_scale[c], kim = P.key_iclr_mix[c], bon = P.bonus[c];
  const bf16_t* pb = P.p + (size_t)(b * SEQ) * NIN;
  bf16_t* rawb = (bf16_t*)(wb + 4608);
  u32x4 pre[11];
#define RAWP_LOAD(chn) do { _Pragma("unroll") for (int u = 0; u < 11; ++u) { const int2 e_ = ptab[u * 64 + lane]; \
    int t_ = (chn) * 16 - 1 + ((e_.x >> 16) & 0x7fff); t_ = (t_ < 0) ? 0 : t_; \
    pre[u] = ld_nt(pb + (size_t)t_ * NIN + e_.y); } } while (0)
  RAWP_LOAD((vb & 3) * 64 + w);
  for (int k8 = 0; k8 < 8; ++k8) {
    const int ch = (vb & 3) * 64 + w + 8 * k8;
    const int t0 = ch * 16;
    char* recb = P.rec + (size_t)(bh * 256 + ch) * REC_BYTES;
    float r[16], an[16], bb[16], km[16], LW[16];
#pragma unroll
    for (int u = 0; u < 11; ++u) {
      const int ex = ptab[u * 64 + lane].x;
      u32x4 val = pre[u];
      if (t0 == 0 && (ex & 0x7fff0000) == 0) val = (u32x4){0u, 0u, 0u, 0u};
      if (ex >= 0) *(u32x4*)((unsigned char*)rawb + (ex & 0xffff)) = val;
    }
    WAVE_FENCE();
    {
      float pr = bf2f(rawb[lane]), pk = bf2f(rawb[64 + lane]), pv = bf2f(rawb[128 + lane]), pw = bf2f(rawb[192 + lane]), pa = bf2f(rawb[256 + lane]);
      float vv[16];
#pragma unroll
      for (int t = 0; t < 16; ++t) {
        const bf16_t* row = rawb + (t + 1) * 328;
        const float cr = bf2f(row[lane]), ck = bf2f(row[64 + lane]), cv = bf2f(row[128 + lane]), cw = bf2f(row[192 + lane]), ca = bf2f(row[256 + lane]);
        r[t] = cr + (pr - cr) * mix_r;
        km[t] = ck + (pk - ck) * mix_k;
        vv[t] = cv + (pv - cv) * mix_v;
        s_twb[t * 72 + lane] = f2bf(fast_tanh(cw + (pw - cw) * mix_w));
        s_pab[t * 72 + lane] = f2bf(ca + (pa - ca) * mix_a);
        pr = cr; pk = ck; pv = cv; pw = cw; pa = ca;
      }
#pragma unroll
      for (int g2 = 0; g2 < 4; ++g2) {
        typedef unsigned u32x2_t __attribute__((ext_vector_type(2)));
        u32x2_t o; o.x = pk_bf16(vv[4 * g2], vv[4 * g2 + 1]); o.y = pk_bf16(vv[4 * g2 + 2], vv[4 * g2 + 3]);
        *(u32x2_t*)(recb + 10240 + (lane >> 4) * 512 + (16 * g2 + (lane & 15)) * 8) = o;
      }
    }
    WAVE_FENCE();
    {
      const bf16x8 aw0 = *(const bf16x8*)(s_twb + i * 72 + 8 * g), aw1 = *(const bf16x8*)(s_twb + i * 72 + 32 + 8 * g);
      const bf16x8 aa0 = *(const bf16x8*)(s_pab + i * 72 + 8 * g), aa1 = *(const bf16x8*)(s_pab + i * 72 + 32 + 8 * g);
#pragma unroll
      for (int nt = 0; nt < 4; ++nt) {
        const bf16x8 bd0 = *(const bf16x8*)(s_du + (16 * nt + i) * 72 + 8 * g), bd1 = *(const bf16x8*)(s_du + (16 * nt + i) * 72 + 32 + 8 * g);
        const bf16x8 bi0 = *(const bf16x8*)(s_iu + (16 * nt + i) * 72 + 8 * g), bi1 = *(const bf16x8*)(s_iu + (16 * nt + i) * 72 + 32 + 8 * g);
        f32x4 xw = (f32x4){0.f, 0.f, 0.f, 0.f}, xa = (f32x4){0.f, 0.f, 0.f, 0.f};
        xw = __builtin_amdgcn_mfma_f32_16x16x32_bf16(aw0, bd0, xw, 0, 0, 0);
        xw = __builtin_amdgcn_mfma_f32_16x16x32_bf16(aw1, bd1, xw, 0, 0, 0);
        xa = __builtin_amdgcn_mfma_f32_16x16x32_bf16(aa0, bi0, xa, 0, 0, 0);
        xa = __builtin_amdgcn_mfma_f32_16x16x32_bf16(aa1, bi1, xa, 0, 0, 0);
#pragma unroll
        for (int j = 0; j < 4; ++j) {
          s_xw[(4 * g + j) * 68 + 16 * nt + i] = xw[j];
          s_xa[(4 * g + j) * 68 + 16 * nt + i] = xa[j];
        }
      }
    }
    WAVE_FENCE();
    {
      float run = 0.f;
#pragma unroll
      for (int t = 0; t < 16; ++t) {
        const float lwv = -0.6065306597126334f * __builtin_amdgcn_rcpf(1.f + __expf(-(dbase + s_xw[t * 68 + lane])));
        const float a = __builtin_amdgcn_rcpf(1.f + __expf(-(ibase + s_xa[t * 68 + lane])));
        const float pk = km[t];
        const float kkr = pk * kns;
        const float ss = wave_sum(kkr * kkr);
        const float kk = kkr * rsqrtf(fmaxf(ss, 1e-24f));
        const float kmod = pk * (1.f + (a - 1.f) * kim);
        km[t] = kmod; an[t] = -kk; bb[t] = kk * a;
        run += lwv; LW[t] = run;
        if ((t & 7) == 7) __builtin_amdgcn_sched_barrier(0);
      }
    }
    WAVE_FENCE();
    {
      const float LWC = LW[15];
      const float ewc = __expf(LWC);
      float e_prev = 1.f;
      ((float*)(recb + REC_WC_B))[lane] = ewc;
#pragma unroll
      for (int g2 = 0; g2 < 4; ++g2) {
        float Bp[4], Kp[4];
#pragma unroll
        for (int j = 0; j < 4; ++j) {
          const int t = 4 * g2 + j;
          const float e_p = e_prev, e_n = __expf(-LW[t]), e_r = __builtin_amdgcn_rcpf(e_n), e_c = ewc * e_n;
          e_prev = e_r;
          const float at = an[t] * e_p;
          an[t] = at;
          im_a[t * 72 + lane] = f2bf(at);
          im_b[t * 72 + lane] = f2bf(bb[t] * e_n);
          im_k[t * 72 + lane] = f2bf(km[t] * e_n);
          im_kb[t * 72 + lane] = f2bf(km[t] * e_n * bon);
          im_r[t * 72 + lane] = f2bf(r[t] * e_r);
          Bp[j] = bb[t] * e_c; Kp[j] = km[t] * e_c;
        }
        u32x4 o; o.x = pk_bf16(Bp[0], Bp[1]); o.y = pk_bf16(Bp[2], Bp[3]); o.z = pk_bf16(Kp[0], Kp[1]); o.w = pk_bf16(Kp[2], Kp[3]);
        *(u32x4*)(recb + 4096 + (lane >> 4) * 1024 + (16 * g2 + (lane & 15)) * 16) = o;
      }
    }
    WAVE_FENCE();
    { const int chn = (k8 < 7) ? ch + 8 : ch; RAWP_LOAD(chn); }
    float abm0, abm1, abm2, abm3;
    {
      const bf16x8 fa0 = *(const bf16x8*)(im_a + i * 72 + 8 * g), fa1 = *(const bf16x8*)(im_a + i * 72 + 32 + 8 * g);
      const bf16x8 fr0 = *(const bf16x8*)(im_r + i * 72 + 8 * g), fr1 = *(const bf16x8*)(im_r + i * 72 + 32 + 8 * g);
      const bf16x8 fb0 = *(const bf16x8*)(im_b + i * 72 + 8 * g), fb1 = *(const bf16x8*)(im_b + i * 72 + 32 + 8 * g);
      const bf16x8 fk0 = *(const bf16x8*)(im_k + i * 72 + 8 * g), fk1 = *(const bf16x8*)(im_k + i * 72 + 32 + 8 * g);
      const f32x4 z4 = (f32x4){0.f, 0.f, 0.f, 0.f};
      f32x4 ab = __builtin_amdgcn_mfma_f32_16x16x32_bf16(fa0, fb0, z4, 0, 0, 0); ab = __builtin_amdgcn_mfma_f32_16x16x32_bf16(fa1, fb1, ab, 0, 0, 0);
      f32x4 ak = __builtin_amdgcn_mfma_f32_16x16x32_bf16(fa0, fk0, z4, 0, 0, 0); ak = __builtin_amdgcn_mfma_f32_16x16x32_bf16(fa1, fk1, ak, 0, 0, 0);
      f32x4 rb = __builtin_amdgcn_mfma_f32_16x16x32_bf16(fr0, fb0, z4, 0, 0, 0); rb = __builtin_amdgcn_mfma_f32_16x16x32_bf16(fr1, fb1, rb, 0, 0, 0);
      f32x4 rk = __builtin_amdgcn_mfma_f32_16x16x32_bf16(fr0, fk0, z4, 0, 0, 0); rk = __builtin_amdgcn_mfma_f32_16x16x32_bf16(fr1, fk1, rk, 0, 0, 0);
      const bf16x8 fq0 = *(const bf16x8*)(im_kb + i * 72 + 8 * g), fq1 = *(const bf16x8*)(im_kb + i * 72 + 32 + 8 * g);
      f32x4 rq = __builtin_amdgcn_mfma_f32_16x16x32_bf16(fr0, fq0, z4, 0, 0, 0); rq = __builtin_amdgcn_mfma_f32_16x16x32_bf16(fr1, fq1, rq, 0, 0, 0);
      if ((i >> 2) == g) {
        const int jd = i & 3;
        const float dv = (jd == 0) ? rq[0] : (jd == 1) ? rq[1] : (jd == 2) ? rq[2] : rq[3];
        ((float*)(recb + REC_RKB_B))[i] = dv;
      }
      abm0 = (i < 4 * g + 0) ? ab[0] : 0.f; abm1 = (i < 4 * g + 1) ? ab[1] : 0.f;
      abm2 = (i < 4 * g + 2) ? ab[2] : 0.f; abm3 = (i < 4 * g + 3) ? ab[3] : 0.f;
#pragma unroll
      for (int j = 0; j < 4; ++j) {
        const int t = 4 * g + j, s2 = i;
        s_Aak[t * 17 + s2] = (s2 < t) ? ak[j] : 0.f;
        const int ara = (16 * (s2 >> 2) + t) * 8 + (s2 & 3);
        arim[ara] = f2bf((s2 <= t) ? rb[j] : 0.f);
        arim[ara + 4] = f2bf((s2 <= t) ? rk[j] : 0.f);
      }
    }
    WAVE_FENCE();
    {
      float X[16], Y[16];
      const int sc = lane & 15;
#pragma unroll
      for (int t = 0; t < 16; ++t) {
        float v1 = an[t], v2 = s_Aak[t * 17 + sc];
        const float arow = ((t & 3) == 0) ? abm0 : ((t & 3) == 1) ? abm1 : ((t & 3) == 2) ? abm2 : abm3;
#pragma unroll
        for (int s2 = 0; s2 < t; ++s2) {
          const float cf = __builtin_bit_cast(float, __builtin_amdgcn_readlane(__builtin_bit_cast(int, arow), 16 * (t >> 2) + s2));
          v1 += cf * X[s2]; v2 += cf * Y[s2];
        }
        X[t] = v1; Y[t] = v2;
        im_m1[t * 72 + lane] = f2bf(v1);
        if (lane < 16) { const int ta = (16 * (sc >> 2) + t) * 8 + (sc & 3); taim[ta] = f2bf(v2); taim[ta + 4] = 0; }
        __builtin_amdgcn_sched_barrier(0);
      }
    }
    WAVE_FENCE();
    {
      typedef unsigned u32x2_t __attribute__((ext_vector_type(2)));
#pragma unroll
      for (int ks = 0; ks < 2; ++ks) {
        const u32x2_t ml = *(const u32x2_t*)(im_m1 + i * 72 + 32 * ks + 4 * g), mh = *(const u32x2_t*)(im_m1 + i * 72 + 32 * ks + 16 + 4 * g);
        const u32x2_t rl = *(const u32x2_t*)(im_r + i * 72 + 32 * ks + 4 * g), rh = *(const u32x2_t*)(im_r + i * 72 + 32 * ks + 16 + 4 * g);
        u32x4 mo; mo.x = ml.x; mo.y = ml.y; mo.z = mh.x; mo.w = mh.y;
        u32x4 ro; ro.x = rl.x; ro.y = rl.y; ro.z = rh.x; ro.w = rh.y;
        *(u32x4*)(recb + ks * 1024 + lane * 16) = mo;
        *(u32x4*)(recb + 2048 + ks * 1024 + lane * 16) = ro;
      }
      *(u32x4*)(recb + 8192 + lane * 16) = *(const u32x4*)(taim + lane * 8);
      *(u32x4*)(recb + 9216 + lane * 16) = *(const u32x4*)(arim + lane * 8);
    }
    WAVE_FENCE();
  }
#undef RAWP_LOAD
}

constexpr int SCAN_SLOT = 13312, SCAN_D = 10;
__device__ void rwkv_scan_block(const Params& P, int bh, LAS unsigned char* lds) {
  const int tid = threadIdx.x, wave = __builtin_amdgcn_readfirstlane(tid >> 6), lane = tid & 63;
  const char* rec0 = P.rec + (size_t)(bh * 256) * REC_BYTES;
  if (wave == 4 || wave == 5) {
    for (int ch = 0; ch < 257; ++ch) asm volatile("s_barrier" ::: "memory");
  } else if (wave >= 2) {
    const int lw = (wave & 1) | ((wave >> 2) << 1);
    const char* src0 = rec0 + lw * 3072 + lane * 16;
#define SCAN_ISSUE(chsrc, slot) do { const char* src_ = src0 + (size_t)(chsrc) * REC_BYTES; LAS unsigned char* dst_ = lds + (slot) * SCAN_SLOT + lw * 3072; \
    _Pragma("unroll") for (int u_ = 0; u_ < 3; ++u_) __builtin_amdgcn_global_load_lds((const unsigned*)(src_ + u_ * 1024), (LAS unsigned*)(dst_ + u_ * 1024), 16, 0, 2); \
    if (lw == 0) __builtin_amdgcn_global_load_lds((const unsigned*)(src_ + 12288), (LAS unsigned*)(dst_ + 12288), 16, 0, 2); } while (0)
#define SCAN_WAITBAR() do { if (lw == 0) asm volatile("s_waitcnt vmcnt(28)\n\ts_barrier" ::: "memory"); else asm volatile("s_waitcnt vmcnt(21)\n\ts_barrier" ::: "memory"); } while (0)
#pragma unroll
    for (int c0 = 0; c0 < SCAN_D - 1; ++c0) SCAN_ISSUE(c0, c0);
    SCAN_WAITBAR();
    int slot = SCAN_D - 1;
    for (int ch = 0; ch < 256; ++ch) {
      const int nx = ch + SCAN_D - 1;
      SCAN_ISSUE((nx < 256 ? nx : 255), slot);
      slot = (slot == SCAN_D - 1) ? 0 : slot + 1;
      SCAN_WAITBAR();
    }
    asm volatile("s_waitcnt vmcnt(0)" ::: "memory");
#undef SCAN_ISSUE
#undef SCAN_WAITBAR
  } else {
    const int b = bh >> 3, h = bh & 7, cw = wave, g = lane >> 4, i = lane & 15;
    f32x4 sa[4], sbt[4];
#pragma unroll
    for (int kt = 0; kt < 4; ++kt) { sa[kt] = (f32x4){0.f, 0.f, 0.f, 0.f}; sbt[kt] = (f32x4){0.f, 0.f, 0.f, 0.f}; }
    const f32x4 zero4 = (f32x4){0.f, 0.f, 0.f, 0.f};
    typedef unsigned u32x2_t __attribute__((ext_vector_type(2)));
    struct Fr { u32x4 m1f0, m1f1, rf0, rf1, bk0, bk1, bk2, bk3, taf, arf; u32x2_t va, vb2; f32x4 wc0, wc1, wc2, wc3; };
#define SCAN_FR(F, slotv) do { const LAS unsigned char* sl_ = lds + (slotv) * SCAN_SLOT; const LAS u32x4* fr_ = (const LAS u32x4*)sl_; \
      F.m1f0 = fr_[lane]; F.m1f1 = fr_[64 + lane]; F.rf0 = fr_[128 + lane]; F.rf1 = fr_[192 + lane]; \
      F.bk0 = fr_[256 + lane]; F.bk1 = fr_[320 + lane]; F.bk2 = fr_[384 + lane]; F.bk3 = fr_[448 + lane]; F.taf = fr_[512 + lane]; F.arf = fr_[576 + lane]; \
      F.va = *(const LAS u32x2_t*)(sl_ + 10240 + (2 * cw) * 512 + lane * 8); F.vb2 = *(const LAS u32x2_t*)(sl_ + 10240 + (2 * cw + 1) * 512 + lane * 8); \
      const LAS f32x4* wc_ = (const LAS f32x4*)(sl_ + REC_WC_B); F.wc0 = wc_[g]; F.wc1 = wc_[4 + g]; F.wc2 = wc_[8 + g]; F.wc3 = wc_[12 + g]; } while (0)
#define SCAN_TILE(F, S, VBL, vtv, chv) do { \
      u32x4 sb0, sb1; \
      sb0.x = pk_bf16(S[0][0], S[0][1]); sb0.y = pk_bf16(S[0][2], S[0][3]); sb0.z = pk_bf16(S[1][0], S[1][1]); sb0.w = pk_bf16(S[1][2], S[1][3]); \
      sb1.x = pk_bf16(S[2][0], S[2][1]); sb1.y = pk_bf16(S[2][2], S[2][3]); sb1.z = pk_bf16(S[3][0], S[3][1]); sb1.w = pk_bf16(S[3][2], S[3][3]); \
      u32x4 vbz; vbz.x = VBL.x; vbz.y = VBL.y; vbz.z = 0u; vbz.w = 0u; \
      f32x4 u = __builtin_amdgcn_mfma_f32_16x16x32_bf16(as_frag(F.taf), as_frag(vbz), zero4, 0, 0, 0); \
      u = __builtin_amdgcn_mfma_f32_16x16x32_bf16(as_frag(F.m1f0), as_frag(sb0), u, 0, 0, 0); \
      u = __builtin_amdgcn_mfma_f32_16x16x32_bf16(as_frag(F.m1f1), as_frag(sb1), u, 0, 0, 0); \
      u32x4 uvb; uvb.x = pk_bf16(u[0], u[1]); uvb.y = pk_bf16(u[2], u[3]); uvb.z = VBL.x; uvb.w = VBL.y; \
      f32x4 y = __builtin_amdgcn_mfma_f32_16x16x32_bf16(as_frag(F.rf0), as_frag(sb0), zero4, 0, 0, 0); \
      y = __builtin_amdgcn_mfma_f32_16x16x32_bf16(as_frag(F.rf1), as_frag(sb1), y, 0, 0, 0); \
      y = __builtin_amdgcn_mfma_f32_16x16x32_bf16(as_frag(F.arf), as_frag(uvb), y, 0, 0, 0); \
      S[0] = __builtin_amdgcn_mfma_f32_16x16x32_bf16(as_frag(F.bk0), as_frag(uvb), S[0] * F.wc0, 0, 0, 0); \
      S[1] = __builtin_amdgcn_mfma_f32_16x16x32_bf16(as_frag(F.bk1), as_frag(uvb), S[1] * F.wc1, 0, 0, 0); \
      S[2] = __builtin_amdgcn_mfma_f32_16x16x32_bf16(as_frag(F.bk2), as_frag(uvb), S[2] * F.wc2, 0, 0, 0); \
      S[3] = __builtin_amdgcn_mfma_f32_16x16x32_bf16(as_frag(F.bk3), as_frag(uvb), S[3] * F.wc3, 0, 0, 0); \
      _Pragma("unroll") for (int j = 0; j < 4; ++j) (ystage + ((chv) & 1) * 512)[(4 * g + j) * 32 + 16 * ((vtv) & 1) + i] = f2bf(y[j]); } while (0)
#define SCAN_YOUT(chprev) do { const u32x4 yv_ = *(const LAS u32x4*)(ystage + ((chprev) & 1) * 512 + (lane >> 2) * 32 + (lane & 3) * 8); \
      *(u32x4*)(P.yraw + (size_t)(b * SEQ + (chprev) * 16 + (lane >> 2)) * 512 + h * 64 + 32 * cw + (lane & 3) * 8) = yv_; } while (0)
#define SCAN_STEP(F, chv) do { if ((chv) > 0) SCAN_YOUT((chv) - 1); SCAN_TILE(F, sa, F.va, 2 * cw, chv); SCAN_TILE(F, sbt, F.vb2, 2 * cw + 1, chv); } while (0)
    LAS bf16_t* ystage = (LAS bf16_t*)(lds + SCAN_D * SCAN_SLOT + cw * 2048);
    Fr FA, FB;
    asm volatile("s_barrier" ::: "memory");
    SCAN_FR(FA, 0);
    int slot = 1;
    for (int ch = 0; ch < 256; ch += 2) {
      SCAN_FR(FB, slot); slot = (slot == SCAN_D - 1) ? 0 : slot + 1;
      SCAN_STEP(FA, ch);
      asm volatile("s_waitcnt lgkmcnt(0)\n\ts_barrier" ::: "memory");
      SCAN_FR(FA, slot); slot = (slot == SCAN_D - 1) ? 0 : slot + 1;
      SCAN_STEP(FB, ch + 1);
      asm volatile("s_waitcnt lgkmcnt(0)\n\ts_barrier" ::: "memory");
    }
    SCAN_YOUT(255);
#undef SCAN_YOUT
#undef SCAN_FR
#undef SCAN_TILE
#undef SCAN_STEP
  }
  __syncthreads();
}

#ifndef ATT_TR
#define ATT_TR 1
#endif
constexpr int ATT_ITEMS = 64 * 3 * 32;
constexpr int KV_LD = 72;
typedef short v4i16_t __attribute__((ext_vector_type(4)));
__device__ __forceinline__ bf16x8 vfrag(const bf16_t* sV, int row0, int row1, int g, int i, int mt) {
  bf16x8 a;
#if ATT_TR
  typedef __attribute__((address_space(3))) v4i16_t* ldsp;
  const v4i16_t lo = __builtin_amdgcn_ds_read_tr16_b64_v4i16((ldsp)(sV + (row0 + 4 * g + (i >> 2)) * KV_LD + 16 * mt + 4 * (i & 3)));
  const v4i16_t hi = __builtin_amdgcn_ds_read_tr16_b64_v4i16((ldsp)(sV + (row1 + 4 * g + (i >> 2)) * KV_LD + 16 * mt + 4 * (i & 3)));
#pragma unroll
  for (int j = 0; j < 4; ++j) { a[j] = lo[j]; a[4 + j] = hi[j]; }
#else
#pragma unroll
  for (int j = 0; j < 4; ++j) {
    a[j] = (short)sV[(row0 + 4 * g + j) * KV_LD + 16 * mt + i];
    a[4 + j] = (short)sV[(row1 + 4 * g + j) * KV_LD + 16 * mt + i];
  }
#endif
  return a;
}
constexpr int ATT_ROWS = 256;
struct AttnRegs { u32x4 k0, k1, k2, k3, k4, k5, k6, k7, v0, v1, v2, v3, v4, v5, v6, v7; bf16x8 qa0, qa1, qb0, qb1; };
__device__ __forceinline__ void attn_load(const Params& P, int item, const int tid, AttnRegs& R) {
  const int lane = tid & 63, w = tid >> 6, g = lane >> 4, i = lane & 15;
  const int bh = item / 96, rem = item % 96, pat = rem >> 5, idx = rem & 31;
  const int b = bh >> 3, h = bh & 7;
  const int sh = 2 * pat, dil = 1 << sh;
  const int rho = idx & (dil - 1), qt = idx >> sh;
  const bf16_t* pb = P.p + (size_t)(b * SEQ) * NIN;
#define ATT_LD(u, KK, VV) do { const int c_ = tid + 256 * (u), row_ = c_ >> 3, cc_ = c_ & 7; int ik_ = 128 * qt - 128 + row_; if (ik_ < 0) ik_ = 0; \
    const bf16_t* src_ = pb + (size_t)(rho + (ik_ << sh)) * NIN + h * 64 + cc_ * 8; KK = *(const u32x4*)(src_ + OFF_KB); VV = *(const u32x4*)(src_ + OFF_VB); } while (0)
  ATT_LD(0, R.k0, R.v0); ATT_LD(1, R.k1, R.v1); ATT_LD(2, R.k2, R.v2); ATT_LD(3, R.k3, R.v3);
  ATT_LD(4, R.k4, R.v4); ATT_LD(5, R.k5, R.v5); ATT_LD(6, R.k6, R.v6); ATT_LD(7, R.k7, R.v7);
#undef ATT_LD
  const int qposa = rho + ((128 * qt + 32 * w + i) << sh);
  const bf16_t* qsrc = pb + (size_t)qposa * NIN + OFF_Q + h * 64 + 8 * g;
  R.qa0 = *(const bf16x8*)(qsrc); R.qa1 = *(const bf16x8*)(qsrc + 32);
  const bf16_t* qsrb = qsrc + (size_t)(16 << sh) * NIN;
  R.qb0 = *(const bf16x8*)(qsrb); R.qb1 = *(const bf16x8*)(qsrb + 32);
}
__device__ __forceinline__ void attn_stage(float* sm, const int tid, const AttnRegs& R) {
  bf16_t* sK = (bf16_t*)sm;
  bf16_t* sV = sK + ATT_ROWS * KV_LD;
#define ATT_ST(u, KK, VV) do { const int c_ = tid + 256 * (u), row_ = c_ >> 3, cc_ = c_ & 7; *(u32x4*)(sK + row_ * KV_LD + cc_ * 8) = KK; *(u32x4*)(sV + row_ * KV_LD + cc_ * 8) = VV; } while (0)
  ATT_ST(0, R.k0, R.v0); ATT_ST(1, R.k1, R.v1); ATT_ST(2, R.k2, R.v2); ATT_ST(3, R.k3, R.v3);
  ATT_ST(4, R.k4, R.v4); ATT_ST(5, R.k5, R.v5); ATT_ST(6, R.k6, R.v6); ATT_ST(7, R.k7, R.v7);
#undef ATT_ST
}
__device__ __forceinline__ void attn_compute(const Params& P, int item, float* sm, const int tid, const int weff, const bf16x8 qf0, const bf16x8 qf1) {
  bf16_t* sK = (bf16_t*)sm;
  bf16_t* sV = sK + ATT_ROWS * KV_LD;
  const int lane = tid & 63, g = lane >> 4, i = lane & 15;
  const int bh = item / 96, rem = item % 96, pat = rem >> 5, idx = rem & 31;
  const int b = bh >> 3, h = bh & 7;
  const int sh = 2 * pat, dil = 1 << sh;
  const int rho = idx & (dil - 1), qt = idx >> sh;
  const int qpos = rho + ((128 * qt + 16 * weff + i) << sh);
  f32x4 st[9];
#pragma unroll
  for (int kt = 0; kt < 9; ++kt) {
    const bf16_t* kr = sK + (16 * (weff + kt) + i) * KV_LD + 8 * g;
    f32x4 acc = (f32x4){0.f, 0.f, 0.f, 0.f};
    acc = __builtin_amdgcn_mfma_f32_16x16x32_bf16(*(const bf16x8*)(kr), qf0, acc, 0, 0, 0);
    acc = __builtin_amdgcn_mfma_f32_16x16x32_bf16(*(const bf16x8*)(kr + 32), qf1, acc, 0, 0, 0);
    st[kt] = acc;
  }
  float mx = -INFINITY;
#pragma unroll
  for (int j = 0; j < 4; ++j) {
    if (4 * g + j < i) st[0][j] = -INFINITY;
    if (4 * g + j > i) st[8][j] = -INFINITY;
  }
  if (qt == 0) {
#pragma unroll
    for (int kt = 0; kt < 9; ++kt)
#pragma unroll
      for (int j = 0; j < 4; ++j) if (16 * (weff + kt) + 4 * g + j < 128) st[kt][j] = -INFINITY;
  }
#pragma unroll
  for (int kt = 0; kt < 9; ++kt)
#pragma unroll
    for (int j = 0; j < 4; ++j) mx = fmaxf(mx, st[kt][j]);
  mx = fmaxf(mx, __shfl_xor(mx, 16));
  mx = fmaxf(mx, __shfl_xor(mx, 32));
  constexpr float C2 = 0.125f * 1.4426950408889634f;
  const float nm2 = -mx * C2;
  float l = 0.f;
#pragma unroll
  for (int kt = 0; kt < 9; ++kt)
#pragma unroll
    for (int j = 0; j < 4; ++j) {
      const float pe = __builtin_amdgcn_exp2f(__builtin_fmaf(st[kt][j], C2, nm2));
      st[kt][j] = pe;
      l += pe;
    }
  l += __shfl_xor(l, 16);
  l += __shfl_xor(l, 32);
  f32x4 o[4];
#pragma unroll
  for (int mt = 0; mt < 4; ++mt) o[mt] = (f32x4){0.f, 0.f, 0.f, 0.f};
#pragma unroll
  for (int s2 = 0; s2 < 5; ++s2) {
    const int t0 = 2 * s2, t1 = (2 * s2 + 1 < 9) ? (2 * s2 + 1) : t0;
    u32x4 pw;
    pw.x = pk_bf16(st[t0][0], st[t0][1]); pw.y = pk_bf16(st[t0][2], st[t0][3]);
    pw.z = (2 * s2 + 1 < 9) ? pk_bf16(st[t1][0], st[t1][1]) : 0u; pw.w = (2 * s2 + 1 < 9) ? pk_bf16(st[t1][2], st[t1][3]) : 0u;
    const bf16x8 pbv = as_frag(pw);
#pragma unroll
    for (int mt = 0; mt < 4; ++mt) {
      const bf16x8 a = vfrag(sV, 16 * (weff + t0), 16 * (weff + t1), g, i, mt);
      o[mt] = __builtin_amdgcn_mfma_f32_16x16x32_bf16(a, pbv, o[mt], 0, 0, 0);
    }
  }
  const float rl = 1.f / l;
  const size_t bt = (size_t)(b * SEQ + qpos);
  bf16_t* od = P.p + bt * NIN + pat * 512 + h * 64 + 4 * g;
#pragma unroll
  for (int mt = 0; mt < 4; ++mt) {
    typedef unsigned u32x2_t __attribute__((ext_vector_type(2)));
    u32x2_t ov; ov.x = pk_bf16(o[mt][0] * rl, o[mt][1] * rl); ov.y = pk_bf16(o[mt][2] * rl, o[mt][3] * rl);
    *(u32x2_t*)(od + 16 * mt) = ov;
  }
  if (g == 0) ((float*)(P.p + bt * NIN + 1536))[pat * 8 + h] = mx * 0.125f + __logf(l);
}

constexpr int MERGE_ITEMS = MTOK * 8 * 8 / 512;
__device__ __forceinline__ void merge_one(const Params& P, const int gid, const bool scratch) {
  const int dg = gid & 7, h = (gid >> 3) & 7, bt = gid >> 6;
  bf16_t* prow = P.p + (size_t)bt * NIN;
  {
    const float* lse = (const float*)(prow + 1536);
    const float l0 = lse[h], l1 = lse[8 + h], l2 = lse[16 + h];
    const float m = fmaxf(l0, fmaxf(l1, l2));
    float w0 = __expf(l0 - m), w1 = __expf(l1 - m), w2 = __expf(l2 - m);
    const float rs = 1.f / (w0 + w1 + w2);
    w0 *= rs; w1 *= rs; w2 *= rs;
    const int off = h * 64 + dg * 8;
    const u32x4 a0 = ld_nt(prow + off), a1 = ld_nt(prow + 512 + off), a2 = ld_nt(prow + 1024 + off);
    const u32x4 zz = ld_nt(prow + OFF_ZB + off);
    const unsigned av0[4] = {a0.x, a0.y, a0.z, a0.w}, av1[4] = {a1.x, a1.y, a1.z, a1.w}, av2[4] = {a2.x, a2.y, a2.z, a2.w}, zv[4] = {zz.x, zz.y, zz.z, zz.w};
    unsigned ov[4];
#pragma unroll
    for (int u = 0; u < 4; ++u) {
      const float lo = w0 * __uint_as_float(av0[u] << 16) + w1 * __uint_as_float(av1[u] << 16) + w2 * __uint_as_float(av2[u] << 16);
      const float hi = w0 * __uint_as_float(av0[u] & 0xffff0000u) + w1 * __uint_as_float(av1[u] & 0xffff0000u) + w2 * __uint_as_float(av2[u] & 0xffff0000u);
      const float zl = __uint_as_float(zv[u] << 16), zh = __uint_as_float(zv[u] & 0xffff0000u);
      ov[u] = (unsigned)f2bf(lo * silu(zl)) | ((unsigned)f2bf(hi * silu(zh)) << 16);
    }
    *(uint4*)((scratch ? (bf16_t*)P.out + (size_t)bt * DM + 512 : prow + OFF_ZB) + off) = make_uint4(ov[0], ov[1], ov[2], ov[3]);
  }
  {
    const int cb = h * 64 + dg * 8;
    const u32x4 yy = ld_nt(P.yraw + (size_t)bt * 512 + cb);
    const u32x4 zz = ld_nt(prow + OFF_ZA + cb);
    const unsigned yv[4] = {yy.x, yy.y, yy.z, yy.w}, zv[4] = {zz.x, zz.y, zz.z, zz.w};
    float y[8];
#pragma unroll
    for (int u = 0; u < 4; ++u) { y[2 * u] = __uint_as_float(yv[u] << 16); y[2 * u + 1] = __uint_as_float(yv[u] & 0xffff0000u); }
    float sm1 = 0.f;
#pragma unroll
    for (int u = 0; u < 8; ++u) sm1 += y[u];
    sm1 += __shfl_xor(sm1, 1); sm1 += __shfl_xor(sm1, 2); sm1 += __shfl_xor(sm1, 4);
    const float mu = sm1 * (1.f / 64.f);
    float sq = 0.f;
#pragma unroll
    for (int u = 0; u < 8; ++u) { const float d = y[u] - mu; sq += d * d; }
    sq += __shfl_xor(sq, 1); sq += __shfl_xor(sq, 2); sq += __shfl_xor(sq, 4);
    const float rstd = rsqrtf(sq * (1.f / 64.f) + 64e-5f);
    const int b = bt >> 12, t = bt & (SEQ - 1), tl = t & 15;
    const char* recb = P.rec + (size_t)((b * 8 + h) * 256 + (t >> 4)) * REC_BYTES;
    const float rkb = ((const float*)(recb + REC_RKB_B))[tl];
    const bf16_t* vbp = (const bf16_t*)recb + REC_VB;
    float o[8];
#pragma unroll
    for (int u = 0; u < 8; ++u) {
      const int v = dg * 8 + u;
      const float vv = bf2f(vbp[(v >> 4) * 256 + (16 * (tl >> 2) + (v & 15)) * 4 + (tl & 3)]);
      const float yn = (y[u] - mu) * rstd * P.gn_gain[cb + u] + P.gn_bias[cb + u];
      const float z = (u & 1) ? __uint_as_float(zv[u >> 1] & 0xffff0000u) : __uint_as_float(zv[u >> 1] << 16);
      o[u] = (yn + rkb * vv) * silu(z);
    }
    *(uint4*)((scratch ? (bf16_t*)P.out + (size_t)bt * DM : prow + OFF_ZA) + cb) = make_uint4(pk_bf16(o[0], o[1]), pk_bf16(o[2], o[3]), pk_bf16(o[4], o[5]), pk_bf16(o[6], o[7]));
  }
}

__device__ void merge_item(const Params& P, int item, const bool scratch) {
  const int gid = item * 512 + threadIdx.x;
  merge_one(P, gid, scratch);
  merge_one(P, gid + (MERGE_ITEMS / 2) * 512, scratch);
}

__device__ void final_norm_item(const Params& P, int it, const bool scratch) {
  const int lane = threadIdx.x & 63, wv = threadIdx.x >> 6;
  const int row = it * 16 + wv * 2;
  const bf16_t* yb = (const bf16_t*)P.rec + (size_t)row * DM;
  u32x4 raw[4];
#pragma unroll
  for (int i = 0; i < 4; ++i) raw[i] = ld_nt(yb + (i >> 1) * DM + (i & 1) * 512 + lane * 8);
  float v[4][8];
  float ss0 = 0.f, ss1 = 0.f;
#pragma unroll
  for (int i = 0; i < 4; ++i)
#pragma unroll
    for (int e = 0; e < 4; ++e) {
      v[i][2 * e] = __uint_as_float(raw[i][e] << 16); v[i][2 * e + 1] = __uint_as_float(raw[i][e] & 0xffff0000u);
      const float q = v[i][2 * e] * v[i][2 * e] + v[i][2 * e + 1] * v[i][2 * e + 1];
      if (i < 2) ss0 += q; else ss1 += q;
    }
  ss0 = wave_sum(ss0); ss1 = wave_sum(ss1);
  const float rstd0 = rsqrtf(ss0 * (1.0f / DM) + 1e-6f), rstd1 = rsqrtf(ss1 * (1.0f / DM) + 1e-6f);
#pragma unroll
  for (int i = 0; i < 4; ++i) {
    const int col = (i & 1) * 512 + lane * 8;
    const f32x4 g0 = *(const f32x4*)(P.final_gain + col), g1 = *(const f32x4*)(P.final_gain + col + 4);
    const float rstd = (i < 2) ? rstd0 : rstd1;
    f32x4 o0, o1;
#pragma unroll
    for (int e = 0; e < 4; ++e) { o0[e] = v[i][e] * rstd * g0[e]; o1[e] = v[i][4 + e] * rstd * g1[e]; }
    float* dst = P.out + (size_t)(row + (i >> 1)) * DM + col;
    __builtin_nontemporal_store(o0, (f32x4*)dst); __builtin_nontemporal_store(o1, (f32x4*)(dst + 4));
  }
}

#define XB_TMO      128
#define XB_XCNT(j)  (256  + 64 * (j))
#define XB_XSUB(j)  (1280 + 64 * (j))
#define XB_XGEN(j)  (2304 + 64 * (j))
#define XB_TOP      3328
#define XB_TOPGEN   3392
#define XCD_BAR_WORDS 3456
#define XB_SPIN_CAP (1u << 18)
__device__ __forceinline__ unsigned xb_ld(unsigned* p)              { return __hip_atomic_load(p, __ATOMIC_RELAXED, __HIP_MEMORY_SCOPE_AGENT); }
__device__ __forceinline__ unsigned xb_add(unsigned* p, unsigned v) { return __hip_atomic_fetch_add(p, v, __ATOMIC_RELAXED, __HIP_MEMORY_SCOPE_AGENT); }
__device__ __forceinline__ unsigned xb_xcc_id() { return (unsigned)__builtin_amdgcn_s_getreg((3 << 11) | 20) & 0xFu; }
#define XB_SPIN(cond, bar) do { unsigned _sp = 0; while (cond) { __builtin_amdgcn_s_sleep(1); \
    if ((++_sp & 255u) == 0u) { if (xb_ld(&(bar)[XB_TMO])) break; if (_sp > XB_SPIN_CAP) { atomicAdd(&(bar)[XB_TMO], 1u); break; } } } } while (0)
struct XcdBarrier { unsigned* bar; unsigned x; volatile LAS unsigned* st; };
__device__ __forceinline__ XcdBarrier xcd_barrier_post(unsigned* bar, volatile LAS unsigned* st) {
  XcdBarrier b; b.bar = bar; b.x = xb_xcc_id(); b.st = st;
  if (threadIdx.x == 0) (void)xb_add(&bar[XB_XCNT(b.x)], 1u);
  return b;
}
__device__ __forceinline__ void xcd_barrier_complete(unsigned* bar, unsigned x, unsigned& nloc, unsigned& nx) {
  const unsigned G = gridDim.x * gridDim.y * gridDim.z;
  unsigned sum, cnt, mine, sp = 0u;
  for (;;) {
    sum = 0u; cnt = 0u; mine = 0u;
#pragma unroll
    for (unsigned j = 0; j < 16; ++j) { const unsigned c = xb_ld(&bar[XB_XCNT(j)]); sum += c; cnt += (c > 0u) ? 1u : 0u; mine = (j == x) ? c : mine; }
    if (sum == G) break;
    __builtin_amdgcn_s_sleep(1);
    if ((++sp & 255u) == 0u) { if (xb_ld(&bar[XB_TMO])) break; if (sp > XB_SPIN_CAP) { atomicAdd(&bar[XB_TMO], 1u); break; } }
  }
  nloc = mine > 0u ? mine : 1u; nx = cnt > 0u ? cnt : 1u;
}
__device__ __forceinline__ void xcd_barrier(const XcdBarrier& b) {
  asm volatile("s_waitcnt vmcnt(0)" ::: "memory");
  __syncthreads();
  if (threadIdx.x == 0) {
    unsigned* bar = b.bar;
    __builtin_amdgcn_s_waitcnt(0);
    unsigned nloc = b.st[0], nx = b.st[1];
    if (nloc == 0u) { xcd_barrier_complete(bar, b.x, nloc, nx); b.st[0] = nloc; b.st[1] = nx; }
    const unsigned old = xb_add(&bar[XB_XSUB(b.x)], 1u);
    const unsigned gen = old / nloc;
    if (old + 1u == (gen + 1u) * nloc) {
      __builtin_amdgcn_fence(__ATOMIC_RELEASE, "agent");
      asm volatile("s_waitcnt vmcnt(0)" ::: "memory");
      const unsigned og = xb_add(&bar[XB_TOP], 1u);
      const unsigned tg = og / nx;
      if (og + 1u == (tg + 1u) * nx) xb_add(&bar[XB_TOPGEN], 1u);
      else XB_SPIN(xb_ld(&bar[XB_TOPGEN]) == tg, bar);
      __builtin_amdgcn_fence(__ATOMIC_ACQUIRE, "agent");
      xb_add(&bar[XB_XGEN(b.x)], 1u);
      asm volatile("s_waitcnt vmcnt(0)" ::: "memory");
    } else {
      XB_SPIN(xb_ld(&bar[XB_XGEN(b.x)]) == gen, bar);
      __builtin_amdgcn_fence(__ATOMIC_ACQUIRE, "agent");
      asm volatile("s_waitcnt vmcnt(0)" ::: "memory");
    }
  }
  __syncthreads();
}

constexpr int LDS_CTRL = 18432 + 8 * 16384 + 5632;
constexpr int LDS_BYTES = LDS_CTRL + 16;
constexpr int HALF_LDS_FLOATS = 18432;
constexpr int SCAN_BLOCKS = 64;
#ifndef PROBE
#define PROBE 0
#endif

__global__ void __launch_bounds__(512, 2) fwd_megakernel(Params P) {
  extern __shared__ __attribute__((aligned(16))) unsigned char lds[];
  float* sm = (float*)lds;
  cg::grid_group grid = cg::this_grid();
  const int nb = gridDim.x, bid = blockIdx.x, tid = threadIdx.x, half = tid >> 8, t8 = tid & 255;
  float* smh = sm + half * HALF_LDS_FLOATS;
  volatile LAS unsigned* xst = (volatile LAS unsigned*)((LAS unsigned char*)lds + LDS_CTRL);
  if (tid == 0) { xst[0] = 0u; xst[1] = 0u; }
  __syncthreads();
  const XcdBarrier xbar = xcd_barrier_post(P.barw, xst);
  for (int rep = 0; rep < (PROBE == 5 ? 2 : 1); ++rep)
  for (int it = bid; it < PREP_ITEMS; it += nb) prep_item(P, it, sm);
  if (P.out == nullptr) grid.sync();
  for (int r_ = 0; r_ < (PROBE == 10 ? 3 : 1); ++r_) xcd_barrier(xbar);
  {
    pg8::Gemm g; g.A = P.hb; g.Bt = P.winT; g.M = MTOK; g.N = NPAD; g.K = DM; g.lda = DM;
    pg8::StaticOrder S; S.init(MTOK, NPAD, nb, bid);
    EpiProj E; E.p = P.p;
    pg8::gemm_phase<EpiProj>((LAS unsigned char*)lds, g, S, E);
    if (PROBE == 4) pg8::gemm_phase<EpiProj>((LAS unsigned char*)lds, g, S, E);
  }
  for (int r_ = 0; r_ < (PROBE == 10 ? 3 : 1); ++r_) xcd_barrier(xbar);
  for (int rep = 0; rep < (PROBE == 3 ? 2 : 1); ++rep)
  for (int vb = bid; vb < 256; vb += nb) rwkv_prep_waves(P, vb, (unsigned char*)lds);
  for (int r_ = 0; r_ < (PROBE == 10 ? 3 : 1); ++r_) xcd_barrier(xbar);
  for (int rep = 0; rep < (PROBE == 7 ? 2 : 1); ++rep) {
  if (bid < SCAN_BLOCKS) rwkv_scan_block(P, bid, (LAS unsigned char*)lds);
  {
    volatile LAS int* qslot = (volatile LAS int*)((LAS unsigned char*)lds + LDS_CTRL + 8);
    unsigned* ctr = P.barw + XCD_BAR_WORDS + 64 + rep * 1024;
    int qx = (int)(xbar.x & 7u), tried = 0;
    constexpr int QPAIRS = ATT_ITEMS / 16;
#define ATT_FETCH(dst) do { dst = -1; while (tried < 8) { const int ix_ = (int)atomicAdd(ctr + qx * 64, 1u); if (ix_ < QPAIRS) { dst = qx * QPAIRS + ix_; break; } qx = (qx + 1) & 7; ++tried; } } while (0)
    int a1 = -1;
    if (tid == 0) { int a0; ATT_FETCH(a0); ATT_FETCH(a1); *qslot = a0; }
    __syncthreads();
    int it = *qslot;
    AttnRegs R;
#define ATT_ITEM(pr) ((8 * ((2 * ((pr) % QPAIRS)) / 96) + (pr) / QPAIRS) * 96 + (2 * ((pr) % QPAIRS)) % 96 + half)
    attn_load(P, ATT_ITEM(it >= 0 ? it : 0), t8, R);
    while (it >= 0) {
      __syncthreads();
      if (tid == 0) { *qslot = a1; ATT_FETCH(a1); }
      attn_stage(smh, t8, R);
      const bf16x8 qa0 = R.qa0, qa1 = R.qa1, qb0 = R.qb0, qb1 = R.qb1;
      __syncthreads();
      const int itn = *qslot;
      attn_load(P, ATT_ITEM(itn >= 0 ? itn : 0), t8, R);
      const int item = ATT_ITEM(it);
      attn_compute(P, item, smh, t8, 2 * (t8 >> 6), qa0, qa1);
      attn_compute(P, item, smh, t8, 2 * (t8 >> 6) + 1, qb0, qb1);
      it = itn;
    }
#undef ATT_FETCH
#undef ATT_ITEM
  }
  __syncthreads();
  }
  for (int r_ = 0; r_ < (PROBE == 10 ? 3 : 1); ++r_) xcd_barrier(xbar);
  if (PROBE == 9) for (int it = bid; it < MERGE_ITEMS / 2; it += nb) merge_item(P, it, true);
  for (int it = bid; it < MERGE_ITEMS / 2; it += nb) merge_item(P, it, false);
  for (int r_ = 0; r_ < (PROBE == 10 ? 3 : 1); ++r_) xcd_barrier(xbar);
  {
    pg8::Gemm g; g.A = P.p + OFF_ZA; g.Bt = P.woutT; g.M = MTOK; g.N = DM; g.K = DM; g.lda = NIN;
    pg8::StaticOrder S; S.init(MTOK, DM, nb, bid);
    EpiOut E; E.x = P.x; E.ybf = (bf16_t*)P.rec;
    pg8::gemm_phase<EpiOut>((LAS unsigned char*)lds, g, S, E);
    if (PROBE == 6) pg8::gemm_phase<EpiOut>((LAS unsigned char*)lds, g, S, E);
  }
  for (int r_ = 0; r_ < (PROBE == 10 ? 3 : 1); ++r_) xcd_barrier(xbar);
  for (int it = bid; it < MTOK / 16; it += nb) final_norm_item(P, it, false);
}

extern "C" void kernel_launch(void* const* d_in, const int* in_sizes, int n_in, void* d_out, int out_size, void* d_ws, size_t ws_size,
                              hipStream_t stream) {
  Params P{};
  P.x = (const float*)d_in[0]; P.norm_gain = (const float*)d_in[1]; P.w_in = (const float*)d_in[2]; P.shift_mix = (const float*)d_in[3];
  P.decay_base = (const float*)d_in[4]; P.decay_up = (const float*)d_in[5]; P.iclr_base = (const float*)d_in[6]; P.iclr_up = (const float*)d_in[7];
  P.key_norm_scale = (const float*)d_in[8]; P.key_iclr_mix = (const float*)d_in[9]; P.bonus = (const float*)d_in[10]; P.gn_gain = (const float*)d_in[11];
  P.gn_bias = (const float*)d_in[12]; P.w_out = (const float*)d_in[13]; P.final_gain = (const float*)d_in[14];
  P.out = (float*)d_out;
  char* ws = (char*)d_ws;
  const size_t MiB = 1024 * 1024;
  P.winT = (bf16_t*)(ws);
  P.woutT = (bf16_t*)(ws + 9 * MiB);
  P.dut = (bf16_t*)(ws + 11 * MiB);
  P.iut = (bf16_t*)(ws + 11 * MiB + 65536);
  P.p = (bf16_t*)(ws + 12 * MiB);
  P.hb = (bf16_t*)(ws + 276 * MiB);
  P.rec = ws + 276 * MiB;
  P.yraw = (bf16_t*)(ws + 474 * MiB);
  P.barw = (unsigned*)(ws + 506 * MiB);
  if (ws_size < 507 * MiB) { fprintf(stderr, "workspace too small\n"); return; }
  static int grid_blocks = 0;
  if (!grid_blocks) {
    int dev = 0, cus = 0, per_cu = 0;
    (void)hipGetDevice(&dev);
    (void)hipDeviceGetAttribute(&cus, hipDeviceAttributeMultiprocessorCount, dev);
    (void)hipFuncSetAttribute((const void*)fwd_megakernel, hipFuncAttributeMaxDynamicSharedMemorySize, LDS_BYTES);
    (void)hipOccupancyMaxActiveBlocksPerMultiprocessor(&per_cu, fwd_megakernel, 512, LDS_BYTES);
    if (per_cu > 1) per_cu = 1;
    grid_blocks = cus * per_cu;
  }
  (void)hipMemsetAsync(P.barw, 0, (XCD_BAR_WORDS + 64 + 2048) * sizeof(unsigned), stream);
  void* args[] = {&P};
  hipError_t e = hipLaunchCooperativeKernel((void*)fwd_megakernel, dim3(grid_blocks), dim3(512), args, LDS_BYTES, stream);
  if (e != hipSuccess) fprintf(stderr, "cooperative launch failed: %s (grid %d)\n", hipGetErrorString(e), grid_blocks);
}
```
